# Optimizing an MI355X kernel written in HIP

```python
import jax, jax.numpy as jnp
from jax import lax
import numpy as np

D_MODEL = 1024
BATCH = 4
SEQ = 4096
DEPTH = 4

GRID_W = 64
CTX_LEN = 256
N_EVEN = (DEPTH + 1) // 2
N_ODD = DEPTH // 2
N_MOD = 6
EPS = 1e-6
D_CONV = D_MODEL // 2
CONV_W = 3
D_POOL = D_MODEL // 2
POOL_WINDOWS = (2, 4, 8, 16)
N_POOL_GROUPS = len(POOL_WINDOWS)
POOL_GROUP = D_POOL // N_POOL_GROUPS
D_MIX_IN = 3 * D_CONV + D_POOL
NA_HEADS = 16
NA_HEAD_DIM = D_MODEL // NA_HEADS
NA_ROWS = 8
NA_COLS = 16
D_FF = 2816
N_EXPERTS = 8
TOP_K = 2
D_FF_EXPERT = 3584

kernel_name = 'hybrid_conv_pool_natten_moe_dit'


def rmsnorm(x, g):
    x32 = x.astype(jnp.float32)
    y = x32 * lax.rsqrt(jnp.mean(x32 * x32, axis=-1, keepdims=True) + EPS)
    return (y * g.astype(jnp.float32)).astype(x.dtype)


def modulate(h, shift, scale):
    return h * (1 + scale) + shift


def adaln(cond, w, b):
    m = jax.nn.silu(cond) @ w + b
    return m.reshape(m.shape[:-1] + (N_MOD, D_MODEL))


def short_conv(z, w):
    L = z.shape[1]
    pad = CONV_W // 2
    zp = jnp.pad(z, ((0, 0), (pad, CONV_W - 1 - pad), (0, 0)))
    out = zp[:, 0:L] * w[0]
    for k in range(1, CONV_W):
        out = out + zp[:, k:k + L] * w[k]
    return out


def multiscale_pool(p, w_grp, scale):
    B_, L, _ = p.shape
    p32 = p.astype(jnp.float32)
    csum = jnp.concatenate([jnp.zeros_like(p32[:, :1]), jnp.cumsum(p32, axis=1)], axis=1)
    t = np.arange(L)
    pooled = []
    for g, win in enumerate(POOL_WINDOWS):
        lo = np.maximum(t - win // 2, 0)
        hi = np.minimum(t + (win - 1 - win // 2), L - 1)
        cs = csum[..., g * POOL_GROUP:(g + 1) * POOL_GROUP]
        cnt = (hi - lo + 1).astype(np.float32)[None, :, None]
        pooled.append((cs[:, hi + 1] - cs[:, lo]) / cnt)
    pooled = jnp.stack(pooled, axis=2).astype(p.dtype)
    diff = pooled - p.reshape(B_, L, N_POOL_GROUPS, POOL_GROUP)
    y = jnp.einsum('blgc,gcd->blgd', diff, w_grp)
    return y.reshape(B_, L, D_POOL) * scale


def conv_pool_mixer(h, w_in, conv_w, pool_w, pool_scale, w_out):
    u = h @ w_in
    gate_b, gate_c, val, pin = jnp.split(u, [D_CONV, 2 * D_CONV, 3 * D_CONV], axis=-1)
    y_conv = gate_b * short_conv(gate_c * val, conv_w)
    y_pool = multiscale_pool(pin, pool_w, pool_scale)
    return jnp.concatenate([y_conv, y_pool], axis=-1) @ w_out


def _heads(t):
    return t.reshape(t.shape[0], t.shape[1], NA_HEADS, NA_HEAD_DIM)


def neighbourhood_attention(q, k, v, kc, vc, rpb):
    B_, L, H, dh = q.shape
    rows = L // GRID_W
    kr = min(NA_ROWS, rows)
    scale = dh ** -0.5
    qg = q.reshape(B_, rows, GRID_W, H, dh)
    kg = k.reshape(B_, rows, GRID_W, H, dh)
    vg = v.reshape(B_, rows, GRID_W, H, dh)
    jcol = np.arange(GRID_W)
    col_start = np.clip(jcol - NA_COLS // 2, 0, GRID_W - NA_COLS)
    col_idx = col_start[:, None] + np.arange(NA_COLS)[None, :]
    dc_idx = col_idx - jcol[:, None] + (NA_COLS - 1)
    rpb_c = rpb[:, :, dc_idx]
    n_loc = kr * NA_COLS

    def row_block(r):
        q_r = lax.dynamic_index_in_dim(qg, r, axis=1, keepdims=False)
        start = jnp.clip(r - NA_ROWS // 2, 0, rows - kr)
        k_band = lax.dynamic_slice_in_dim(kg, start, kr, axis=1)
        v_band = lax.dynamic_slice_in_dim(vg, start, kr, axis=1)
        k_win = k_band[:, :, col_idx]
        v_win = v_band[:, :, col_idx]
        dr_idx = start + jnp.arange(kr) - r + (NA_ROWS - 1)
        bias = jnp.take(rpb_c, dr_idx, axis=1).transpose(0, 2, 1, 3)
        s_loc = jnp.einsum('bjhd,brjchd->bhjrc', q_r, k_win).astype(jnp.float32) * scale + bias
        s_ctx = jnp.einsum('bjhd,bnhd->bhjn', q_r, kc).astype(jnp.float32) * scale
        logits = jnp.concatenate([s_loc.reshape(B_, H, GRID_W, n_loc), s_ctx], axis=-1)
        p = jax.nn.softmax(logits, axis=-1).astype(v.dtype)
        p_loc = p[..., :n_loc].reshape(B_, H, GRID_W, kr, NA_COLS)
        p_ctx = p[..., n_loc:]
        return (jnp.einsum('bhjrc,brjchd->bjhd', p_loc, v_win)
                + jnp.einsum('bhjn,bnhd->bjhd', p_ctx, vc))

    out = lax.map(row_block, jnp.arange(rows))
    return out.transpose(1, 0, 2, 3, 4).reshape(B_, L, H * dh)


def context_attention(qc, kc, vc):
    B_, N, H, dh = qc.shape
    s = jnp.einsum('bmhd,bnhd->bhmn', qc, kc).astype(jnp.float32) * (dh ** -0.5)
    p = jax.nn.softmax(s, axis=-1).astype(vc.dtype)
    return jnp.einsum('bhmn,bnhd->bmhd', p, vc).reshape(B_, N, H * dh)


def swiglu(h, w_gate, w_up, w_down):
    return (jax.nn.silu(h @ w_gate) * (h @ w_up)) @ w_down


def moe_swiglu(h, w_router, we_gate, we_up, we_down):
    shp = h.shape
    t = h.reshape(-1, D_MODEL)
    logits = (t @ w_router).astype(jnp.float32)
    top_v, top_i = lax.top_k(logits, TOP_K)
    gates = jax.nn.softmax(top_v, axis=-1)
    comb = jnp.sum(jax.nn.one_hot(top_i, N_EXPERTS, dtype=jnp.float32) * gates[..., None], axis=1).astype(h.dtype)
    out = jnp.zeros_like(t)
    for e in range(N_EXPERTS):
        out = out + comb[:, e:e + 1] * swiglu(t, we_gate[e], we_up[e], we_down[e])
    return out.reshape(shp)


def channel_mix(layer, h, w_ff_gate, w_ff_up, w_ff_down, w_router, we_gate, we_up, we_down):
    j = layer // 2
    if layer % 2 == 0:
        return swiglu(h, w_ff_gate[j], w_ff_up[j], w_ff_down[j])
    return moe_swiglu(h, w_router[j], we_gate[j], we_up[j], we_down[j])


def setup_inputs(seed: int = 0) -> dict:
    key = jax.random.key(seed)
    ks = iter(jax.random.split(key, 32))
    D = D_MODEL

    def nrm(shape, scale):
        return jax.random.normal(next(ks), shape, jnp.float32) * scale

    return {
        'x': nrm((BATCH, SEQ, D), 1.0),
        'c': nrm((BATCH, D), 1.0),
        'ctx': nrm((BATCH, CTX_LEN, D), 1.0),
        'c_ctx': nrm((D,), 1.0),
        'w_mod': nrm((DEPTH, D, N_MOD * D), 0.5 * D ** -0.5),
        'b_mod': nrm((DEPTH, N_MOD * D), 0.02),
        'g_mix': 1.0 + nrm((DEPTH, D), 0.05),
        'g_ffn': 1.0 + nrm((DEPTH, D), 0.05),
        'g_final': 1.0 + nrm((D,), 0.05),
        'w_in_ab': nrm((N_EVEN, D, D_MIX_IN), D ** -0.5),
        'conv_w': nrm((N_EVEN, CONV_W, D_CONV), CONV_W ** -0.5),
        'pool_w': nrm((N_EVEN, N_POOL_GROUPS, POOL_GROUP, POOL_GROUP), POOL_GROUP ** -0.5),
        'pool_scale': 1.0 + nrm((N_EVEN, D_POOL), 0.1),
        'w_out_ab': nrm((N_EVEN, D_CONV + D_POOL, D), (D_CONV + D_POOL) ** -0.5),
        'w_ff_gate': nrm((N_EVEN, D, D_FF), D ** -0.5),
        'w_ff_up': nrm((N_EVEN, D, D_FF), D ** -0.5),
        'w_ff_down': nrm((N_EVEN, D_FF, D), D_FF ** -0.5),
        'w_qkv': nrm((N_ODD, D, 3 * D), D ** -0.5),
        'rpb': nrm((N_ODD, NA_HEADS, 2 * NA_ROWS - 1, 2 * NA_COLS - 1), 0.1),
        'w_out_na': nrm((N_ODD, D, D), D ** -0.5),
        'w_router': nrm((N_ODD, D, N_EXPERTS), D ** -0.5),
        'we_gate': nrm((N_ODD, N_EXPERTS, D, D_FF_EXPERT), D ** -0.5),
        'we_up': nrm((N_ODD, N_EXPERTS, D, D_FF_EXPERT), D ** -0.5),
        'we_down': nrm((N_ODD, N_EXPERTS, D_FF_EXPERT, D), D_FF_EXPERT ** -0.5),
    }


def reference(x, c, ctx, c_ctx, w_mod, b_mod, g_mix, g_ffn, g_final, w_in_ab, conv_w, pool_w, pool_scale,
              w_out_ab, w_ff_gate, w_ff_up, w_ff_down, w_qkv, rpb, w_out_na, w_router, we_gate, we_up, we_down):
    h_lat, h_ctx = x, ctx
    for i in range(DEPTH):
        last = i == DEPTH - 1
        j = i // 2
        m_lat = adaln(c, w_mod[i], b_mod[i])[:, :, None, :]
        m_ctx = adaln(c_ctx, w_mod[i], b_mod[i])[None, :, None, :]
        a_lat = modulate(rmsnorm(h_lat, g_mix[i]), m_lat[:, 0], m_lat[:, 1])
        if i % 2 == 0:
            y_lat = conv_pool_mixer(a_lat, w_in_ab[j], conv_w[j], pool_w[j], pool_scale[j], w_out_ab[j])
        else:
            a_ctx = modulate(rmsnorm(h_ctx, g_mix[i]), m_ctx[:, 0], m_ctx[:, 1])
            q, k, v = (_heads(t) for t in jnp.split(a_lat @ w_qkv[j], 3, axis=-1))
            kc, vc = (_heads(t) for t in jnp.split(a_ctx @ w_qkv[j][:, D_MODEL:], 2, axis=-1))
            y_lat = neighbourhood_attention(q, k, v, kc, vc, rpb[j]) @ w_out_na[j]
        h_lat = h_lat + m_lat[:, 2] * y_lat
        f_lat = modulate(rmsnorm(h_lat, g_ffn[i]), m_lat[:, 3], m_lat[:, 4])
        h_lat = h_lat + m_lat[:, 5] * channel_mix(i, f_lat, w_ff_gate, w_ff_up, w_ff_down,
                                                  w_router, we_gate, we_up, we_down)
        if not last:
            if i % 2 == 0:
                a_ctx = modulate(rmsnorm(h_ctx, g_mix[i]), m_ctx[:, 0], m_ctx[:, 1])
                y_ctx = conv_pool_mixer(a_ctx, w_in_ab[j], conv_w[j], pool_w[j], pool_scale[j], w_out_ab[j])
            else:
                qc = _heads(a_ctx @ w_qkv[j][:, :D_MODEL])
                y_ctx = context_attention(qc, kc, vc) @ w_out_na[j]
            h_ctx = h_ctx + m_ctx[:, 2] * y_ctx
            f_ctx = modulate(rmsnorm(h_ctx, g_ffn[i]), m_ctx[:, 3], m_ctx[:, 4])
            h_ctx = h_ctx + m_ctx[:, 5] * channel_mix(i, f_ctx, w_ff_gate, w_ff_up, w_ff_down,
                                                      w_router, we_gate, we_up, we_down)
    return rmsnorm(h_lat, g_final)
```

```cpp
#include <hip/hip_runtime.h>
#include <cstdio>
#include <cstdint>

#define GAS __attribute__((address_space(1)))
#define LAS __attribute__((address_space(3)))
typedef unsigned short bf16;
typedef short bf16x8 __attribute__((ext_vector_type(8)));
typedef float f32x4 __attribute__((ext_vector_type(4)));
typedef float f32x2 __attribute__((ext_vector_type(2)));
typedef unsigned u32x4 __attribute__((ext_vector_type(4)));
typedef unsigned u32x2 __attribute__((ext_vector_type(2)));

constexpr int D = 1024, NB = 4, SEQ = 4096, CTXL = 256, GW = 64;
constexpr int ML = NB * SEQ, MC = NB * CTXL, MT = ML + MC;
constexpr int DFF = 2816, NE = 8, DFE = 3584, NH = 16, HD = 64;
constexpr int MPAIR_MAX = 36864;
constexpr float EPS = 1e-6f;
constexpr float QSCALE = 0.18033688011112042f;
constexpr float LOG2E = 1.4426950408889634f;

constexpr size_t MiB = 1u << 20;
constexpr size_t WS_CTL = 0, CTL_BYTES = 1 * MiB;
constexpr size_t WS_MODS = 1 * MiB;
constexpr size_t WS_RPB = 2 * MiB;
constexpr size_t WS_TOK = 4 * MiB;
constexpr size_t WS_WB = 8 * MiB, WB_STRIDE = 200 * MiB;
constexpr size_t WS_H = 408 * MiB;
constexpr size_t WS_AF = 476 * MiB;
constexpr size_t WS_Y1 = 510 * MiB;
constexpr size_t WS_VT = 544 * MiB;
constexpr size_t WS_YPB = WS_Y1;
constexpr size_t WS_YPAIR = 582 * MiB;
constexpr size_t WS_BIG = 654 * MiB;
constexpr size_t WS_END = 906 * MiB;
static_assert(WS_YPB + (size_t)MPAIR_MAX * 1024 * 2 <= WS_YPAIR && WS_YPAIR + (size_t)MPAIR_MAX * 1024 * 2 <= WS_BIG, "expert output buffers");
constexpr size_t WB_WIN = 0;
constexpr size_t WB_WOUT = WB_WIN + (size_t)2048 * 1024;
constexpr size_t WB_WGU = WB_WOUT + (size_t)1024 * 1024;
constexpr size_t WB_WD = WB_WGU + (size_t)5632 * 1024;
constexpr size_t WB_WQKV = WB_WD + (size_t)1024 * 2816;
constexpr size_t WB_WO = WB_WQKV + (size_t)3072 * 1024;
constexpr size_t WB_WEGU = WB_WO + (size_t)1024 * 1024;
constexpr size_t WB_WED = WB_WEGU + (size_t)8 * 7168 * 1024;
constexpr size_t WB_END = WB_WED + (size_t)8 * 1024 * 3584;
static_assert(WB_END * 2 <= WB_STRIDE && WS_WB + 2 * WB_STRIDE <= WS_H, "weights fit");
static_assert(WS_BIG + (size_t)MPAIR_MAX * 3584 * 2 <= WS_END, "big fits");
constexpr int CW_CNT = 64;
constexpr int CW_QHEAD = 1024;
constexpr int CW_SS = 32768;
constexpr size_t WS_BIAS = WS_MODS + 512 * 1024;
constexpr int BIAS_GU = 0, BIAS_QKV = 2 * 5 * 5632;
constexpr int CW_BAR = 4096;

constexpr int LDS_BYTES = 147456;
constexpr int MISC_OFF = 131072 + 320;
constexpr int PART_OFF = 131072 + 1024;

#ifndef FAST_MASK
#define FAST_MASK 0x3FF
#endif
#define FAST(k) ((FAST_MASK >> (k)) & 1)
#ifndef REP_MASK
#define REP_MASK 0
#endif
#define REPN(k) (1 + ((REP_MASK >> (k)) & 1))
struct Args { const float* in[24]; float* out; unsigned char* ws; };

__device__ __forceinline__ unsigned cvt_pk_bf16(float lo, float hi) { unsigned r; asm("v_cvt_pk_bf16_f32 %0, %1, %2" : "=v"(r) : "v"(lo), "v"(hi)); return r; }
__device__ __forceinline__ float bf2f(short s) { return __uint_as_float(((unsigned)(unsigned short)s) << 16); }
__device__ __forceinline__ float bfu2f(bf16 s) { return __uint_as_float(((unsigned)s) << 16); }
__device__ __forceinline__ float wave_sum(float v) {
#pragma unroll
    for (int o = 1; o < 64; o <<= 1) v += __shfl_xor(v, o);
    return v;
}
__device__ __forceinline__ float wave_max(float v) {
#pragma unroll
    for (int o = 1; o < 64; o <<= 1) v = fmaxf(v, __shfl_xor(v, o));
    return v;
}
__device__ __forceinline__ float silu_f(float g) { return g * __builtin_amdgcn_rcpf(1.f + __builtin_amdgcn_exp2f(-1.4426950408889634f * g)); }

#define XB_TMO      128
#define XB_XCNT(j)  (256  + 64 * (j))
#define XB_XSUB(j)  (1280 + 64 * (j))
#define XB_XGEN(j)  (2304 + 64 * (j))
#define XB_TOP      3328
#define XB_TOPGEN   3392
#define XCD_BAR_WORDS 3456
#define XB_SPIN_CAP (1u << 22)
__device__ __forceinline__ unsigned xb_ld(unsigned* p)              { return __hip_atomic_load(p, __ATOMIC_RELAXED, __HIP_MEMORY_SCOPE_AGENT); }
__device__ __forceinline__ unsigned xb_add(unsigned* p, unsigned v) { return __hip_atomic_fetch_add(p, v, __ATOMIC_RELAXED, __HIP_MEMORY_SCOPE_AGENT); }
__device__ __forceinline__ unsigned xb_xcc_id() { return (unsigned)__builtin_amdgcn_s_getreg((3 << 11) | 20) & 0xFu; }
#define XB_SPIN(cond, bar) do { unsigned _sp = 0; while (cond) { __builtin_amdgcn_s_sleep(1); \
    if ((++_sp & 255u) == 0u) { if (xb_ld(&(bar)[XB_TMO])) break; if (_sp > XB_SPIN_CAP) { atomicAdd(&(bar)[XB_TMO], 1u); break; } } } } while (0)
struct XcdBarrier { unsigned* bar; unsigned x; volatile LAS unsigned* st; };
__device__ __forceinline__ XcdBarrier xcd_barrier_post(unsigned* bar, volatile LAS unsigned* st) {
    XcdBarrier b; b.bar = bar; b.x = xb_xcc_id(); b.st = st;
    if (threadIdx.x == 0) (void)xb_add(&bar[XB_XCNT(b.x)], 1u);
    return b;
}
__device__ __forceinline__ void xcd_barrier_complete(unsigned* bar, unsigned x, unsigned& nloc, unsigned& nx) {
    const unsigned G = gridDim.x * gridDim.y * gridDim.z;
    unsigned sum, cnt, mine, sp = 0u;
    for (;;) {
        sum = 0u; cnt = 0u; mine = 0u;
#pragma unroll
        for (unsigned j = 0; j < 16; ++j) { const unsigned c = xb_ld(&bar[XB_XCNT(j)]); sum += c; cnt += (c > 0u) ? 1u : 0u; mine = (j == x) ? c : mine; }
        if (sum == G) break;
        __builtin_amdgcn_s_sleep(1);
        if ((++sp & 255u) == 0u) { if (xb_ld(&bar[XB_TMO])) break; if (sp > XB_SPIN_CAP) { atomicAdd(&bar[XB_TMO], 1u); break; } }
    }
    nloc = mine > 0u ? mine : 1u; nx = cnt > 0u ? cnt : 1u;
}
__device__ __forceinline__ void xcd_barrier(const XcdBarrier& b) {
    asm volatile("s_waitcnt vmcnt(0)" ::: "memory");
    __syncthreads();
    if (threadIdx.x == 0) {
        unsigned* bar = b.bar;
        __builtin_amdgcn_s_waitcnt(0);
        unsigned nloc = b.st[0], nx = b.st[1];
        if (nloc == 0u) { xcd_barrier_complete(bar, b.x, nloc, nx); b.st[0] = nloc; b.st[1] = nx; }
        const unsigned old = xb_add(&bar[XB_XSUB(b.x)], 1u);
        const unsigned gen = old / nloc;
        if (old + 1u == (gen + 1u) * nloc) {
            __builtin_amdgcn_fence(__ATOMIC_RELEASE, "agent");
            asm volatile("s_waitcnt vmcnt(0)" ::: "memory");
            const unsigned og = xb_add(&bar[XB_TOP], 1u);
            const unsigned tg = og / nx;
            if (og + 1u == (tg + 1u) * nx) xb_add(&bar[XB_TOPGEN], 1u);
            else XB_SPIN(xb_ld(&bar[XB_TOPGEN]) == tg, bar);
            __builtin_amdgcn_fence(__ATOMIC_ACQUIRE, "agent");
            xb_add(&bar[XB_XGEN(b.x)], 1u);
            asm volatile("s_waitcnt vmcnt(0)" ::: "memory");
        } else {
            XB_SPIN(xb_ld(&bar[XB_XGEN(b.x)]) == gen, bar);
            __builtin_amdgcn_fence(__ATOMIC_ACQUIRE, "agent");
            asm volatile("s_waitcnt vmcnt(0)" ::: "memory");
        }
    }
    __syncthreads();
}

typedef const __attribute__((address_space(4))) Args* KArgs;
__device__ __forceinline__ KArgs kargs() { KArgs p = (KArgs)__builtin_amdgcn_kernarg_segment_ptr(); asm volatile("" : "+s"(p)); return p; }
struct Frame {
    LAS unsigned char* lds;
    KArgs K;
    int tid, lane, wave, blk, G, gw, ngw;
    __device__ __forceinline__ void renew() { K = kargs(); int t = threadIdx.x; asm volatile("" : "+v"(t)); tid = t; lane = t & 63; wave = __builtin_amdgcn_readfirstlane(t >> 6);
        int b = blockIdx.x, g = gridDim.x; asm volatile("" : "+s"(b), "+s"(g)); blk = b; G = g; gw = b * 8 + wave; ngw = g * 8; }
    __device__ __forceinline__ const float* in(int i) const { return K->in[i]; }
    __device__ __forceinline__ float* out() const { return K->out; }
    __device__ __forceinline__ unsigned char* ws() const { return K->ws; }
    __device__ __forceinline__ unsigned* ctl() const { return (unsigned*)(ws() + WS_CTL); }
    __device__ __forceinline__ float* mods() const { return (float*)(ws() + WS_MODS); }
    __device__ __forceinline__ float* ssp(int use) const { return (float*)(ws() + 2 * MiB + 512 * 1024) + (size_t)use * MT * 4; }
    __device__ __forceinline__ float* bias() const { return (float*)(ws() + WS_BIAS); }
    __device__ __forceinline__ float* rpbt() const { return (float*)(ws() + WS_RPB); }
    __device__ __forceinline__ int* tok() const { return (int*)(ws() + WS_TOK); }
    __device__ __forceinline__ bf16* wb(int j) const { return (bf16*)(ws() + WS_WB + (size_t)j * WB_STRIDE); }
    __device__ __forceinline__ float* H() const { return (float*)(ws() + WS_H); }
    __device__ __forceinline__ bf16* AF() const { return (bf16*)(ws() + WS_AF); }
    __device__ __forceinline__ bf16* Y1() const { return (bf16*)(ws() + WS_Y1); }
    __device__ __forceinline__ bf16* VT() const { return (bf16*)(ws() + WS_VT); }
    __device__ __forceinline__ bf16* YPAIR() const { return (bf16*)(ws() + WS_YPAIR); }
    __device__ __forceinline__ bf16* YPB() const { return (bf16*)(ws() + WS_YPB); }
    __device__ __forceinline__ bf16* BIG() const { return (bf16*)(ws() + WS_BIG); }
};
enum { I_X = 0, I_C, I_CTX, I_CCTX, I_WMOD, I_BMOD, I_GMIX, I_GFFN, I_GFINAL, I_WIN, I_CONVW, I_POOLW, I_POOLS, I_WOUT, I_WFG, I_WFU, I_WFD, I_WQKV, I_RPB, I_WONA, I_WR, I_WEG, I_WEU, I_WED };

__device__ __forceinline__ int row_bm(int row) { return row < ML ? (row >> 12) : 4; }

constexpr size_t WS_SSP = 2 * MiB + 512 * 1024;
struct NoCtx {};
struct ColCtx { f32x4 x[2][2]; };
struct RowColCtx { float r[8]; f32x4 x[2][2]; };
__device__ __forceinline__ void st4bf(bf16* p, f32x4 v) { u32x2 a; a.x = cvt_pk_bf16(v[0], v[1]); a.y = cvt_pk_bf16(v[2], v[3]); *(u32x2*)p = a; }
__device__ __forceinline__ float rstd_of(const float* SSP, int row) { const f32x4 s = *(const f32x4*)(SSP + (size_t)row * 4); return 1.0f / sqrtf(((s[0] + s[1]) + (s[2] + s[3])) * (1.0f / D) + EPS); }
#define UNIT_ROW(pm, wr, fr, ri) ((pm) * 256 + ((ri) >> 2) * 128 + (wr) * 64 + ((ri) & 3) * 16 + (fr))
#define UNIT_COL(pn, wc, fq, bj, n) ((pn) * 256 + (bj) * 128 + (wc) * 32 + (n) * 16 + 4 * (fq))
struct EpiStoreBf16 { bf16* O; int ldc; static constexpr bool UNIT_END = false; typedef NoCtx Ctx;
    __device__ __forceinline__ Ctx unit_ctx(int, int, int, int, int, int) const { return Ctx{}; }
    __device__ __forceinline__ void operator()(const Ctx&, int row, int col, int, int, f32x4 v0, f32x4 v1) const { bf16* p = O + (size_t)row * ldc + col; st4bf(p, v0); st4bf(p + 16, v1); } };
struct EpiDownK2 { bf16* Y0; bf16* Y1; static constexpr bool UNIT_END = false; typedef NoCtx Ctx;
    __device__ __forceinline__ Ctx unit_ctx(int, int, int, int, int, int) const { return Ctx{}; }
    __device__ __forceinline__ void operator()(const Ctx&, int row, int col, int, int, f32x4 v0, f32x4 v1) const {
        bf16* p = ((col >> 10) ? Y1 : Y0) + (size_t)row * 1024 + (col & 1023); st4bf(p, v0); st4bf(p + 16, v1); } };
struct EpiResGate { float* H; const float* gate; static constexpr bool UNIT_END = false; typedef ColCtx Ctx;
    __device__ __forceinline__ Ctx unit_ctx(int pm, int pn, int, int wc, int, int fq) const { Ctx c; const float* g = gate + row_bm(pm * 256) * 6144;
#pragma unroll
        for (int bj = 0; bj < 2; ++bj)
#pragma unroll
            for (int n = 0; n < 2; ++n) c.x[bj][n] = *(const f32x4*)(g + UNIT_COL(pn, wc, fq, bj, n));
        return c; }
    __device__ __forceinline__ void operator()(const Ctx& c, int row, int col, int, int bj, f32x4 v0, f32x4 v1) const {
        float* p = H + (size_t)row * D + col;
        *(f32x4*)p = *(const f32x4*)p + c.x[bj][0] * v0; *(f32x4*)(p + 16) = *(const f32x4*)(p + 16) + c.x[bj][1] * v1; } };
struct GateNormCtx { f32x4 g[2][2], G[2][2]; };
struct EpiResGateNorm { float* H; const float* gate; const float* gn; const float* scn  ; bf16* AFn; float* SSP; LAS float* part  ;
    static constexpr bool UNIT_END = true; typedef GateNormCtx Ctx;
    __device__ __forceinline__ Ctx unit_ctx(int pm, int pn, int, int wc, int, int fq) const { Ctx c; const int bm = row_bm(pm * 256);
#pragma unroll
        for (int bj = 0; bj < 2; ++bj)
#pragma unroll
            for (int n = 0; n < 2; ++n) { const int col = UNIT_COL(pn, wc, fq, bj, n); c.g[bj][n] = *(const f32x4*)(gate + bm * 6144 + col); c.G[bj][n] = *(const f32x4*)(gn + col) * (1.0f + *(const f32x4*)(scn + bm * 6144 + col)); }
        return c; }
    __device__ __forceinline__ void operator()(const Ctx& c, int row, int col, int, int bj, f32x4 v0, f32x4 v1) const {
        float* p = H + (size_t)row * D + col;
        const f32x4 h0 = *(const f32x4*)p + c.g[bj][0] * v0, h1 = *(const f32x4*)(p + 16) + c.g[bj][1] * v1;
        *(f32x4*)p = h0; *(f32x4*)(p + 16) = h1;
        bf16* q = AFn + (size_t)row * D + col; st4bf(q, h0 * c.G[bj][0]); st4bf(q + 16, h1 * c.G[bj][1]);
        float s = ((h0[0] * h0[0] + h0[1] * h0[1]) + (h0[2] * h0[2] + h0[3] * h0[3])) + ((h1[0] * h1[0] + h1[1] * h1[1]) + (h1[2] * h1[2] + h1[3] * h1[3]));
        s += __shfl_xor(s, 16); s += __shfl_xor(s, 32);
        if ((threadIdx.x & 48) == 0) part[(row & 255) * 8 + bj * 4 + ((col >> 5) & 3)] = s; }
    __device__ __forceinline__ void unit_end(int pm, int pn, int tid) const {
        if (tid < 256) { const LAS f32x4* q = (const LAS f32x4*)(part + tid * 8); const f32x4 a = q[0], b = q[1];
            SSP[(size_t)(pm * 256 + tid) * 4 + pn] = ((a[0] + a[1]) + (a[2] + a[3])) + ((b[0] + b[1]) + (b[2] + b[3])); } } };
struct EpiSwiGLU { bf16* O; int ldc; static constexpr bool UNIT_END = false; typedef NoCtx Ctx;
    __device__ __forceinline__ Ctx unit_ctx(int, int, int, int, int, int) const { return Ctx{}; }
    __device__ __forceinline__ void store(int row, int col, f32x4 v0, f32x4 v1) const {
        const int rc = ((col >> 5) << 4) + (col & 15);
        f32x4 r;
#pragma unroll
        for (int i = 0; i < 4; ++i) r[i] = silu_f(v0[i]) * v1[i];
        st4bf(O + (size_t)row * ldc + rc, r); }
    __device__ __forceinline__ void operator()(const Ctx&, int row, int col, int, int, f32x4 v0, f32x4 v1) const { store(row, col, v0, v1); } };
struct EpiSwiGLUNorm { bf16* O; int ldc; const float* SSP; const float* bias  ; static constexpr bool UNIT_END = false; typedef RowColCtx Ctx;
    __device__ __forceinline__ Ctx unit_ctx(int pm, int pn, int wr, int wc, int fr, int fq) const { Ctx c; const float* b = bias + row_bm(pm * 256) * 5632;
#pragma unroll
        for (int ri = 0; ri < 8; ++ri) c.r[ri] = rstd_of(SSP, UNIT_ROW(pm, wr, fr, ri));
#pragma unroll
        for (int bj = 0; bj < 2; ++bj)
#pragma unroll
            for (int n = 0; n < 2; ++n) c.x[bj][n] = *(const f32x4*)(b + UNIT_COL(pn, wc, fq, bj, n));
        return c; }
    __device__ __forceinline__ void operator()(const Ctx& c, int row, int col, int ri, int bj, f32x4 v0, f32x4 v1) const {
        EpiSwiGLU e{O, ldc}; e.store(row, col, v0 * c.r[ri] + c.x[bj][0], v1 * c.r[ri] + c.x[bj][1]); } };

struct MoeTiles {
    int c0, c1, c2, c3, c4, c5, c6, c7, total;
    __device__ __forceinline__ static int ld(const unsigned* p) { return __builtin_amdgcn_readfirstlane((int)__hip_atomic_load(p, __ATOMIC_RELAXED, __HIP_MEMORY_SCOPE_AGENT)); }
    __device__ __forceinline__ static int t(int c) { return (c + 255) >> 8; }
    __device__ __forceinline__ void init(const unsigned* cnt) { c0 = ld(cnt); c1 = ld(cnt + 1); c2 = ld(cnt + 2); c3 = ld(cnt + 3); c4 = ld(cnt + 4); c5 = ld(cnt + 5); c6 = ld(cnt + 6); c7 = ld(cnt + 7);
        total = t(c0) + t(c1) + t(c2) + t(c3) + t(c4) + t(c5) + t(c6) + t(c7); }
    __device__ __forceinline__ void tile_info(int tile, int& ex, int& pos0, int& count) const {
        int cum = 0, e = 0, first = 0, c = c0;
#define MT_STEP(k, ck, cn) cum += t(ck); if (tile >= cum) { e = k + 1; first = cum; c = cn; }
        MT_STEP(0, c0, c1) MT_STEP(1, c1, c2) MT_STEP(2, c2, c3) MT_STEP(3, c3, c4) MT_STEP(4, c4, c5) MT_STEP(5, c5, c6) MT_STEP(6, c6, c7)
#undef MT_STEP
        ex = e; pos0 = (tile - first) * 256; count = c; }
    __device__ __forceinline__ int expert_of_tile(int tile) const { int ex, pos0, count; tile_info(tile, ex, pos0, count); return ex; }
    __device__ __forceinline__ int row_offset(int ex) const {
        return ((ex > 0 ? t(c0) : 0) + (ex > 1 ? t(c1) : 0) + (ex > 2 ? t(c2) : 0) + (ex > 3 ? t(c3) : 0) + (ex > 4 ? t(c4) : 0) + (ex > 5 ? t(c5) : 0) + (ex > 6 ? t(c6) : 0)) * 256; }
};
namespace pg8 {
constexpr int BM = 256, BK = 64, HALF = 128, HTB = HALF * BK * 2, STAGE_BYTES = 8 * HTB, NXCD = 8, WGM = 8;
__host__ __device__ __forceinline__ int lds_byte(int r, int c) { const int st = (r >> 4) * 2 + (c >> 5), rr = r & 15, cc = c & 31, ob = rr * 64 + cc * 2; return st * 1024 + (ob ^ (((ob >> 9) & 1) << 5)); }
__host__ __device__ __forceinline__ void stage_rc(int b, int& R, int& C) { const int st = b / 1024, sb = b % 1024, swz = sb ^ (((sb >> 9) & 1) << 5); R = (st >> 1) * 16 + swz / 64; C = (st & 1) * 32 + (swz % 64) / 2; }
struct Unit { int pm, pn; };
__device__ __forceinline__ void tile_of(int L, int nwg, int nM, int nN, int& pm, int& pn) {
    int wgid = L; { const int q = nwg / NXCD, r = nwg % NXCD, xcd = wgid % NXCD, off = wgid / NXCD; wgid = (xcd < r ? xcd * (q + 1) : r * (q + 1) + (xcd - r) * q) + off; }
    const int nig = WGM * nN, gid = wgid / nig, fm = gid * WGM, gsz = (nM - fm) < WGM ? (nM - fm) : WGM;
    pm = fm + ((wgid % nig) % gsz); pn = (wgid % nig) / gsz;
}
struct SchedStatic {
    const char* A; const char* B; int nM, nN, nwg, G, c; size_t tstep;
    __device__ __forceinline__ void init(const bf16* A_, const bf16* B_, int M, int N, int K, int G_, int c_) { A = (const char*)A_; B = (const char*)B_; nM = M / BM; nN = N / BM; nwg = nM * nN; G = G_; c = c_; tstep = (size_t)BM * K * 2; }
    __device__ __forceinline__ bool next(int i, Unit& u) const { const int L = i * G + c; if (L >= nwg) return false; tile_of(L, nwg, nM, nN, u.pm, u.pn); return true; }
    __device__ __forceinline__ const char* a_base(const Unit& u) const { return A + (size_t)u.pm * tstep; }
    __device__ __forceinline__ const char* b_base(const Unit& u) const { return B + (size_t)u.pn * tstep; }
};
struct SchedQKVT {
    const char* AF; const char* WQK; const char* WV; int G, c; size_t tstep;
    static constexpr int NQK = 68 * 8, NVT = 4 * 68;
    __device__ __forceinline__ bool next(int i, Unit& u) const { const int L = i * G + c; if (L >= NQK + NVT) return false;
        int wgid = L; { const int nwg = NQK + NVT, q = nwg / NXCD, r = nwg % NXCD, xcd = wgid % NXCD, off = wgid / NXCD; wgid = (xcd < r ? xcd * (q + 1) : r * (q + 1) + (xcd - r) * q) + off; }
        if (wgid < NQK) { const int nig = WGM * 8, gid = wgid / nig, fm = gid * WGM, gsz = (68 - fm) < WGM ? (68 - fm) : WGM; u.pm = fm + ((wgid % nig) % gsz); u.pn = (wgid % nig) / gsz; }
        else { const int w = wgid - NQK; u.pm = 68 + (w & 3); u.pn = w >> 2; }
        return true; }
    __device__ __forceinline__ const char* a_base(const Unit& u) const { return u.pm < 68 ? AF + (size_t)u.pm * tstep : WV + (size_t)(u.pm - 68) * tstep; }
    __device__ __forceinline__ const char* b_base(const Unit& u) const { return u.pm < 68 ? WQK + (size_t)u.pn * tstep : AF + (size_t)u.pn * tstep; }
};
struct SchedMoe {
    const char* A; const char* B; const int* rowsrc; MoeTiles mt; int nN, nwg, G, c; size_t tstep, estride;
    __device__ __forceinline__ void init(const bf16* A_, const bf16* B_, size_t estride_elems, const unsigned* cnt, const int* rowsrc_, int N, int K, int G_, int c_) { A = (const char*)A_; B = (const char*)B_; rowsrc = rowsrc_; mt.init(cnt); nN = N / BM; nwg = mt.total * nN; G = G_; c = c_; tstep = (size_t)BM * K * 2; estride = estride_elems * 2; }
    __device__ __forceinline__ bool next(int i, Unit& u) const { const int L = i * G + c; if (L >= nwg) return false; tile_of(L, nwg, mt.total, nN, u.pm, u.pn); return true; }
    __device__ __forceinline__ const char* a_base(const Unit& u) const { return A + (size_t)u.pm * tstep; }
    __device__ __forceinline__ const char* b_base(const Unit& u) const { return B + (size_t)mt.expert_of_tile(u.pm) * estride + (size_t)u.pn * tstep; }
    __device__ __forceinline__ const char* a_matrix() const { return A; }
    __device__ __forceinline__ void rows_of(const Unit& u, const int (&r)[4], int (&row)[4]) const { int ex, pos0, count; mt.tile_info(u.pm, ex, pos0, count); const int* rs = rowsrc + (size_t)ex * MT + pos0;
#pragma unroll
        for (int q = 0; q < 4; ++q) row[q] = (pos0 + r[q] < count) ? rs[r[q]] : 0; }
};
constexpr int DOWN_KH = 1792;
struct SchedDownK2 {
    const char* A; const char* B; MoeTiles mt; int nwg, G, c; size_t tstep, estride;
    __device__ __forceinline__ void init(const bf16* A_, const bf16* B_, const unsigned* cnt, int G_, int c_) { A = (const char*)A_; B = (const char*)B_; mt.init(cnt); nwg = mt.total * 8; G = G_; c = c_; tstep = (size_t)BM * DFE * 2; estride = (size_t)1024 * DFE * 2; }
    __device__ __forceinline__ bool next(int i, Unit& u) const { const int L = i * G + c; if (L >= nwg) return false; tile_of(L, nwg, mt.total, 8, u.pm, u.pn); return true; }
    __device__ __forceinline__ const char* a_base(const Unit& u) const { return A + (size_t)u.pm * tstep + (size_t)(u.pn >> 2) * DOWN_KH * 2; }
    __device__ __forceinline__ const char* b_base(const Unit& u) const { return B + (size_t)mt.expert_of_tile(u.pm) * estride + (size_t)(u.pn & 3) * tstep + (size_t)(u.pn >> 2) * DOWN_KH * 2; }
};
template <class Epi>
__device__ __forceinline__ void epi_apply(const f32x4 (&acc)[2][2][4][2], const Unit& u, int wr, int wc, int fr, int fq, const Epi& E, int tid) {
    const typename Epi::Ctx ctx = E.unit_ctx(u.pm, u.pn, wr, wc, fr, fq);
#pragma unroll
    for (int ai = 0; ai < 2; ++ai)
#pragma unroll
        for (int m = 0; m < 4; ++m) { const int row = u.pm * BM + ai * HALF + wr * 64 + m * 16 + fr;
#pragma unroll
            for (int bj = 0; bj < 2; ++bj) E(ctx, row, u.pn * BM + bj * HALF + wc * 32 + 4 * fq, ai * 4 + m, bj, acc[ai][bj][m][0], acc[ai][bj][m][1]);
            if (m & 1) asm volatile("" ::: "memory"); }
    if constexpr (Epi::UNIT_END) {
        asm volatile("s_waitcnt lgkmcnt(0)" ::: "memory"); __builtin_amdgcn_s_barrier(); asm volatile("" ::: "memory");
        E.unit_end(u.pm, u.pn, tid);
    }
}
template <class Epi, class Sched>
__device__ __forceinline__ void gemm_phase(LAS unsigned char* lds, const int tid, const int K, const int LD  , const Sched& S, const Epi& E) {
    const int wid = __builtin_amdgcn_readfirstlane(tid >> 6), lane = tid & 63, wr = wid >> 2, wc = wid & 3, fr = lane & 15, fq = lane >> 4;
    const int nt = K / BK;
    unsigned voff[2];
#pragma unroll
    for (int i = 0; i < 2; ++i) { int R, C; stage_rc(tid * 16 + i * 8192, R, C); voff[i] = (unsigned)(R * LD + C) * 2u; }
    const size_t kstep = (size_t)(BK * 2);
    const size_t hstep = (size_t)HALF * LD * 2;
    const unsigned ldsw = (unsigned)wid * 1024u;
    const int aoff = lds_byte(wr * 64 + fr, fq * 8), boff = lds_byte(wc * 32 + fr, fq * 8);
#define PG8_SA(b, h) (((b) * 2 + (h)) * HTB)
#define PG8_SB(b, h) ((4 + (b) * 2 + (h)) * HTB)
#define PG8_STAGE(bufoff, gbase) do { _Pragma("unroll") for (int _i = 0; _i < 2; ++_i) \
        __builtin_amdgcn_global_load_lds((const unsigned*)((const char*)(gbase) + voff[_i]), (LAS unsigned*)(lds + (bufoff) + ldsw + _i * 8192), 16, 0, 0); } while (0)
#define PG8_LDA(dst, b, h) do { _Pragma("unroll") for (int m = 0; m < 4; ++m) _Pragma("unroll") for (int k = 0; k < 2; ++k) dst[m][k] = *(const LAS bf16x8*)(lds + PG8_SA(b, h) + aoff + m * 2048 + k * 1024); } while (0)
#define PG8_LDB(dst, b, h) do { _Pragma("unroll") for (int n = 0; n < 2; ++n) _Pragma("unroll") for (int k = 0; k < 2; ++k) dst[n][k] = *(const LAS bf16x8*)(lds + PG8_SB(b, h) + boff + n * 2048 + k * 1024); } while (0)
#define PG8_MMA(ai, bj, At, Bt) do { __builtin_amdgcn_s_setprio(1); _Pragma("unroll") for (int m = 0; m < 4; ++m) _Pragma("unroll") for (int n = 0; n < 2; ++n) _Pragma("unroll") for (int k = 0; k < 2; ++k) \
        acc[ai][bj][m][n] = __builtin_amdgcn_mfma_f32_16x16x32_bf16(Bt[n][k], At[m][k], acc[ai][bj][m][n], 0, 0, 0); __builtin_amdgcn_s_setprio(0); } while (0)
#define PG8_WAIT_V(n) asm volatile("s_waitcnt vmcnt(" #n ")" ::: "memory")
#define PG8_WAIT_L(n) asm volatile("s_waitcnt lgkmcnt(" #n ")" ::: "memory")
#define PG8_BAR __builtin_amdgcn_s_barrier()
#define PG8_SCHED __builtin_amdgcn_sched_barrier(0)
    Unit cur, nxt; int ui = 0;
    if (!S.next(0, cur)) return;
    f32x4 acc[2][2][4][2];
#pragma unroll
    for (int a = 0; a < 2; ++a)
#pragma unroll
        for (int b = 0; b < 2; ++b)
#pragma unroll
            for (int m = 0; m < 4; ++m)
#pragma unroll
                for (int n = 0; n < 2; ++n) acc[a][b][m][n] = (f32x4){0.f, 0.f, 0.f, 0.f};
    bf16x8 At[4][2], B0[2][2], B1[2][2];
    const char* cA = S.a_base(cur); const char* cB = S.b_base(cur);
    PG8_STAGE(PG8_SB(0, 0), cB); PG8_STAGE(PG8_SB(0, 1), cB + hstep); PG8_STAGE(PG8_SA(0, 0), cA); PG8_STAGE(PG8_SA(0, 1), cA + hstep);
    if (wr == 1) PG8_BAR;
    PG8_WAIT_V(2); PG8_BAR;
    PG8_STAGE(PG8_SB(1, 0), cB + kstep); PG8_STAGE(PG8_SA(1, 0), cA + kstep); PG8_STAGE(PG8_SB(1, 1), cB + hstep + kstep);
    PG8_WAIT_V(6); PG8_BAR;
    for (;;) {
        const bool has_next = S.next(ui + 1, nxt);
        const char* nA = has_next ? S.a_base(nxt) : cA; const char* nB = has_next ? S.b_base(nxt) : cB;
        for (int t = 0; t < nt; t += 2) {
            const bool last = (t == nt - 2);
            const char* a1 = cA + (size_t)(t + 1) * kstep;
            const char* a2 = last ? nA : cA + (size_t)(t + 2) * kstep; const char* b2 = last ? nB : cB + (size_t)(t + 2) * kstep;
            const char* a3 = a2 + kstep; const char* b3 = b2 + kstep;
            PG8_LDB(B0, 0, 0); PG8_LDB(B1, 0, 1); PG8_SCHED; PG8_LDA(At, 0, 0); PG8_STAGE(PG8_SA(1, 1), a1 + hstep);
            PG8_WAIT_V(8); PG8_WAIT_L(0); PG8_BAR; PG8_MMA(0, 0, At, B0); PG8_MMA(0, 1, At, B1); PG8_BAR; PG8_SCHED;
            PG8_LDA(At, 0, 1); PG8_STAGE(PG8_SB(0, 0), b2); PG8_STAGE(PG8_SB(0, 1), b2 + hstep); PG8_STAGE(PG8_SA(0, 0), a2);
            PG8_WAIT_V(8); PG8_WAIT_L(0); PG8_BAR; PG8_MMA(1, 0, At, B0); PG8_MMA(1, 1, At, B1); PG8_BAR; PG8_SCHED;
            PG8_LDB(B0, 1, 0); PG8_LDB(B1, 1, 1); PG8_SCHED; PG8_LDA(At, 1, 0); PG8_STAGE(PG8_SA(0, 1), a2 + hstep);
            PG8_WAIT_V(8); PG8_WAIT_L(0); PG8_BAR; PG8_MMA(0, 0, At, B0); PG8_MMA(0, 1, At, B1); PG8_BAR; PG8_SCHED;
            PG8_LDA(At, 1, 1); PG8_STAGE(PG8_SB(1, 0), b3); PG8_STAGE(PG8_SB(1, 1), b3 + hstep); PG8_STAGE(PG8_SA(1, 0), a3);
            PG8_WAIT_V(8); PG8_WAIT_L(0); PG8_BAR; PG8_MMA(1, 0, At, B0); PG8_MMA(1, 1, At, B1); PG8_BAR; PG8_SCHED;
        }
        if (wr == 0) PG8_BAR;
        epi_apply(acc, cur, wr, wc, fr, fq, E, tid);
        if (!has_next) break;
#pragma unroll
        for (int a = 0; a < 2; ++a)
#pragma unroll
            for (int b = 0; b < 2; ++b)
#pragma unroll
                for (int m = 0; m < 4; ++m)
#pragma unroll
                    for (int n = 0; n < 2; ++n) acc[a][b][m][n] = (f32x4){0.f, 0.f, 0.f, 0.f};
        cur = nxt; cA = nA; cB = nB; ++ui;
        if (wr == 1) PG8_BAR;
    }
    PG8_WAIT_V(0);
    PG8_BAR;
#undef PG8_SA
#undef PG8_SB
#undef PG8_STAGE
#undef PG8_LDA
#undef PG8_LDB
#undef PG8_MMA
#undef PG8_WAIT_V
#undef PG8_WAIT_L
#undef PG8_BAR
#undef PG8_SCHED
}
template <class Epi, class Sched>
__device__ __forceinline__ void gemm_phase_gather(LAS unsigned char* lds, const int tid, const int K, const int LD, const Sched& S, const Epi& E) {
    const int wid = __builtin_amdgcn_readfirstlane(tid >> 6), lane = tid & 63, wr = wid >> 2, wc = wid & 3, fr = lane & 15, fq = lane >> 4;
    const int nt = K / BK;
    unsigned voff[2];
#pragma unroll
    for (int i = 0; i < 2; ++i) { int R, C; stage_rc(tid * 16 + i * 8192, R, C); voff[i] = (unsigned)(R * LD + C) * 2u; }
    int rloc[4];
#pragma unroll
    for (int i = 0; i < 2; ++i) { int R, C; stage_rc(tid * 16 + i * 8192, R, C); rloc[i] = R; rloc[2 + i] = HALF + R; }
    unsigned vc[2][2], vn[2][2];
    const char* Am = S.a_matrix();
#define PG8_OFFS(dst, u) do { int _row[4]; S.rows_of(u, rloc, _row); _Pragma("unroll") for (int _h = 0; _h < 2; ++_h) _Pragma("unroll") for (int _i = 0; _i < 2; ++_i) \
        dst[_h][_i] = (unsigned)_row[2 * _h + _i] * (unsigned)(LD * 2) + (voff[_i] - (unsigned)(rloc[_i] * LD * 2)); } while (0)
#define PG8_STAGE_A(bufoff, koff, v) do { _Pragma("unroll") for (int _i = 0; _i < 2; ++_i) \
        __builtin_amdgcn_global_load_lds((const unsigned*)(Am + (koff) + (v)[_i]), (LAS unsigned*)(lds + (bufoff) + ldsw + _i * 8192), 16, 0, 0); } while (0)
    const size_t kstep = (size_t)(BK * 2);
    const size_t hstep = (size_t)HALF * LD * 2;
    const unsigned ldsw = (unsigned)wid * 1024u;
    const int aoff = lds_byte(wr * 64 + fr, fq * 8), boff = lds_byte(wc * 32 + fr, fq * 8);
#define PG8_SA(b, h) (((b) * 2 + (h)) * HTB)
#define PG8_SB(b, h) ((4 + (b) * 2 + (h)) * HTB)
#define PG8_STAGE(bufoff, gbase) do { _Pragma("unroll") for (int _i = 0; _i < 2; ++_i) \
        __builtin_amdgcn_global_load_lds((const unsigned*)((const char*)(gbase) + voff[_i]), (LAS unsigned*)(lds + (bufoff) + ldsw + _i * 8192), 16, 0, 0); } while (0)
#define PG8_LDA(dst, b, h) do { _Pragma("unroll") for (int m = 0; m < 4; ++m) _Pragma("unroll") for (int k = 0; k < 2; ++k) dst[m][k] = *(const LAS bf16x8*)(lds + PG8_SA(b, h) + aoff + m * 2048 + k * 1024); } while (0)
#define PG8_LDB(dst, b, h) do { _Pragma("unroll") for (int n = 0; n < 2; ++n) _Pragma("unroll") for (int k = 0; k < 2; ++k) dst[n][k] = *(const LAS bf16x8*)(lds + PG8_SB(b, h) + boff + n * 2048 + k * 1024); } while (0)
#define PG8_MMA(ai, bj, At, Bt) do { __builtin_amdgcn_s_setprio(1); _Pragma("unroll") for (int m = 0; m < 4; ++m) _Pragma("unroll") for (int n = 0; n < 2; ++n) _Pragma("unroll") for (int k = 0; k < 2; ++k) \
        acc[ai][bj][m][n] = __builtin_amdgcn_mfma_f32_16x16x32_bf16(Bt[n][k], At[m][k], acc[ai][bj][m][n], 0, 0, 0); __builtin_amdgcn_s_setprio(0); } while (0)
#define PG8_WAIT_V(n) asm volatile("s_waitcnt vmcnt(" #n ")" ::: "memory")
#define PG8_WAIT_L(n) asm volatile("s_waitcnt lgkmcnt(" #n ")" ::: "memory")
#define PG8_BAR __builtin_amdgcn_s_barrier()
#define PG8_SCHED __builtin_amdgcn_sched_barrier(0)
    Unit cur, nxt; int ui = 0;
    if (!S.next(0, cur)) return;
    f32x4 acc[2][2][4][2];
#pragma unroll
    for (int a = 0; a < 2; ++a)
#pragma unroll
        for (int b = 0; b < 2; ++b)
#pragma unroll
            for (int m = 0; m < 4; ++m)
#pragma unroll
                for (int n = 0; n < 2; ++n) acc[a][b][m][n] = (f32x4){0.f, 0.f, 0.f, 0.f};
    bf16x8 At[4][2], B0[2][2], B1[2][2];
    const char* cB = S.b_base(cur);
    PG8_OFFS(vc, cur);
    PG8_STAGE(PG8_SB(0, 0), cB); PG8_STAGE(PG8_SB(0, 1), cB + hstep); PG8_STAGE_A(PG8_SA(0, 0), 0, vc[0]); PG8_STAGE_A(PG8_SA(0, 1), 0, vc[1]);
    if (wr == 1) PG8_BAR;
    PG8_WAIT_V(2); PG8_BAR;
    PG8_STAGE(PG8_SB(1, 0), cB + kstep); PG8_STAGE_A(PG8_SA(1, 0), kstep, vc[0]); PG8_STAGE(PG8_SB(1, 1), cB + hstep + kstep);
    PG8_WAIT_V(6); PG8_BAR;
    for (;;) {
        const bool has_next = S.next(ui + 1, nxt);
        const char* nB = has_next ? S.b_base(nxt) : cB;
        if (has_next) PG8_OFFS(vn, nxt); else {
#pragma unroll
            for (int _h = 0; _h < 2; ++_h)
#pragma unroll
                for (int _i = 0; _i < 2; ++_i) vn[_h][_i] = vc[_h][_i]; }
        for (int t = 0; t < nt; t += 2) {
            const bool last = (t == nt - 2);
            const size_t k1 = (size_t)(t + 1) * kstep, k2 = last ? 0 : (size_t)(t + 2) * kstep, k3 = k2 + kstep;
            const char* b2 = last ? nB : cB + (size_t)(t + 2) * kstep; const char* b3 = b2 + kstep;
            unsigned w0[2], w1[2];
#pragma unroll
            for (int _i = 0; _i < 2; ++_i) { w0[_i] = last ? vn[0][_i] : vc[0][_i]; w1[_i] = last ? vn[1][_i] : vc[1][_i]; }
            PG8_LDB(B0, 0, 0); PG8_LDB(B1, 0, 1); PG8_SCHED; PG8_LDA(At, 0, 0); PG8_STAGE_A(PG8_SA(1, 1), k1, vc[1]);
            PG8_WAIT_V(8); PG8_WAIT_L(0); PG8_BAR; PG8_MMA(0, 0, At, B0); PG8_MMA(0, 1, At, B1); PG8_BAR; PG8_SCHED;
            PG8_LDA(At, 0, 1); PG8_STAGE(PG8_SB(0, 0), b2); PG8_STAGE(PG8_SB(0, 1), b2 + hstep); PG8_STAGE_A(PG8_SA(0, 0), k2, w0);
            PG8_WAIT_V(8); PG8_WAIT_L(0); PG8_BAR; PG8_MMA(1, 0, At, B0); PG8_MMA(1, 1, At, B1); PG8_BAR; PG8_SCHED;
            PG8_LDB(B0, 1, 0); PG8_LDB(B1, 1, 1); PG8_SCHED; PG8_LDA(At, 1, 0); PG8_STAGE_A(PG8_SA(0, 1), k2, w1);
            PG8_WAIT_V(8); PG8_WAIT_L(0); PG8_BAR; PG8_MMA(0, 0, At, B0); PG8_MMA(0, 1, At, B1); PG8_BAR; PG8_SCHED;
            PG8_LDA(At, 1, 1); PG8_STAGE(PG8_SB(1, 0), b3); PG8_STAGE(PG8_SB(1, 1), b3 + hstep); PG8_STAGE_A(PG8_SA(1, 0), k3, w0);
            PG8_WAIT_V(8); PG8_WAIT_L(0); PG8_BAR; PG8_MMA(1, 0, At, B0); PG8_MMA(1, 1, At, B1); PG8_BAR; PG8_SCHED;
        }
        if (wr == 0) PG8_BAR;
        epi_apply(acc, cur, wr, wc, fr, fq, E, tid);
        if (!has_next) break;
#pragma unroll
        for (int a = 0; a < 2; ++a)
#pragma unroll
            for (int b = 0; b < 2; ++b)
#pragma unroll
                for (int m = 0; m < 4; ++m)
#pragma unroll
                    for (int n = 0; n < 2; ++n) acc[a][b][m][n] = (f32x4){0.f, 0.f, 0.f, 0.f};
        cur = nxt; cB = nB; ++ui;
#pragma unroll
        for (int _h = 0; _h < 2; ++_h)
#pragma unroll
            for (int _i = 0; _i < 2; ++_i) vc[_h][_i] = vn[_h][_i];
        if (wr == 1) PG8_BAR;
    }
    PG8_WAIT_V(0);
    PG8_BAR;
#undef PG8_OFFS
#undef PG8_STAGE_A
#undef PG8_SA
#undef PG8_SB
#undef PG8_STAGE
#undef PG8_LDA
#undef PG8_LDB
#undef PG8_MMA
#undef PG8_WAIT_V
#undef PG8_WAIT_L
#undef PG8_BAR
#undef PG8_SCHED
}
}
struct EpiQKVT { bf16* QB; bf16* KH; bf16* VT8; const float* SSP; const float* bias  ;
    static constexpr bool UNIT_END = false; typedef RowColCtx Ctx;
    __device__ __forceinline__ Ctx unit_ctx(int pm, int pn, int wr, int wc, int fr, int fq) const { Ctx c;
        if (pm < 68) { const float* b = bias + row_bm(pm * 256) * 3072;
#pragma unroll
            for (int ri = 0; ri < 8; ++ri) c.r[ri] = rstd_of(SSP, UNIT_ROW(pm, wr, fr, ri));
#pragma unroll
            for (int bj = 0; bj < 2; ++bj)
#pragma unroll
                for (int n = 0; n < 2; ++n) c.x[bj][n] = *(const f32x4*)(b + UNIT_COL(pn, wc, fq, bj, n));
        } else { const float* b = bias + row_bm(pn * 256) * 3072 + 2048;
#pragma unroll
            for (int ri = 0; ri < 8; ++ri) c.r[ri] = b[UNIT_ROW(pm - 68, wr, fr, ri)];
#pragma unroll
            for (int bj = 0; bj < 2; ++bj)
#pragma unroll
                for (int n = 0; n < 2; ++n)
#pragma unroll
                    for (int i = 0; i < 4; ++i) c.x[bj][n][i] = rstd_of(SSP, UNIT_COL(pn, wc, fq, bj, n) + i);
        }
        return c; }
    __device__ __forceinline__ void operator()(const Ctx& c, int row, int col, int ri, int bj, f32x4 v0, f32x4 v1) const {
        if (row < MT) {
            v0 = v0 * c.r[ri] + c.x[bj][0]; v1 = v1 * c.r[ri] + c.x[bj][1];
            if (col < 1024) { bf16* p = QB + (size_t)row * 1024 + col; st4bf(p, v0 * QSCALE); st4bf(p + 16, v1 * QSCALE); }
            else { const int cc = col - 1024, h = cc >> 6, d = cc & 63; bf16* p = KH + ((size_t)h * MT + row) * 64 + d; st4bf(p, v0); st4bf(p + 16, v1); }
        } else {
            const int ch = row - MT, h = ch >> 6, d = ch & 63;
            v0 = v0 * c.x[bj][0] + c.r[ri]; v1 = v1 * c.x[bj][1] + c.r[ri];
            bf16* p = VT8 + (((size_t)h * (MT / 8) + (col >> 3)) * 64 + d) * 8 + (col & 7); st4bf(p, v0);
            bf16* q = VT8 + (((size_t)h * (MT / 8) + ((col + 16) >> 3)) * 64 + d) * 8 + (col & 7); st4bf(q, v1);
        } } };

__device__ __forceinline__ void mods_phase(const Frame& F) {
    LAS float* sl = (LAS float*)F.lds;
    LAS float* red = sl + 5 * 1024;
    const int tid = F.tid;
    for (int i = tid; i < 5 * 1024; i += 512) { const int b = i >> 10, k = i & 1023; const float v = b < 4 ? F.in(I_C)[b * 1024 + k] : F.in(I_CCTX)[k]; sl[i] = v / (1.f + expf(-v)); }
    __syncthreads();
    const int l16 = tid & 15, kg = tid >> 4;
    for (int it = F.blk; it < 4 * 96; it += F.G) {
        const int layer = it / 96, cc = it % 96;
        const float* W = F.in(I_WMOD) + (size_t)layer * 1024 * 6144 + cc * 64 + l16 * 4;
        f32x4 acc[5];
#pragma unroll
        for (int b = 0; b < 5; ++b) acc[b] = (f32x4){0.f, 0.f, 0.f, 0.f};
#pragma unroll 8
        for (int kk = 0; kk < 32; ++kk) { const int k = kg * 32 + kk; const f32x4 w = *(const f32x4*)(W + (size_t)k * 6144);
#pragma unroll
            for (int b = 0; b < 5; ++b) acc[b] += sl[b * 1024 + k] * w; }
#pragma unroll
        for (int b = 0; b < 5; ++b) *(LAS f32x4*)(red + ((kg * 5 + b) * 64 + l16 * 4)) = acc[b];
        __syncthreads();
        if (tid < 320) { const int b = tid >> 6, col = tid & 63; float s = 0.f;
            for (int g = 0; g < 32; ++g) s += red[(g * 5 + b) * 64 + col];
            F.mods()[((size_t)layer * 5 + b) * 6144 + cc * 64 + col] = s + F.in(I_BMOD)[layer * 6144 + cc * 64 + col]; }
        __syncthreads();
    }
}
__device__ __forceinline__ void rpb_phase(const Frame& F) {
    const int gt = F.blk * 512 + F.tid, ngt = F.G * 512;
    for (int i = gt; i < 2 * 16 * 15 * 64; i += ngt) { const int c = i & 63, r = (i >> 6) % 15, h = (i / (64 * 15)) & 15, jj = i / (64 * 15 * 16);
        const int dc = c - 32; float v = 0.f; if (dc >= -15 && dc <= 15) v = F.in(I_RPB)[((size_t)(jj * 16 + h) * 15 + r) * 31 + dc + 15] * LOG2E;
        F.rpbt()[i] = v; }
}
__device__ __forceinline__ void poolfold_phase(const Frame& F, int j) {
    const float* pw = F.in(I_POOLW) + (size_t)j * 4 * 128 * 128; const float* ps = F.in(I_POOLS) + (size_t)j * 512; const float* wo = F.in(I_WOUT) + (size_t)j * 1024 * 1024 + (size_t)512 * 1024;
    bf16* dst = F.wb(j) + WB_WOUT;
    const int gt = F.blk * 512 + F.tid, ngt = F.G * 512;
    for (int it = gt; it < 4 * 32 * 1024; it += ngt) {
        const int n = it & 1023, c4 = (it >> 10) & 31, g = it >> 15;
        const float* pr = pw + ((size_t)g * 128 + c4 * 4) * 128; const float* wr = wo + (size_t)g * 128 * 1024 + n; const float* sr = ps + g * 128;
        float acc[4] = {0.f, 0.f, 0.f, 0.f};
#pragma unroll 4
        for (int d = 0; d < 128; ++d) { const float w = wr[(size_t)d * 1024] * sr[d];
#pragma unroll
            for (int q = 0; q < 4; ++q) acc[q] += pr[q * 128 + d] * w; }
        u32x2 o; o.x = cvt_pk_bf16(acc[0], acc[1]); o.y = cvt_pk_bf16(acc[2], acc[3]);
        *(u32x2*)(dst + (size_t)n * 1024 + 512 + g * 128 + c4 * 4) = o;
    }
}
__device__ __forceinline__ void bias_phase(const Frame& F, int j) {
    const int lane = F.lane;
    for (int it = F.gw; it < 5632 + 3072; it += F.ngw) {
        const bool gu = it < 5632; const int n = gu ? it : it - 5632;
        const bf16* wrow = F.wb(j) + (gu ? WB_WGU : WB_WQKV) + (size_t)n * 1024;
        const float* sh = F.mods() + (size_t)(gu ? 2 * j : 2 * j + 1) * 5 * 6144 + (gu ? 3 * 1024 : 0);
        float w[16];
#pragma unroll
        for (int jj = 0; jj < 2; ++jj) { const bf16x8 v = *(const bf16x8*)(wrow + 8 * lane + 512 * jj);
#pragma unroll
            for (int e = 0; e < 8; ++e) w[8 * jj + e] = bf2f(v[e]); }
        float* out = F.bias() + (gu ? BIAS_GU + (size_t)j * 5 * 5632 : BIAS_QKV + (size_t)j * 5 * 3072);
#pragma unroll
        for (int bm = 0; bm < 5; ++bm) { float s = 0.f;
#pragma unroll
            for (int jj = 0; jj < 2; ++jj) { const f32x4 a = *(const f32x4*)(sh + bm * 6144 + 8 * lane + 512 * jj), b = *(const f32x4*)(sh + bm * 6144 + 8 * lane + 512 * jj + 4);
                s += (a[0] * w[8 * jj] + a[1] * w[8 * jj + 1]) + (a[2] * w[8 * jj + 2] + a[3] * w[8 * jj + 3]) + (b[0] * w[8 * jj + 4] + b[1] * w[8 * jj + 5]) + (b[2] * w[8 * jj + 6] + b[3] * w[8 * jj + 7]); }
            s = wave_sum(s);
            if (lane == 0) out[bm * (gu ? 5632 : 3072) + n] = s; }
    }
}
__device__ __forceinline__ void conv_tile(const float* src, int ldn, bf16* dst, int pitch, int k0, int n0, int mode, LAS unsigned* T, int lane) {
    const int c4 = (lane & 15) * 4;
#pragma unroll
    for (int it = 0; it < 8; ++it) { const int r = it * 4 + (lane >> 4);
        const f32x4 a = __builtin_nontemporal_load((const f32x4*)(src + (size_t)(k0 + 2 * r) * ldn + n0 + c4)), b = __builtin_nontemporal_load((const f32x4*)(src + (size_t)(k0 + 2 * r + 1) * ldn + n0 + c4));
#pragma unroll
        for (int c = 0; c < 4; ++c) T[(c4 + c) * 33 + r] = cvt_pk_bf16(a[c], b[c]); }
    asm volatile("s_waitcnt lgkmcnt(0)" ::: "memory");
#pragma unroll
    for (int it = 0; it < 8; ++it) { const int n = it * 8 + (lane >> 3), q = lane & 7; const int gn = n0 + n;
        const int drow = mode == 0 ? gn : ((gn >> 4) << 5) + (gn & 15) + (mode == 2 ? 16 : 0);
        u32x4 v; v.x = T[n * 33 + 4 * q]; v.y = T[n * 33 + 4 * q + 1]; v.z = T[n * 33 + 4 * q + 2]; v.w = T[n * 33 + 4 * q + 3];
        __builtin_nontemporal_store(v, (u32x4*)(dst + (size_t)drow * pitch + k0 + 8 * q)); }
    asm volatile("s_waitcnt lgkmcnt(0)" ::: "memory");
}
constexpr int CT0 = 512, CT1 = CT0 + 128, CT2 = CT1 + 704, CT3 = CT2 + 704, CT4 = CT3 + 704, CT5 = CT4 + 768, CT6 = CT5 + 256, CT7 = CT6 + 7168, CT8 = CT7 + 7168, CT9 = CT8 + 7168;
constexpr int CQ_P0M = CT9 - CT6, CQ_P1D = CQ_P0M + CT6, CQ_END = CQ_P1D + (CT9 - CT6);
static_assert(CQ_P0M % 8 == 0 && CQ_P1D % 8 == 0 && CQ_END % 8 == 0, "queue chunks");
__device__ __forceinline__ void conv_item(const Frame& F, int j, int it, LAS unsigned* T) {
    const float* src; int K, N, mode = 0, r; bf16* dst; size_t se = 0, de = 0; int tpe;
    if (it < CT0)      { r = it;       src = F.in(I_WIN) + (size_t)j * 1024 * 2048;  K = 1024; N = 2048; dst = F.wb(j) + WB_WIN; tpe = CT0; }
    else if (it < CT1) { r = it - CT0; src = F.in(I_WOUT) + (size_t)j * 1024 * 1024; K = 1024; N = 1024; dst = F.wb(j) + WB_WOUT; tpe = 128; }
    else if (it < CT2) { r = it - CT1; src = F.in(I_WFG) + (size_t)j * 1024 * DFF;   K = 1024; N = DFF; dst = F.wb(j) + WB_WGU; mode = 1; tpe = 704; }
    else if (it < CT3) { r = it - CT2; src = F.in(I_WFU) + (size_t)j * 1024 * DFF;   K = 1024; N = DFF; dst = F.wb(j) + WB_WGU; mode = 2; tpe = 704; }
    else if (it < CT4) { r = it - CT3; src = F.in(I_WFD) + (size_t)j * DFF * 1024;   K = DFF; N = 1024; dst = F.wb(j) + WB_WD; tpe = 704; }
    else if (it < CT5) { r = it - CT4; src = F.in(I_WQKV) + (size_t)j * 1024 * 3072; K = 1024; N = 3072; dst = F.wb(j) + WB_WQKV; tpe = 768; }
    else if (it < CT6) { r = it - CT5; src = F.in(I_WONA) + (size_t)j * 1024 * 1024; K = 1024; N = 1024; dst = F.wb(j) + WB_WO; tpe = 256; }
    else if (it < CT7) { r = it - CT6; src = F.in(I_WEG) + (size_t)j * NE * 1024 * DFE; K = 1024; N = DFE; dst = F.wb(j) + WB_WEGU; mode = 1; tpe = 896; se = (size_t)1024 * DFE; de = (size_t)7168 * 1024; }
    else if (it < CT8) { r = it - CT7; src = F.in(I_WEU) + (size_t)j * NE * 1024 * DFE; K = 1024; N = DFE; dst = F.wb(j) + WB_WEGU; mode = 2; tpe = 896; se = (size_t)1024 * DFE; de = (size_t)7168 * 1024; }
    else               { r = it - CT8; src = F.in(I_WED) + (size_t)j * NE * DFE * 1024; K = DFE; N = 1024; dst = F.wb(j) + WB_WED; tpe = 896; se = (size_t)DFE * 1024; de = (size_t)1024 * DFE; }
    const int e = r / tpe, rr = r % tpe, nb = N / 64, kb = rr / nb, nbi = rr % nb;
    conv_tile(src + e * se, N, dst + e * de, K, kb * 64, nbi * 64, mode, T, F.lane);
}
__device__ __forceinline__ void conv_dense0(const Frame& F) {
    LAS unsigned* T = (LAS unsigned*)(F.lds + F.wave * 8448);
    for (int it = F.gw; it < CT6; it += F.ngw) conv_item(F, 0, it, T);
}
__device__ __forceinline__ void conv_queue(const Frame& F, int limit, int max_chunks) {
    LAS unsigned* T = (LAS unsigned*)(F.lds + F.wave * 8448);
    volatile LAS int* qslot = (volatile LAS int*)(F.lds + 8 * 8448);
    unsigned* head = F.ctl() + CW_QHEAD;
    for (int n = 0; n < max_chunks; ++n) {
        __syncthreads();
        if (F.tid == 0) { int v = -1; if ((int)__hip_atomic_load(head, __ATOMIC_RELAXED, __HIP_MEMORY_SCOPE_AGENT) < limit) v = (int)__hip_atomic_fetch_add(head, 8u, __ATOMIC_RELAXED, __HIP_MEMORY_SCOPE_AGENT); *qslot = v; }
        __syncthreads();
        const int q0 = *qslot;
        if (q0 < 0 || q0 >= CQ_END) break;
        const int q = q0 + F.wave;
        if (q < CQ_P0M) conv_item(F, 0, CT6 + q, T); else if (q < CQ_P1D) conv_item(F, 1, q - CQ_P0M, T); else conv_item(F, 1, CT6 + (q - CQ_P1D), T);
    }
    __syncthreads();
}
__device__ __forceinline__ bool tail_idle(int nwg, int G, int c) { const int mine = c < nwg ? (nwg - c + G - 1) / G : 0; return mine < (nwg + G - 1) / G; }

__device__ __forceinline__ f32x4 bf4_to_f32(u32x2 u) { return (f32x4){__uint_as_float(u.x << 16), __uint_as_float(u.x & 0xffff0000u), __uint_as_float(u.y << 16), __uint_as_float(u.y & 0xffff0000u)}; }
__device__ __forceinline__ f32x4 moe_row4(const Frame& F, int rr, int c) {
    return bf4_to_f32(*(const u32x2*)(F.YPAIR() + (size_t)rr * D + c)) + bf4_to_f32(*(const u32x2*)(F.YPB() + (size_t)rr * D + c));
}
template <bool FIRST, bool COMBINE, bool ROUTER, bool FINAL>
__device__ __forceinline__ void norm_phase(const Frame& F, int Mrows, const float* g, const float* modbase  , int shift_idx, const float* prev_gate  ,
                                           const float* wr  , unsigned* cnt  ) {
    const int lane = F.lane;
    int2* tok_e = (int2*)F.tok(); int2* tok_pos = tok_e + MT; float2* tok_w = (float2*)(tok_pos + MT); int* rowsrc = (int*)(F.ws() + WS_TOK + 2 * MiB);
    constexpr int NR = 2;
    LAS int* lcnt = (LAS int*)F.lds; LAS int* lbase = lcnt + 8; LAS int* rec = lcnt + 16 + F.wave * 64;
    int nrec = 0;
    if (ROUTER) { if (F.tid < 8) lcnt[F.tid] = 0; __syncthreads(); }
    MoeTiles mtc; if (COMBINE) mtc.init(cnt);
    for (int row0 = F.gw * NR; row0 < Mrows; row0 += F.ngw * NR) {
        f32x4 v[NR][4];
#pragma unroll
        for (int q = 0; q < NR; ++q) { const int row = row0 + q;
            const float* src = FIRST ? (row < ML ? F.in(I_X) + (size_t)row * D : F.in(I_CTX) + (size_t)(row - ML) * D) : F.H() + (size_t)row * D;
#pragma unroll
            for (int jj = 0; jj < 4; ++jj) v[q][jj] = *(const f32x4*)(src + 4 * lane + 256 * jj); }
        if (COMBINE) {
#pragma unroll
            for (int q = 0; q < NR; ++q) { const int row = row0 + q; const int bm = row_bm(row);
                const int2 ee = tok_e[row], pp = tok_pos[row]; const int2 rr = make_int2(mtc.row_offset(ee.x) + pp.x, mtc.row_offset(ee.y) + pp.y); const float2 ww = tok_w[row];
                const float* pg = prev_gate + bm * 6144;
#pragma unroll
                for (int jj = 0; jj < 4; ++jj) { const int c = 4 * lane + 256 * jj; const f32x4 gg = *(const f32x4*)(pg + c);
                    const f32x4 a = moe_row4(F, rr.x, c), b = moe_row4(F, rr.y, c);
                    v[q][jj] += gg * (ww.x * a + ww.y * b); } }
        }
#pragma unroll
        for (int q = 0; q < NR; ++q) {
            const int row = row0 + q; const int bm = row_bm(row);
            if ((FIRST || COMBINE) && !FINAL) {
#pragma unroll
                for (int jj = 0; jj < 4; ++jj) *(f32x4*)(F.H() + (size_t)row * D + 4 * lane + 256 * jj) = v[q][jj];
            }
            float ss = 0.f;
#pragma unroll
            for (int jj = 0; jj < 4; ++jj) ss += (v[q][jj][0] * v[q][jj][0] + v[q][jj][1] * v[q][jj][1]) + (v[q][jj][2] * v[q][jj][2] + v[q][jj][3] * v[q][jj][3]);
            ss = wave_sum(ss);
            const float rstd = 1.0f / sqrtf(ss * (1.0f / D) + EPS);
            if (FINAL) {
#pragma unroll
                for (int jj = 0; jj < 4; ++jj) { const int c = 4 * lane + 256 * jj; *(f32x4*)(F.out() + (size_t)row * D + c) = v[q][jj] * rstd * *(const f32x4*)(g + c); }
                continue;
            }
            const float* sh = modbase + bm * 6144 + shift_idx * 1024; const float* sc = sh + 1024;
            float lg[NE];
#pragma unroll
            for (int e = 0; e < NE; ++e) lg[e] = 0.f;
#pragma unroll
            for (int jj = 0; jj < 4; ++jj) { const int c = 4 * lane + 256 * jj;
                const f32x4 y = v[q][jj] * rstd * *(const f32x4*)(g + c);
                const f32x4 a = y * (1.0f + *(const f32x4*)(sc + c)) + *(const f32x4*)(sh + c);
                u32x2 w; w.x = cvt_pk_bf16(a[0], a[1]); w.y = cvt_pk_bf16(a[2], a[3]);
                *(u32x2*)(F.AF() + (size_t)row * D + c) = w;
                if (ROUTER) {
#pragma unroll
                    for (int i = 0; i < 4; ++i) { const f32x4 w0 = *(const f32x4*)(wr + (size_t)(c + i) * 8), w1 = *(const f32x4*)(wr + (size_t)(c + i) * 8 + 4);
                        lg[0] += a[i] * w0[0]; lg[1] += a[i] * w0[1]; lg[2] += a[i] * w0[2]; lg[3] += a[i] * w0[3]; lg[4] += a[i] * w1[0]; lg[5] += a[i] * w1[1]; lg[6] += a[i] * w1[2]; lg[7] += a[i] * w1[3]; }
                }
            }
            if (ROUTER) {
#pragma unroll
                for (int e = 0; e < NE; ++e) lg[e] = wave_sum(lg[e]);
                int e0 = 0; float v0 = lg[0];
#pragma unroll
                for (int e = 1; e < NE; ++e) if (lg[e] > v0) { v0 = lg[e]; e0 = e; }
                int e1 = -1; float v1 = -3.0e38f;
#pragma unroll
                for (int e = 0; e < NE; ++e) if (e != e0 && lg[e] > v1) { v1 = lg[e]; e1 = e; }
                const float t = __expf(v1 - v0), w0 = 1.0f / (1.0f + t), w1 = t / (1.0f + t);
                if (lane == 0) {
                    const int p0 = __hip_atomic_fetch_add(lcnt + e0, 1, __ATOMIC_RELAXED, __HIP_MEMORY_SCOPE_WORKGROUP);
                    const int p1 = __hip_atomic_fetch_add(lcnt + e1, 1, __ATOMIC_RELAXED, __HIP_MEMORY_SCOPE_WORKGROUP);
                    rec[nrec * 4 + 0] = e0; rec[nrec * 4 + 1] = e1; rec[nrec * 4 + 2] = p0; rec[nrec * 4 + 3] = p1;
                    tok_e[row] = make_int2(e0, e1); tok_w[row] = make_float2(w0, w1);
                }
                ++nrec;
            }
        }
    }
    if (ROUTER) {
        __syncthreads();
        if (F.tid < 8) lbase[F.tid] = (int)__hip_atomic_fetch_add(cnt + F.tid, (unsigned)lcnt[F.tid], __ATOMIC_RELAXED, __HIP_MEMORY_SCOPE_AGENT);
        __syncthreads();
        if (lane < nrec) {
            const int row = F.gw * NR + (lane / NR) * F.ngw * NR + (lane % NR);
            const int e0 = rec[lane * 4 + 0], e1 = rec[lane * 4 + 1], p0 = lbase[e0] + rec[lane * 4 + 2], p1 = lbase[e1] + rec[lane * 4 + 3];
            tok_pos[row] = make_int2(p0, p1); rowsrc[(size_t)e0 * MT + p0] = row; rowsrc[(size_t)e1 * MT + p1] = row;
        }
    }
}

__device__ __forceinline__ void mix_phase(const Frame& F, int j) {
    const bf16* U = F.BIG(); const float* cw = F.in(I_CONVW) + (size_t)j * 3 * 512;
    const int gt = F.blk * 512 + F.tid, ngt = F.G * 512;
    for (int it = gt; it < MT * 128; it += ngt) {
        const int row = it >> 7, ch = it & 127;
        int t, L; if (row < ML) { t = row & 4095; L = SEQ; } else { t = (row - ML) & 255; L = CTXL; }
        if (ch < 64) {
            const int c0 = ch * 8; float o[8];
#pragma unroll
            for (int e = 0; e < 8; ++e) o[e] = 0.f;
#pragma unroll
            for (int k = 0; k < 3; ++k) { const int tt = t + k - 1;
                if (tt >= 0 && tt < L) { const bf16* ur = U + (size_t)(row + k - 1) * 2048; const bf16x8 gc = *(const bf16x8*)(ur + 512 + c0), vl = *(const bf16x8*)(ur + 1024 + c0);
                    const f32x4 w0 = *(const f32x4*)(cw + k * 512 + c0), w1 = *(const f32x4*)(cw + k * 512 + c0 + 4);
#pragma unroll
                    for (int e = 0; e < 8; ++e) o[e] += (bf2f(gc[e]) * bf2f(vl[e])) * (e < 4 ? w0[e & 3] : w1[e & 3]); } }
            const bf16x8 gb = *(const bf16x8*)(U + (size_t)row * 2048 + c0);
            u32x4 w; w.x = cvt_pk_bf16(bf2f(gb[0]) * o[0], bf2f(gb[1]) * o[1]); w.y = cvt_pk_bf16(bf2f(gb[2]) * o[2], bf2f(gb[3]) * o[3]);
            w.z = cvt_pk_bf16(bf2f(gb[4]) * o[4], bf2f(gb[5]) * o[5]); w.w = cvt_pk_bf16(bf2f(gb[6]) * o[6], bf2f(gb[7]) * o[7]);
            *(u32x4*)(F.Y1() + (size_t)row * D + c0) = w;
        } else {
            const int c0 = (ch - 64) * 8, grp = c0 >> 7, win = 2 << grp;
            const int lo = max(t - win / 2, 0), hi = min(t + (win - 1 - win / 2), L - 1);
            float s[8];
#pragma unroll
            for (int e = 0; e < 8; ++e) s[e] = 0.f;
            for (int tt = lo; tt <= hi; ++tt) { const bf16x8 p = *(const bf16x8*)(U + (size_t)(row + tt - t) * 2048 + 1536 + c0);
#pragma unroll
                for (int e = 0; e < 8; ++e) s[e] += bf2f(p[e]); }
            const float inv = 1.0f / (float)(hi - lo + 1);
            const bf16x8 pc = *(const bf16x8*)(U + (size_t)row * 2048 + 1536 + c0);
            float d[8];
#pragma unroll
            for (int e = 0; e < 8; ++e) d[e] = s[e] * inv - bf2f(pc[e]);
            u32x4 w; w.x = cvt_pk_bf16(d[0], d[1]); w.y = cvt_pk_bf16(d[2], d[3]); w.z = cvt_pk_bf16(d[4], d[5]); w.w = cvt_pk_bf16(d[6], d[7]);
            *(u32x4*)(F.Y1() + (size_t)row * D + 512 + c0) = w;
        }
    }
}

struct AttnState { f32x4 O[4]; float m, l; };
struct KVFrag { bf16x8 kf[2][2], vf[4]; };
__device__ __forceinline__ void attn_load(KVFrag& f, const bf16* kp  , const bf16* vp  ) {
#pragma unroll
    for (int t = 0; t < 2; ++t)
#pragma unroll
        for (int ks = 0; ks < 2; ++ks) f.kf[t][ks] = *(const bf16x8*)(kp + t * 4 * 64 + 32 * ks);
#pragma unroll
    for (int dt = 0; dt < 4; ++dt) f.vf[dt] = *(const bf16x8*)(vp + dt * 16 * 8);
}
template <bool LOCAL>
__device__ __forceinline__ void attn_compute(AttnState& st, const KVFrag& f, const bf16x8 (&qf)[2], const LAS float* brow, const float (&maskadd)[8]) {
    f32x4 S0 = (f32x4){0.f, 0.f, 0.f, 0.f}, S1 = (f32x4){0.f, 0.f, 0.f, 0.f};
    S0 = __builtin_amdgcn_mfma_f32_16x16x32_bf16(f.kf[0][0], qf[0], S0, 0, 0, 0); S0 = __builtin_amdgcn_mfma_f32_16x16x32_bf16(f.kf[0][1], qf[1], S0, 0, 0, 0);
    S1 = __builtin_amdgcn_mfma_f32_16x16x32_bf16(f.kf[1][0], qf[0], S1, 0, 0, 0); S1 = __builtin_amdgcn_mfma_f32_16x16x32_bf16(f.kf[1][1], qf[1], S1, 0, 0, 0);
    float s[8];
#pragma unroll
    for (int i = 0; i < 4; ++i) { s[i] = S0[i]; s[4 + i] = S1[i]; }
    if (LOCAL) {
#pragma unroll
        for (int i = 0; i < 8; ++i) s[i] += brow[i] + maskadd[i];
    }
    float mx = fmaxf(fmaxf(fmaxf(s[0], s[1]), fmaxf(s[2], s[3])), fmaxf(fmaxf(s[4], s[5]), fmaxf(s[6], s[7])));
    mx = fmaxf(mx, __shfl_xor(mx, 16)); mx = fmaxf(mx, __shfl_xor(mx, 32));
    const float mnew = fmaxf(st.m, mx), alpha = __builtin_amdgcn_exp2f(st.m - mnew);
    st.m = mnew;
    float p[8], ps = 0.f;
#pragma unroll
    for (int i = 0; i < 8; ++i) { p[i] = __builtin_amdgcn_exp2f(s[i] - mnew); ps += p[i]; }
    st.l = st.l * alpha + ps;
    u32x4 pw; pw.x = cvt_pk_bf16(p[0], p[1]); pw.y = cvt_pk_bf16(p[2], p[3]); pw.z = cvt_pk_bf16(p[4], p[5]); pw.w = cvt_pk_bf16(p[6], p[7]);
    const bf16x8 pb = __builtin_bit_cast(bf16x8, pw);
#pragma unroll
    for (int dt = 0; dt < 4; ++dt) { st.O[dt] = st.O[dt] * alpha; st.O[dt] = __builtin_amdgcn_mfma_f32_16x16x32_bf16(f.vf[dt], pb, st.O[dt], 0, 0, 0); }
}
__device__ __forceinline__ void attn_finish(AttnState& st, bf16* orow  ) {
    float l = st.l; l += __shfl_xor(l, 16); l += __shfl_xor(l, 32);
    const float inv = 1.0f / l;
#pragma unroll
    for (int dt = 0; dt < 4; ++dt) { const f32x4 o = st.O[dt] * inv; u32x2 w; w.x = cvt_pk_bf16(o[0], o[1]); w.y = cvt_pk_bf16(o[2], o[3]); *(u32x2*)(orow + 16 * dt) = w; }
}
template <int NL>
__device__ __forceinline__ void attn_unit(const bf16* kl, const bf16* vl, const bf16* kc, const bf16* vc, const bf16x8 (&qf)[2], const LAS float* brow0  ,
                                          const float (&maskadd)[8], bf16* orow) {
    constexpr int NC = NL + 8;
    AttnState st;
#pragma unroll
    for (int dt = 0; dt < 4; ++dt) st.O[dt] = (f32x4){0.f, 0.f, 0.f, 0.f};
    st.m = -1.0e30f; st.l = 0.f;
    KVFrag fr[3];
#define ATT_KP(c) ((c) < NL ? kl + (c) * 64 * 64 : kc + ((c) - NL) * 32 * 64)
#define ATT_VP(c) ((c) < NL ? vl + (c) * 8 * 512 : vc + ((c) - NL) * 4 * 512)
    attn_load(fr[0], ATT_KP(0), ATT_VP(0)); attn_load(fr[1], ATT_KP(1), ATT_VP(1));
#pragma unroll
    for (int c = 0; c < NC; ++c) {
        if (c + 2 < NC) attn_load(fr[(c + 2) % 3], ATT_KP(c + 2), ATT_VP(c + 2));
        __builtin_amdgcn_sched_barrier(0);
        if (c < NL) attn_compute<true>(st, fr[c % 3], qf, brow0 + c * 64, maskadd); else attn_compute<false>(st, fr[c % 3], qf, brow0, maskadd);
        __builtin_amdgcn_sched_barrier(0);
    }
#undef ATT_KP
#undef ATT_VP
    attn_finish(st, orow);
}
__device__ __forceinline__ void attn_fast(const Frame& F, const float* rpbt, bool do_ctx) {
    const bf16* QB = F.BIG(); const bf16* KH = F.BIG() + (size_t)MT * 1024; const bf16* VT8 = F.VT(); bf16* AO = F.Y1();
    LAS float* tbl = (LAS float*)F.lds;
    const int lane = F.lane, fr = lane & 15, fq = lane >> 4, wave = F.wave;
    const int krow = 8 * (fr >> 2) + (fr & 3);
    const int per = (2048 + F.G - 1) / F.G;
    int cur_h = -1;
    const int vb = (F.G % 8 == 0) ? (F.blk % 8) * (F.G / 8) + F.blk / 8 : F.blk;
    const int bu_end = min((vb + 1) * per, 2048);
    for (int bu = vb * per; bu < bu_end; ++bu) {
        const int bh = bu >> 5, rp = bu & 31, b = bh >> 4, h = bh & 15;
        if (h != cur_h) { __syncthreads(); for (int i = F.tid; i < 15 * 64; i += 512) tbl[i] = rpbt[h * 15 * 64 + i]; cur_h = h; __syncthreads(); }
        const int r = 2 * rp + (wave >> 2), jb = wave & 3;
        const int w0 = jb == 0 ? 0 : (jb == 1 ? 8 : (jb == 2 ? 24 : 32));
        const int jq = 16 * jb + fr, cs = min(max(jq - 8, 0), 48), rs = min(max(r - 4, 0), 56);
        const int qrow = b * 4096 + r * 64 + jq;
        bf16x8 qf[2];
#pragma unroll
        for (int ks = 0; ks < 2; ++ks) qf[ks] = *(const bf16x8*)(QB + (size_t)qrow * 1024 + h * 64 + 32 * ks + 8 * fq);
        float maskadd[8];
#pragma unroll
        for (int i = 0; i < 8; ++i) { const int col = w0 + 8 * fq + i; maskadd[i] = (col >= cs && col < cs + 16) ? 0.f : -1.0e30f; }
        const int boff = w0 + 8 * fq - jq + 32;
        const int tl = b * 4096 + rs * 64 + w0, tc = ML + b * 256;
        const bf16* kl = KH + ((size_t)h * MT + tl + krow) * 64 + 8 * fq;
        const bf16* vl = VT8 + (((size_t)h * (MT / 8) + (tl >> 3) + fq) * 64 + fr) * 8;
        const bf16* kc = KH + ((size_t)h * MT + tc + krow) * 64 + 8 * fq;
        const bf16* vc = VT8 + (((size_t)h * (MT / 8) + (tc >> 3) + fq) * 64 + fr) * 8;
        attn_unit<8>(kl, vl, kc, vc, qf, tbl + (rs - r + 7) * 64 + boff, maskadd, AO + (size_t)qrow * D + h * 64 + 4 * fq);
    }
    if (do_ctx) {
        for (int wu = F.gw; wu < 1024; wu += F.ngw) {
            const int bh = wu >> 4, qb = wu & 15, b = bh >> 4, h = bh & 15;
            const int qrow = ML + b * 256 + 16 * qb + fr;
            bf16x8 qf[2];
#pragma unroll
            for (int ks = 0; ks < 2; ++ks) qf[ks] = *(const bf16x8*)(QB + (size_t)qrow * 1024 + h * 64 + 32 * ks + 8 * fq);
            float maskadd[8];
#pragma unroll
            for (int i = 0; i < 8; ++i) maskadd[i] = 0.f;
            const int tc = ML + b * 256;
            const bf16* kc = KH + ((size_t)h * MT + tc + krow) * 64 + 8 * fq;
            const bf16* vc = VT8 + (((size_t)h * (MT / 8) + (tc >> 3) + fq) * 64 + fr) * 8;
            attn_unit<0>(kc, vc, kc, vc, qf, tbl, maskadd, AO + (size_t)qrow * D + h * 64 + 4 * fq);
        }
    }
}

__global__ void __launch_bounds__(512, 2) fwd_kernel(Args args) {
    extern __shared__ __attribute__((aligned(16))) unsigned char lds_raw[];
    Frame F;
    F.lds = (LAS unsigned char*)lds_raw;
    F.renew();
    volatile LAS unsigned* MISC = (volatile LAS unsigned*)(F.lds + MISC_OFF);
    if (F.tid < 32) MISC[F.tid] = 0u;
    __syncthreads();
    XcdBarrier bar = xcd_barrier_post(F.ctl() + CW_BAR, MISC + 8);
#define GRID_BAR() do { xcd_barrier(bar); F.renew(); } while (0)
#define MODS(layer) (F.mods() + (size_t)(layer) * 5 * 6144)
#define CNT(jj) (F.ctl() + CW_CNT + 64 * (jj))
#define TAIL_CONV(nwg, q) do { if (tail_idle((nwg), F.G, F.blk)) conv_queue(F, CQ_END, (q)); } while (0)

    mods_phase(F); rpb_phase(F); poolfold_phase(F, 0); conv_dense0(F);
    GRID_BAR();

    for (int j = 0; j < 2; ++j) {
        const int le = 2 * j, lo = 2 * j + 1;
        const bool last = (j == 1);
        if (j == 0) norm_phase<true, false, false, false>(F, MT, F.in(I_GMIX) + le * D, MODS(le), 0, nullptr, nullptr, nullptr);
        else { norm_phase<false, true, false, false>(F, MT, F.in(I_GMIX) + le * D, MODS(le), 0, MODS(le - 1) + 5 * 1024, nullptr, CNT(j - 1));
               __syncthreads(); poolfold_phase(F, 1); conv_queue(F, CQ_P1D, 1 << 20); }
        GRID_BAR();
        { pg8::SchedStatic S; S.init(F.AF(), F.wb(j) + WB_WIN, MT, 2048, 1024, F.G, F.blk); EpiStoreBf16 E{F.BIG(), 2048}; pg8::gemm_phase(F.lds, F.tid, 1024, 1024, S, E); }
        TAIL_CONV(68 * 8, 3);
        GRID_BAR();
        mix_phase(F, j); bias_phase(F, j);
        GRID_BAR();
        { pg8::SchedStatic S; S.init(F.Y1(), F.wb(j) + WB_WOUT, MT, 1024, 1024, F.G, F.blk); EpiResGateNorm E{F.H(), MODS(le) + 2 * 1024, F.in(I_GFFN) + le * D, MODS(le) + 4 * 1024, F.AF(), F.ssp(2 * j), (LAS float*)(F.lds + PART_OFF)}; pg8::gemm_phase(F.lds, F.tid, 1024, 1024, S, E); }
        TAIL_CONV(68 * 4, 3);
        GRID_BAR();
        { pg8::SchedStatic S; S.init(F.AF(), F.wb(j) + WB_WGU, MT, 2 * DFF, 1024, F.G, F.blk); EpiSwiGLUNorm E{F.BIG(), DFF, F.ssp(2 * j), F.bias() + BIAS_GU + (size_t)j * 5 * 5632}; pg8::gemm_phase(F.lds, F.tid, 1024, 1024, S, E); }
        GRID_BAR();
        { pg8::SchedStatic S; S.init(F.BIG(), F.wb(j) + WB_WD, MT, 1024, DFF, F.G, F.blk); EpiResGateNorm E{F.H(), MODS(le) + 5 * 1024, F.in(I_GMIX) + lo * D, MODS(lo) + 1 * 1024, F.AF(), F.ssp(2 * j + 1), (LAS float*)(F.lds + PART_OFF)}; pg8::gemm_phase(F.lds, F.tid, DFF, DFF, S, E); }
        TAIL_CONV(68 * 4, 9);
        GRID_BAR();
        const int Mo = last ? ML : MT;
        { pg8::SchedQKVT S; S.AF = (const char*)F.AF(); S.WQK = (const char*)(F.wb(j) + WB_WQKV); S.WV = (const char*)(F.wb(j) + WB_WQKV + (size_t)2048 * 1024); S.G = F.G; S.c = F.blk; S.tstep = (size_t)256 * 1024 * 2;
          EpiQKVT E{F.BIG(), F.BIG() + (size_t)MT * 1024, F.VT(), F.ssp(2 * j + 1), F.bias() + BIAS_QKV + (size_t)j * 5 * 3072}; pg8::gemm_phase(F.lds, F.tid, 1024, 1024, S, E); }
        TAIL_CONV(pg8::SchedQKVT::NQK + pg8::SchedQKVT::NVT, 3);
        GRID_BAR();
        attn_fast(F, F.rpbt() + (size_t)j * 16 * 15 * 64, !last);
        GRID_BAR();
        { pg8::SchedStatic S; S.init(F.Y1(), F.wb(j) + WB_WO, Mo, 1024, 1024, F.G, F.blk); EpiResGate E{F.H(), MODS(lo) + 2 * 1024}; pg8::gemm_phase(F.lds, F.tid, 1024, 1024, S, E); }
        TAIL_CONV((Mo / 256) * 4, 3);
        GRID_BAR();
        norm_phase<false, false, true, false>(F, Mo, F.in(I_GFFN) + lo * D, MODS(lo), 3, nullptr, F.in(I_WR) + (size_t)j * 1024 * 8, CNT(j));
        conv_queue(F, j == 0 ? CQ_P0M : CQ_END, 1 << 20);
        GRID_BAR();
        { pg8::SchedMoe S; S.init(F.AF(), F.wb(j) + WB_WEGU, (size_t)7168 * 1024, CNT(j), (const int*)(F.ws() + WS_TOK + 2 * MiB), 2 * DFE, 1024, F.G, F.blk); EpiSwiGLU E{F.BIG(), DFE}; pg8::gemm_phase_gather(F.lds, F.tid, 1024, 1024, S, E); }
        GRID_BAR();
        { pg8::SchedDownK2 S; S.init(F.BIG(), F.wb(j) + WB_WED, CNT(j), F.G, F.blk); EpiDownK2 E{F.YPAIR(), F.YPB()}; pg8::gemm_phase(F.lds, F.tid, pg8::DOWN_KH, DFE, S, E);
          TAIL_CONV(S.nwg, 6); }
        GRID_BAR();
    }
    norm_phase<false, true, false, true>(F, ML, F.in(I_GFINAL), nullptr, 0, MODS(3) + 5 * 1024, nullptr, CNT(1));
}

extern "C" void kernel_launch(void* const* d_in, const int* in_sizes, int n_in, void* d_out, int out_size, void* d_ws, size_t ws_size, hipStream_t stream) {
    static int grid = 0;
    if (grid == 0) {
        if (n_in != 24 || out_size != ML * D || ws_size < WS_END) { fprintf(stderr, "kernel_launch: unexpected shapes (n_in %d out %d ws %zu)\n", n_in, out_size, ws_size); grid = -1; return; }
        int dev = 0, cus = 0, per_cu = 0;
        if (hipGetDevice(&dev) != hipSuccess || hipDeviceGetAttribute(&cus, hipDeviceAttributeMultiprocessorCount, dev) != hipSuccess) { grid = -1; return; }
        if (hipFuncSetAttribute((const void*)fwd_kernel, hipFuncAttributeMaxDynamicSharedMemorySize, LDS_BYTES) != hipSuccess) { fprintf(stderr, "kernel_launch: hipFuncSetAttribute failed\n"); grid = -1; return; }
        if (hipOccupancyMaxActiveBlocksPerMultiprocessor(&per_cu, (const void*)fwd_kernel, 512, LDS_BYTES) != hipSuccess || per_cu < 1) { fprintf(stderr, "kernel_launch: occupancy query says %d\n", per_cu); grid = -1; return; }
        (void)hipGetLastError();
        grid = cus;
    }
    if (grid < 0) return;
    if (hipMemsetAsync((char*)d_ws + WS_CTL, 0, CTL_BYTES, stream) != hipSuccess) return;
    Args a{};
    for (int i = 0; i < 24; ++i) a.in[i] = (const float*)d_in[i];
    a.out = (float*)d_out; a.ws = (unsigned char*)d_ws;
    hipLaunchKernelGGL(fwd_kernel, dim3(grid), dim3(512), LDS_BYTES, stream, a);
}
```

```cpp
#include <hip/hip_runtime.h>
#include <cstdio>
#include <cstdint>

#define GAS __attribute__((address_space(1)))
#define LAS __attribute__((address_space(3)))
typedef unsigned short bf16;
typedef short bf16x8 __attribute__((ext_vector_type(8)));
typedef float f32x4 __attribute__((ext_vector_type(4)));
typedef float f32x2 __attribute__((ext_vector_type(2)));
typedef unsigned u32x4 __attribute__((ext_vector_type(4)));
typedef unsigned u32x2 __attribute__((ext_vector_type(2)));

constexpr int D = 1024, NB = 4, SEQ = 4096, CTXL = 256, GW = 64;
constexpr int ML = NB * SEQ, MC = NB * CTXL, MT = ML + MC;
constexpr int DFF = 2816, NE = 8, DFE = 3584, NH = 16, HD = 64;
constexpr int MPAIR_MAX = 36864;
constexpr float EPS = 1e-6f;
constexpr float QSCALE = 0.18033688011112042f;
constexpr float LOG2E = 1.4426950408889634f;

constexpr size_t MiB = 1u << 20;
constexpr size_t WS_CTL = 0, CTL_BYTES = 1 * MiB;
constexpr size_t WS_MODS = 1 * MiB;
constexpr size_t WS_RPB = 2 * MiB;
constexpr size_t WS_TOK = 4 * MiB;
constexpr size_t WS_WB = 8 * MiB, WB_STRIDE = 200 * MiB;
constexpr size_t WS_H = 408 * MiB;
constexpr size_t WS_AF = 476 * MiB;
constexpr size_t WS_Y1 = 510 * MiB;
constexpr size_t WS_VT = 544 * MiB;
constexpr size_t WS_YPB = WS_Y1;
constexpr size_t WS_YPAIR = 582 * MiB;
constexpr size_t WS_BIG = 654 * MiB;
constexpr size_t WS_END = 906 * MiB;
static_assert(WS_YPB + (size_t)MPAIR_MAX * 1024 * 2 <= WS_YPAIR && WS_YPAIR + (size_t)MPAIR_MAX * 1024 * 2 <= WS_BIG, "expert output buffers");
constexpr size_t WB_WIN = 0;
constexpr size_t WB_WOUT = WB_WIN + (size_t)2048 * 1024;
constexpr size_t WB_WGU = WB_WOUT + (size_t)1024 * 1024;
constexpr size_t WB_WD = WB_WGU + (size_t)5632 * 1024;
constexpr size_t WB_WQKV = WB_WD + (size_t)1024 * 2816;
constexpr size_t WB_WO = WB_WQKV + (size_t)3072 * 1024;
constexpr size_t WB_WEGU = WB_WO + (size_t)1024 * 1024;
constexpr size_t WB_WED = WB_WEGU + (size_t)8 * 7168 * 1024;
constexpr size_t WB_END = WB_WED + (size_t)8 * 1024 * 3584;
static_assert(WB_END * 2 <= WB_STRIDE && WS_WB + 2 * WB_STRIDE <= WS_H, "weights fit");
static_assert(WS_BIG + (size_t)MPAIR_MAX * 3584 * 2 <= WS_END, "big fits");
constexpr int CW_CNT = 64;
constexpr int CW_QHEAD = 1024;
constexpr int CW_SS = 32768;
constexpr size_t WS_BIAS = WS_MODS + 512 * 1024;
constexpr int BIAS_GU = 0, BIAS_QKV = 2 * 5 * 5632;
constexpr int CW_BAR = 4096;

constexpr int LDS_BYTES = 147456;
constexpr int MISC_OFF = 131072 + 320;
constexpr int PART_OFF = 131072 + 1024;

#ifndef FAST_MASK
#define FAST_MASK 0x3FF
#endif
#define FAST(k) ((FAST_MASK >> (k)) & 1)
#ifndef REP_MASK
#define REP_MASK 0
#endif
#define REPN(k) (1 + ((REP_MASK >> (k)) & 1))
struct Args { const float* in[24]; float* out; unsigned char* ws; };

__device__ __forceinline__ unsigned cvt_pk_bf16(float lo, float hi) { unsigned r; asm("v_cvt_pk_bf16_f32 %0, %1, %2" : "=v"(r) : "v"(lo), "v"(hi)); return r; }
__device__ __forceinline__ float bf2f(short s) { return __uint_as_float(((unsigned)(unsigned short)s) << 16); }
__device__ __forceinline__ float bfu2f(bf16 s) { return __uint_as_float(((unsigned)s) << 16); }
__device__ __forceinline__ float wave_sum(float v) {
#pragma unroll
    for (int o = 1; o < 64; o <<= 1) v += __shfl_xor(v, o);
    return v;
}
__device__ __forceinline__ float wave_max(float v) {
#pragma unroll
    for (int o = 1; o < 64; o <<= 1) v = fmaxf(v, __shfl_xor(v, o));
    return v;
}
__device__ __forceinline__ float silu_f(float g) { return g * __builtin_amdgcn_rcpf(1.f + __builtin_amdgcn_exp2f(-1.4426950408889634f * g)); }

#define XB_TMO      128
#define XB_XCNT(j)  (256  + 64 * (j))
#define XB_XSUB(j)  (1280 + 64 * (j))
#define XB_XGEN(j)  (2304 + 64 * (j))
#define XB_TOP      3328
#define XB_TOPGEN   3392
#define XCD_BAR_WORDS 3456
#define XB_SPIN_CAP (1u << 22)
__device__ __forceinline__ unsigned xb_ld(unsigned* p)              { return __hip_atomic_load(p, __ATOMIC_RELAXED, __HIP_MEMORY_SCOPE_AGENT); }
__device__ __forceinline__ unsigned xb_add(unsigned* p, unsigned v) { return __hip_atomic_fetch_add(p, v, __ATOMIC_RELAXED, __HIP_MEMORY_SCOPE_AGENT); }
__device__ __forceinline__ unsigned xb_xcc_id() { return (unsigned)__builtin_amdgcn_s_getreg((3 << 11) | 20) & 0xFu; }
#define XB_SPIN(cond, bar) do { unsigned _sp = 0; while (cond) { __builtin_amdgcn_s_sleep(1); \
    if ((++_sp & 255u) == 0u) { if (xb_ld(&(bar)[XB_TMO])) break; if (_sp > XB_SPIN_CAP) { atomicAdd(&(bar)[XB_TMO], 1u); break; } } } } while (0)
struct XcdBarrier { unsigned* bar; unsigned x; volatile LAS unsigned* st; };
__device__ __forceinline__ XcdBarrier xcd_barrier_post(unsigned* bar, volatile LAS unsigned* st) {
    XcdBarrier b; b.bar = bar; b.x = xb_xcc_id(); b.st = st;
    if (threadIdx.x == 0) (void)xb_add(&bar[XB_XCNT(b.x)], 1u);
    return b;
}
__device__ __forceinline__ void xcd_barrier_complete(unsigned* bar, unsigned x, unsigned& nloc, unsigned& nx) {
    const unsigned G = gridDim.x * gridDim.y * gridDim.z;
    unsigned sum, cnt, mine, sp = 0u;
    for (;;) {
        sum = 0u; cnt = 0u; mine = 0u;
#pragma unroll
        for (unsigned j = 0; j < 16; ++j) { const unsigned c = xb_ld(&bar[XB_XCNT(j)]); sum += c; cnt += (c > 0u) ? 1u : 0u; mine = (j == x) ? c : mine; }
        if (sum == G) break;
        __builtin_amdgcn_s_sleep(1);
        if ((++sp & 255u) == 0u) { if (xb_ld(&bar[XB_TMO])) break; if (sp > XB_SPIN_CAP) { atomicAdd(&bar[XB_TMO], 1u); break; } }
    }
    nloc = mine > 0u ? mine : 1u; nx = cnt > 0u ? cnt : 1u;
}
__device__ __forceinline__ void xcd_barrier(const XcdBarrier& b) {
    asm volatile("s_waitcnt vmcnt(0)" ::: "memory");
    __syncthreads();
    if (threadIdx.x == 0) {
        unsigned* bar = b.bar;
        __builtin_amdgcn_s_waitcnt(0);
        unsigned nloc = b.st[0], nx = b.st[1];
        if (nloc == 0u) { xcd_barrier_complete(bar, b.x, nloc, nx); b.st[0] = nloc; b.st[1] = nx; }
        const unsigned old = xb_add(&bar[XB_XSUB(b.x)], 1u);
        const unsigned gen = old / nloc;
        if (old + 1u == (gen + 1u) * nloc) {
            __builtin_amdgcn_fence(__ATOMIC_RELEASE, "agent");
            asm volatile("s_waitcnt vmcnt(0)" ::: "memory");
            const unsigned og = xb_add(&bar[XB_TOP], 1u);
            const unsigned tg = og / nx;
            if (og + 1u == (tg + 1u) * nx) xb_add(&bar[XB_TOPGEN], 1u);
            else XB_SPIN(xb_ld(&bar[XB_TOPGEN]) == tg, bar);
            __builtin_amdgcn_fence(__ATOMIC_ACQUIRE, "agent");
            xb_add(&bar[XB_XGEN(b.x)], 1u);
            asm volatile("s_waitcnt vmcnt(0)" ::: "memory");
        } else {
            XB_SPIN(xb_ld(&bar[XB_XGEN(b.x)]) == gen, bar);
            __builtin_amdgcn_fence(__ATOMIC_ACQUIRE, "agent");
            asm volatile("s_waitcnt vmcnt(0)" ::: "memory");
        }
    }
    __syncthreads();
}

typedef const __attribute__((address_space(4))) Args* KArgs;
__device__ __forceinline__ KArgs kargs() { KArgs p = (KArgs)__builtin_amdgcn_kernarg_segment_ptr(); asm volatile("" : "+s"(p)); return p; }
struct Frame {
    LAS unsigned char* lds;
    KArgs K;
    int tid, lane, wave, blk, G, gw, ngw;
    __device__ __forceinline__ void renew() { K = kargs(); int t = threadIdx.x; asm volatile("" : "+v"(t)); tid = t; lane = t & 63; wave = __builtin_amdgcn_readfirstlane(t >> 6);
        int b = blockIdx.x, g = gridDim.x; asm volatile("" : "+s"(b), "+s"(g)); blk = b; G = g; gw = b * 8 + wave; ngw = g * 8; }
    __device__ __forceinline__ const float* in(int i) const { return K->in[i]; }
    __device__ __forceinline__ float* out() const { return K->out; }
    __device__ __forceinline__ unsigned char* ws() const { return K->ws; }
    __device__ __forceinline__ unsigned* ctl() const { return (unsigned*)(ws() + WS_CTL); }
    __device__ __forceinline__ float* mods() const { return (float*)(ws() + WS_MODS); }
    __device__ __forceinline__ float* ssp(int use) const { return (float*)(ws() + 2 * MiB + 512 * 1024) + (size_t)use * MT * 4; }
    __device__ __forceinline__ float* bias() const { return (float*)(ws() + WS_BIAS); }
    __device__ __forceinline__ float* rpbt() const { return (float*)(ws() + WS_RPB); }
    __device__ __forceinline__ int* tok() const { return (int*)(ws() + WS_TOK); }
    __device__ __forceinline__ bf16* wb(int j) const { return (bf16*)(ws() + WS_WB + (size_t)j * WB_STRIDE); }
    __device__ __forceinline__ float* H() const { return (float*)(ws() + WS_H); }
    __device__ __forceinline__ bf16* AF() const { return (bf16*)(ws() + WS_AF); }
    __device__ __forceinline__ bf16* Y1() const { return (bf16*)(ws() + WS_Y1); }
    __device__ __forceinline__ bf16* VT() const { return (bf16*)(ws() + WS_VT); }
    __device__ __forceinline__ bf16* YPAIR() const { return (bf16*)(ws() + WS_YPAIR); }
    __device__ __forceinline__ bf16* YPB() const { return (bf16*)(ws() + WS_YPB); }
    __device__ __forceinline__ bf16* BIG() const { return (bf16*)(ws() + WS_BIG); }
};
enum { I_X = 0, I_C, I_CTX, I_CCTX, I_WMOD, I_BMOD, I_GMIX, I_GFFN, I_GFINAL, I_WIN, I_CONVW, I_POOLW, I_POOLS, I_WOUT, I_WFG, I_WFU, I_WFD, I_WQKV, I_RPB, I_WONA, I_WR, I_WEG, I_WEU, I_WED };

__device__ __forceinline__ int row_bm(int row) { return row < ML ? (row >> 12) : 4; }

constexpr size_t WS_SSP = 2 * MiB + 512 * 1024;
struct NoCtx {};
struct ColCtx { f32x4 x[2][2]; };
struct RowColCtx { float r[8]; f32x4 x[2][2]; };
__device__ __forceinline__ void st4bf(bf16* p, f32x4 v) { u32x2 a; a.x = cvt_pk_bf16(v[0], v[1]); a.y = cvt_pk_bf16(v[2], v[3]); *(u32x2*)p = a; }
__device__ __forceinline__ float rstd_of(const float* SSP, int row) { const f32x4 s = *(const f32x4*)(SSP + (size_t)row * 4); return 1.0f / sqrtf(((s[0] + s[1]) + (s[2] + s[3])) * (1.0f / D) + EPS); }
#define UNIT_ROW(pm, wr, fr, ri) ((pm) * 256 + ((ri) >> 2) * 128 + (wr) * 64 + ((ri) & 3) * 16 + (fr))
#define UNIT_COL(pn, wc, fq, bj, n) ((pn) * 256 + (bj) * 128 + (wc) * 32 + (n) * 16 + 4 * (fq))
struct EpiStoreBf16 { bf16* O; int ldc; static constexpr bool UNIT_END = false; typedef NoCtx Ctx;
    __device__ __forceinline__ Ctx unit_ctx(int, int, int, int, int, int) const { return Ctx{}; }
    __device__ __forceinline__ void operator()(const Ctx&, int row, int col, int, int, f32x4 v0, f32x4 v1) const { bf16* p = O + (size_t)row * ldc + col; st4bf(p, v0); st4bf(p + 16, v1); } };
struct EpiDownK2 { bf16* Y0; bf16* Y1; static constexpr bool UNIT_END = false; typedef NoCtx Ctx;
    __device__ __forceinline__ Ctx unit_ctx(int, int, int, int, int, int) const { return Ctx{}; }
    __device__ __forceinline__ void operator()(const Ctx&, int row, int col, int, int, f32x4 v0, f32x4 v1) const {
        bf16* p = ((col >> 10) ? Y1 : Y0) + (size_t)row * 1024 + (col & 1023); st4bf(p, v0); st4bf(p + 16, v1); } };
struct EpiResGate { float* H; const float* gate; static constexpr bool UNIT_END = false; typedef ColCtx Ctx;
    __device__ __forceinline__ Ctx unit_ctx(int pm, int pn, int, int wc, int, int fq) const { Ctx c; const float* g = gate + row_bm(pm * 256) * 6144;
#pragma unroll
        for (int bj = 0; bj < 2; ++bj)
#pragma unroll
            for (int n = 0; n < 2; ++n) c.x[bj][n] = *(const f32x4*)(g + UNIT_COL(pn, wc, fq, bj, n));
        return c; }
    __device__ __forceinline__ void operator()(const Ctx& c, int row, int col, int, int bj, f32x4 v0, f32x4 v1) const {
        float* p = H + (size_t)row * D + col;
        *(f32x4*)p = *(const f32x4*)p + c.x[bj][0] * v0; *(f32x4*)(p + 16) = *(const f32x4*)(p + 16) + c.x[bj][1] * v1; } };
struct GateNormCtx { f32x4 g[2][2], G[2][2]; };
struct EpiResGateNorm { float* H; const float* gate; const float* gn; const float* scn  ; bf16* AFn; float* SSP; LAS float* part  ;
    static constexpr bool UNIT_END = true; typedef GateNormCtx Ctx;
    __device__ __forceinline__ Ctx unit_ctx(int pm, int pn, int, int wc, int, int fq) const { Ctx c; const int bm = row_bm(pm * 256);
#pragma unroll
        for (int bj = 0; bj < 2; ++bj)
#pragma unroll
            for (int n = 0; n < 2; ++n) { const int col = UNIT_COL(pn, wc, fq, bj, n); c.g[bj][n] = *(const f32x4*)(gate + bm * 6144 + col); c.G[bj][n] = *(const f32x4*)(gn + col) * (1.0f + *(const f32x4*)(scn + bm * 6144 + col)); }
        return c; }
    __device__ __forceinline__ void operator()(const Ctx& c, int row, int col, int, int bj, f32x4 v0, f32x4 v1) const {
        float* p = H + (size_t)row * D + col;
        const f32x4 h0 = *(const f32x4*)p + c.g[bj][0] * v0, h1 = *(const f32x4*)(p + 16) + c.g[bj][1] * v1;
        *(f32x4*)p = h0; *(f32x4*)(p + 16) = h1;
        bf16* q = AFn + (size_t)row * D + col; st4bf(q, h0 * c.G[bj][0]); st4bf(q + 16, h1 * c.G[bj][1]);
        float s = ((h0[0] * h0[0] + h0[1] * h0[1]) + (h0[2] * h0[2] + h0[3] * h0[3])) + ((h1[0] * h1[0] + h1[1] * h1[1]) + (h1[2] * h1[2] + h1[3] * h1[3]));
        s += __shfl_xor(s, 16); s += __shfl_xor(s, 32);
        if ((threadIdx.x & 48) == 0) part[(row & 255) * 8 + bj * 4 + ((col >> 5) & 3)] = s; }
    __device__ __forceinline__ void unit_end(int pm, int pn, int tid) const {
        if (tid < 256) { const LAS f32x4* q = (const LAS f32x4*)(part + tid * 8); const f32x4 a = q[0], b = q[1];
            SSP[(size_t)(pm * 256 + tid) * 4 + pn] = ((a[0] + a[1]) + (a[2] + a[3])) + ((b[0] + b[1]) + (b[2] + b[3])); } } };
struct EpiSwiGLU { bf16* O; int ldc; static constexpr bool UNIT_END = false; typedef NoCtx Ctx;
    __device__ __forceinline__ Ctx unit_ctx(int, int, int, int, int, int) const { return Ctx{}; }
    __device__ __forceinline__ void store(int row, int col, f32x4 v0, f32x4 v1) const {
        const int rc = ((col >> 5) << 4) + (col & 15);
        f32x4 r;
#pragma unroll
        for (int i = 0; i < 4; ++i) r[i] = silu_f(v0[i]) * v1[i];
        st4bf(O + (size_t)row * ldc + rc, r); }
    __device__ __forceinline__ void operator()(const Ctx&, int row, int col, int, int, f32x4 v0, f32x4 v1) const { store(row, col, v0, v1); } };
struct EpiSwiGLUNorm { bf16* O; int ldc; const float* SSP; const float* bias  ; static constexpr bool UNIT_END = false; typedef RowColCtx Ctx;
    __device__ __forceinline__ Ctx unit_ctx(int pm, int pn, int wr, int wc, int fr, int fq) const { Ctx c; const float* b = bias + row_bm(pm * 256) * 5632;
#pragma unroll
        for (int ri = 0; ri < 8; ++ri) c.r[ri] = rstd_of(SSP, UNIT_ROW(pm, wr, fr, ri));
#pragma unroll
        for (int bj = 0; bj < 2; ++bj)
#pragma unroll
            for (int n = 0; n < 2; ++n) c.x[bj][n] = *(const f32x4*)(b + UNIT_COL(pn, wc, fq, bj, n));
        return c; }
    __device__ __forceinline__ void operator()(const Ctx& c, int row, int col, int ri, int bj, f32x4 v0, f32x4 v1) const {
        EpiSwiGLU e{O, ldc}; e.store(row, col, v0 * c.r[ri] + c.x[bj][0], v1 * c.r[ri] + c.x[bj][1]); } };

struct MoeTiles {
    int c0, c1, c2, c3, c4, c5, c6, c7, total;
    __device__ __forceinline__ static int ld(const unsigned* p) { return __builtin_amdgcn_readfirstlane((int)__hip_atomic_load(p, __ATOMIC_RELAXED, __HIP_MEMORY_SCOPE_AGENT)); }
    __device__ __forceinline__ static int t(int c) { return (c + 255) >> 8; }
    __device__ __forceinline__ void init(const unsigned* cnt) { c0 = ld(cnt); c1 = ld(cnt + 1); c2 = ld(cnt + 2); c3 = ld(cnt + 3); c4 = ld(cnt + 4); c5 = ld(cnt + 5); c6 = ld(cnt + 6); c7 = ld(cnt + 7);
        total = t(c0) + t(c1) + t(c2) + t(c3) + t(c4) + t(c5) + t(c6) + t(c7); }
    __device__ __forceinline__ void tile_info(int tile, int& ex, int& pos0, int& count) const {
        int cum = 0, e = 0, first = 0, c = c0;
#define MT_STEP(k, ck, cn) cum += t(ck); if (tile >= cum) { e = k + 1; first = cum; c = cn; }
        MT_STEP(0, c0, c1) MT_STEP(1, c1, c2) MT_STEP(2, c2, c3) MT_STEP(3, c3, c4) MT_STEP(4, c4, c5) MT_STEP(5, c5, c6) MT_STEP(6, c6, c7)
#undef MT_STEP
        ex = e; pos0 = (tile - first) * 256; count = c; }
    __device__ __forceinline__ int expert_of_tile(int tile) const { int ex, pos0, count; tile_info(tile, ex, pos0, count); return ex; }
    __device__ __forceinline__ int row_offset(int ex) const {
        return ((ex > 0 ? t(c0) : 0) + (ex > 1 ? t(c1) : 0) + (ex > 2 ? t(c2) : 0) + (ex > 3 ? t(c3) : 0) + (ex > 4 ? t(c4) : 0) + (ex > 5 ? t(c5) : 0) + (ex > 6 ? t(c6) : 0)) * 256; }
};
namespace pg8 {
constexpr int BM = 256, BK = 64, HALF = 128, HTB = HALF * BK * 2, STAGE_BYTES = 8 * HTB, NXCD = 8, WGM = 8;
__host__ __device__ __forceinline__ int lds_byte(int r, int c) { const int st = (r >> 4) * 2 + (c >> 5), rr = r & 15, cc = c & 31, ob = rr * 64 + cc * 2; return st * 1024 + (ob ^ (((ob >> 9) & 1) << 5)); }
__host__ __device__ __forceinline__ void stage_rc(int b, int& R, int& C) { const int st = b / 1024, sb = b % 1024, swz = sb ^ (((sb >> 9) & 1) << 5); R = (st >> 1) * 16 + swz / 64; C = (st & 1) * 32 + (swz % 64) / 2; }
struct Unit { int pm, pn; };
__device__ __forceinline__ void tile_of(int L, int nwg, int nM, int nN, int& pm, int& pn) {
    int wgid = L; { const int q = nwg / NXCD, r = nwg % NXCD, xcd = wgid % NXCD, off = wgid / NXCD; wgid = (xcd < r ? xcd * (q + 1) : r * (q + 1) + (xcd - r) * q) + off; }
    const int nig = WGM * nN, gid = wgid / nig, fm = gid * WGM, gsz = (nM - fm) < WGM ? (nM - fm) : WGM;
    pm = fm + ((wgid % nig) % gsz); pn = (wgid % nig) / gsz;
}
struct SchedStatic {
    const char* A; const char* B; int nM, nN, nwg, G, c; size_t tstep;
    __device__ __forceinline__ void init(const bf16* A_, const bf16* B_, int M, int N, int K, int G_, int c_) { A = (const char*)A_; B = (const char*)B_; nM = M / BM; nN = N / BM; nwg = nM * nN; G = G_; c = c_; tstep = (size_t)BM * K * 2; }
    __device__ __forceinline__ bool next(int i, Unit& u) const { const int L = i * G + c; if (L >= nwg) return false; tile_of(L, nwg, nM, nN, u.pm, u.pn); return true; }
    __device__ __forceinline__ const char* a_base(const Unit& u) const { return A + (size_t)u.pm * tstep; }
    __device__ __forceinline__ const char* b_base(const Unit& u) const { return B + (size_t)u.pn * tstep; }
};
struct SchedQKVT {
    const char* AF; const char* WQK; const char* WV; int G, c; size_t tstep;
    static constexpr int NQK = 68 * 8, NVT = 4 * 68;
    __device__ __forceinline__ bool next(int i, Unit& u) const { const int L = i * G + c; if (L >= NQK + NVT) return false;
        int wgid = L; { const int nwg = NQK + NVT, q = nwg / NXCD, r = nwg % NXCD, xcd = wgid % NXCD, off = wgid / NXCD; wgid = (xcd < r ? xcd * (q + 1) : r * (q + 1) + (xcd - r) * q) + off; }
        if (wgid < NQK) { const int nig = WGM * 8, gid = wgid / nig, fm = gid * WGM, gsz = (68 - fm) < WGM ? (68 - fm) : WGM; u.pm = fm + ((wgid % nig) % gsz); u.pn = (wgid % nig) / gsz; }
        else { const int w = wgid - NQK; u.pm = 68 + (w & 3); u.pn = w >> 2; }
        return true; }
    __device__ __forceinline__ const char* a_base(const Unit& u) const { return u.pm < 68 ? AF + (size_t)u.pm * tstep : WV + (size_t)(u.pm - 68) * tstep; }
    __device__ __forceinline__ const char* b_base(const Unit& u) const { return u.pm < 68 ? WQK + (size_t)u.pn * tstep : AF + (size_t)u.pn * tstep; }
};
struct SchedMoe {
    const char* A; const char* B; const int* rowsrc; MoeTiles mt; int nN, nwg, G, c; size_t tstep, estride;
    __device__ __forceinline__ void init(const bf16* A_, const bf16* B_, size_t estride_elems, const unsigned* cnt, const int* rowsrc_, int N, int K, int G_, int c_) { A = (const char*)A_; B = (const char*)B_; rowsrc = rowsrc_; mt.init(cnt); nN = N / BM; nwg = mt.total * nN; G = G_; c = c_; tstep = (size_t)BM * K * 2; estride = estride_elems * 2; }
    __device__ __forceinline__ bool next(int i, Unit& u) const { const int L = i * G + c; if (L >= nwg) return false; tile_of(L, nwg, mt.total, nN, u.pm, u.pn); return true; }
    __device__ __forceinline__ const char* a_base(const Unit& u) const { return A + (size_t)u.pm * tstep; }
    __device__ __forceinline__ const char* b_base(const Unit& u) const { return B + (size_t)mt.expert_of_tile(u.pm) * estride + (size_t)u.pn * tstep; }
    __device__ __forceinline__ const char* a_matrix() const { return A; }
    __device__ __forceinline__ void rows_of(const Unit& u, const int (&r)[4], int (&row)[4]) const { int ex, pos0, count; mt.tile_info(u.pm, ex, pos0, count); const int* rs = rowsrc + (size_t)ex * MT + pos0;
#pragma unroll
        for (int q = 0; q < 4; ++q) row[q] = (pos0 + r[q] < count) ? rs[r[q]] : 0; }
};
constexpr int DOWN_KH = 1792;
struct SchedDownK2 {
    const char* A; const char* B; MoeTiles mt; int nwg, G, c; size_t tstep, estride;
    __device__ __forceinline__ void init(const bf16* A_, const bf16* B_, const unsigned* cnt, int G_, int c_) { A = (const char*)A_; B = (const char*)B_; mt.init(cnt); nwg = mt.total * 8; G = G_; c = c_; tstep = (size_t)BM * DFE * 2; estride = (size_t)1024 * DFE * 2; }
    __device__ __forceinline__ bool next(int i, Unit& u) const { const int L = i * G + c; if (L >= nwg) return false; tile_of(L, nwg, mt.total, 8, u.pm, u.pn); return true; }
    __device__ __forceinline__ const char* a_base(const Unit& u) const { return A + (size_t)u.pm * tstep + (size_t)(u.pn >> 2) * DOWN_KH * 2; }
    __device__ __forceinline__ const char* b_base(const Unit& u) const { return B + (size_t)mt.expert_of_tile(u.pm) * estride + (size_t)(u.pn & 3) * tstep + (size_t)(u.pn >> 2) * DOWN_KH * 2; }
};
template <class Epi>
__device__ __forceinline__ void epi_apply(const f32x4 (&acc)[2][2][4][2], const Unit& u, int wr, int wc, int fr, int fq, const Epi& E, int tid) {
    const typename Epi::Ctx ctx = E.unit_ctx(u.pm, u.pn, wr, wc, fr, fq);
#pragma unroll
    for (int ai = 0; ai < 2; ++ai)
#pragma unroll
        for (int m = 0; m < 4; ++m) { const int row = u.pm * BM + ai * HALF + wr * 64 + m * 16 + fr;
#pragma unroll
            for (int bj = 0; bj < 2; ++bj) E(ctx, row, u.pn * BM + bj * HALF + wc * 32 + 4 * fq, ai * 4 + m, bj, acc[ai][bj][m][0], acc[ai][bj][m][1]);
            if (m & 1) asm volatile("" ::: "memory"); }
    if constexpr (Epi::UNIT_END) {
        asm volatile("s_waitcnt lgkmcnt(0)" ::: "memory"); __builtin_amdgcn_s_barrier(); asm volatile("" ::: "memory");
        E.unit_end(u.pm, u.pn, tid);
    }
}
template <class Epi, class Sched>
__device__ __forceinline__ void gemm_phase(LAS unsigned char* lds, const int tid, const int K, const int LD  , const Sched& S, const Epi& E) {
    const int wid = __builtin_amdgcn_readfirstlane(tid >> 6), lane = tid & 63, wr = wid >> 2, wc = wid & 3, fr = lane & 15, fq = lane >> 4;
    const int nt = K / BK;
    unsigned voff[2];
#pragma unroll
    for (int i = 0; i < 2; ++i) { int R, C; stage_rc(tid * 16 + i * 8192, R, C); voff[i] = (unsigned)(R * LD + C) * 2u; }
    const size_t kstep = (size_t)(BK * 2);
    const size_t hstep = (size_t)HALF * LD * 2;
    const unsigned ldsw = (unsigned)wid * 1024u;
    const int aoff = lds_byte(wr * 64 + fr, fq * 8), boff = lds_byte(wc * 32 + fr, fq * 8);
#define PG8_SA(b, h) (((b) * 2 + (h)) * HTB)
#define PG8_SB(b, h) ((4 + (b) * 2 + (h)) * HTB)
#define PG8_STAGE(bufoff, gbase) do { _Pragma("unroll") for (int _i = 0; _i < 2; ++_i) \
        __builtin_amdgcn_global_load_lds((const unsigned*)((const char*)(gbase) + voff[_i]), (LAS unsigned*)(lds + (bufoff) + ldsw + _i * 8192), 16, 0, 0); } while (0)
#define PG8_LDA(dst, b, h) do { _Pragma("unroll") for (int m = 0; m < 4; ++m) _Pragma("unroll") for (int k = 0; k < 2; ++k) dst[m][k] = *(const LAS bf16x8*)(lds + PG8_SA(b, h) + aoff + m * 2048 + k * 1024); } while (0)
#define PG8_LDB(dst, b, h) do { _Pragma("unroll") for (int n = 0; n < 2; ++n) _Pragma("unroll") for (int k = 0; k < 2; ++k) dst[n][k] = *(const LAS bf16x8*)(lds + PG8_SB(b, h) + boff + n * 2048 + k * 1024); } while (0)
#define PG8_MMA(ai, bj, At, Bt) do { __builtin_amdgcn_s_setprio(1); _Pragma("unroll") for (int m = 0; m < 4; ++m) _Pragma("unroll") for (int n = 0; n < 2; ++n) _Pragma("unroll") for (int k = 0; k < 2; ++k) \
        acc[ai][bj][m][n] = __builtin_amdgcn_mfma_f32_16x16x32_bf16(Bt[n][k], At[m][k], acc[ai][bj][m][n], 0, 0, 0); __builtin_amdgcn_s_setprio(0); } while (0)
#define PG8_WAIT_V(n) asm volatile("s_waitcnt vmcnt(" #n ")" ::: "memory")
#define PG8_WAIT_L(n) asm volatile("s_waitcnt lgkmcnt(" #n ")" ::: "memory")
#define PG8_BAR __builtin_amdgcn_s_barrier()
#define PG8_SCHED __builtin_amdgcn_sched_barrier(0)
    Unit cur, nxt; int ui = 0;
    if (!S.next(0, cur)) return;
    f32x4 acc[2][2][4][2];
#pragma unroll
    for (int a = 0; a < 2; ++a)
#pragma unroll
        for (int b = 0; b < 2; ++b)
#pragma unroll
            for (int m = 0; m < 4; ++m)
#pragma unroll
                for (int n = 0; n < 2; ++n) acc[a][b][m][n] = (f32x4){0.f, 0.f, 0.f, 0.f};
    bf16x8 At[4][2], B0[2][2], B1[2][2];
    const char* cA = S.a_base(cur); const char* cB = S.b_base(cur);
    PG8_STAGE(PG8_SB(0, 0), cB); PG8_STAGE(PG8_SB(0, 1), cB + hstep); PG8_STAGE(PG8_SA(0, 0), cA); PG8_STAGE(PG8_SA(0, 1), cA + hstep);
    if (wr == 1) PG8_BAR;
    PG8_WAIT_V(2); PG8_BAR;
    PG8_STAGE(PG8_SB(1, 0), cB + kstep); PG8_STAGE(PG8_SA(1, 0), cA + kstep); PG8_STAGE(PG8_SB(1, 1), cB + hstep + kstep);
    PG8_WAIT_V(6); PG8_BAR;
    for (;;) {
        const bool has_next = S.next(ui + 1, nxt);
        const char* nA = has_next ? S.a_base(nxt) : cA; const char* nB = has_next ? S.b_base(nxt) : cB;
        for (int t = 0; t < nt; t += 2) {
            const bool last = (t == nt - 2);
            const char* a1 = cA + (size_t)(t + 1) * kstep;
            const char* a2 = last ? nA : cA + (size_t)(t + 2) * kstep; const char* b2 = last ? nB : cB + (size_t)(t + 2) * kstep;
            const char* a3 = a2 + kstep; const char* b3 = b2 + kstep;
            PG8_LDB(B0, 0, 0); PG8_LDB(B1, 0, 1); PG8_SCHED; PG8_LDA(At, 0, 0); PG8_STAGE(PG8_SA(1, 1), a1 + hstep);
            PG8_WAIT_V(8); PG8_WAIT_L(0); PG8_BAR; PG8_MMA(0, 0, At, B0); PG8_MMA(0, 1, At, B1); PG8_BAR; PG8_SCHED;
            PG8_LDA(At, 0, 1); PG8_STAGE(PG8_SB(0, 0), b2); PG8_STAGE(PG8_SB(0, 1), b2 + hstep); PG8_STAGE(PG8_SA(0, 0), a2);
            PG8_WAIT_V(8); PG8_WAIT_L(0); PG8_BAR; PG8_MMA(1, 0, At, B0); PG8_MMA(1, 1, At, B1); PG8_BAR; PG8_SCHED;
            PG8_LDB(B0, 1, 0); PG8_LDB(B1, 1, 1); PG8_SCHED; PG8_LDA(At, 1, 0); PG8_STAGE(PG8_SA(0, 1), a2 + hstep);
            PG8_WAIT_V(8); PG8_WAIT_L(0); PG8_BAR; PG8_MMA(0, 0, At, B0); PG8_MMA(0, 1, At, B1); PG8_BAR; PG8_SCHED;
            PG8_LDA(At, 1, 1); PG8_STAGE(PG8_SB(1, 0), b3); PG8_STAGE(PG8_SB(1, 1), b3 + hstep); PG8_STAGE(PG8_SA(1, 0), a3);
            PG8_WAIT_V(8); PG8_WAIT_L(0); PG8_BAR; PG8_MMA(1, 0, At, B0); PG8_MMA(1, 1, At, B1); PG8_BAR; PG8_SCHED;
        }
        if (wr == 0) PG8_BAR;
        epi_apply(acc, cur, wr, wc, fr, fq, E, tid);
        if (!has_next) break;
#pragma unroll
        for (int a = 0; a < 2; ++a)
#pragma unroll
            for (int b = 0; b < 2; ++b)
#pragma unroll
                for (int m = 0; m < 4; ++m)
#pragma unroll
                    for (int n = 0; n < 2; ++n) acc[a][b][m][n] = (f32x4){0.f, 0.f, 0.f, 0.f};
        cur = nxt; cA = nA; cB = nB; ++ui;
        if (wr == 1) PG8_BAR;
    }
    PG8_WAIT_V(0);
    PG8_BAR;
#undef PG8_SA
#undef PG8_SB
#undef PG8_STAGE
#undef PG8_LDA
#undef PG8_LDB
#undef PG8_MMA
#undef PG8_WAIT_V
#undef PG8_WAIT_L
#undef PG8_BAR
#undef PG8_SCHED
}
template <class Epi, class Sched>
__device__ __forceinline__ void gemm_phase_gather(LAS unsigned char* lds, const int tid, const int K, const int LD, const Sched& S, const Epi& E) {
    const int wid = __builtin_amdgcn_readfirstlane(tid >> 6), lane = tid & 63, wr = wid >> 2, wc = wid & 3, fr = lane & 15, fq = lane >> 4;
    const int nt = K / BK;
    unsigned voff[2];
#pragma unroll
    for (int i = 0; i < 2; ++i) { int R, C; stage_rc(tid * 16 + i * 8192, R, C); voff[i] = (unsigned)(R * LD + C) * 2u; }
    int rloc[4];
#pragma unroll
    for (int i = 0; i < 2; ++i) { int R, C; stage_rc(tid * 16 + i * 8192, R, C); rloc[i] = R; rloc[2 + i] = HALF + R; }
    unsigned vc[2][2], vn[2][2];
    const char* Am = S.a_matrix();
#define PG8_OFFS(dst, u) do { int _row[4]; S.rows_of(u, rloc, _row); _Pragma("unroll") for (int _h = 0; _h < 2; ++_h) _Pragma("unroll") for (int _i = 0; _i < 2; ++_i) \
        dst[_h][_i] = (unsigned)_row[2 * _h + _i] * (unsigned)(LD * 2) + (voff[_i] - (unsigned)(rloc[_i] * LD * 2)); } while (0)
#define PG8_STAGE_A(bufoff, koff, v) do { _Pragma("unroll") for (int _i = 0; _i < 2; ++_i) \
        __builtin_amdgcn_global_load_lds((const unsigned*)(Am + (koff) + (v)[_i]), (LAS unsigned*)(lds + (bufoff) + ldsw + _i * 8192), 16, 0, 0); } while (0)
    const size_t kstep = (size_t)(BK * 2);
    const size_t hstep = (size_t)HALF * LD * 2;
    const unsigned ldsw = (unsigned)wid * 1024u;
    const int aoff = lds_byte(wr * 64 + fr, fq * 8), boff = lds_byte(wc * 32 + fr, fq * 8);
#define PG8_SA(b, h) (((b) * 2 + (h)) * HTB)
#define PG8_SB(b, h) ((4 + (b) * 2 + (h)) * HTB)
#define PG8_STAGE(bufoff, gbase) do { _Pragma("unroll") for (int _i = 0; _i < 2; ++_i) \
        __builtin_amdgcn_global_load_lds((const unsigned*)((const char*)(gbase) + voff[_i]), (LAS unsigned*)(lds + (bufoff) + ldsw + _i * 8192), 16, 0, 0); } while (0)
#define PG8_LDA(dst, b, h) do { _Pragma("unroll") for (int m = 0; m < 4; ++m) _Pragma("unroll") for (int k = 0; k < 2; ++k) dst[m][k] = *(const LAS bf16x8*)(lds + PG8_SA(b, h) + aoff + m * 2048 + k * 1024); } while (0)
#define PG8_LDB(dst, b, h) do { _Pragma("unroll") for (int n = 0; n < 2; ++n) _Pragma("unroll") for (int k = 0; k < 2; ++k) dst[n][k] = *(const LAS bf16x8*)(lds + PG8_SB(b, h) + boff + n * 2048 + k * 1024); } while (0)
#define PG8_MMA(ai, bj, At, Bt) do { __builtin_amdgcn_s_setprio(1); _Pragma("unroll") for (int m = 0; m < 4; ++m) _Pragma("unroll") for (int n = 0; n < 2; ++n) _Pragma("unroll") for (int k = 0; k < 2; ++k) \
        acc[ai][bj][m][n] = __builtin_amdgcn_mfma_f32_16x16x32_bf16(Bt[n][k], At[m][k], acc[ai][bj][m][n], 0, 0, 0); __builtin_amdgcn_s_setprio(0); } while (0)
#define PG8_WAIT_V(n) asm volatile("s_waitcnt vmcnt(" #n ")" ::: "memory")
#define PG8_WAIT_L(n) asm volatile("s_waitcnt lgkmcnt(" #n ")" ::: "memory")
#define PG8_BAR __builtin_amdgcn_s_barrier()
#define PG8_SCHED __builtin_amdgcn_sched_barrier(0)
    Unit cur, nxt; int ui = 0;
    if (!S.next(0, cur)) return;
    f32x4 acc[2][2][4][2];
#pragma unroll
    for (int a = 0; a < 2; ++a)
#pragma unroll
        for (int b = 0; b < 2; ++b)
#pragma unroll
            for (int m = 0; m < 4; ++m)
#pragma unroll
                for (int n = 0; n < 2; ++n) acc[a][b][m][n] = (f32x4){0.f, 0.f, 0.f, 0.f};
    bf16x8 At[4][2], B0[2][2], B1[2][2];
    const char* cB = S.b_base(cur);
    PG8_OFFS(vc, cur);
    PG8_STAGE(PG8_SB(0, 0), cB); PG8_STAGE(PG8_SB(0, 1), cB + hstep); PG8_STAGE_A(PG8_SA(0, 0), 0, vc[0]); PG8_STAGE_A(PG8_SA(0, 1), 0, vc[1]);
    if (wr == 1) PG8_BAR;
    PG8_WAIT_V(2); PG8_BAR;
    PG8_STAGE(PG8_SB(1, 0), cB + kstep); PG8_STAGE_A(PG8_SA(1, 0), kstep, vc[0]); PG8_STAGE(PG8_SB(1, 1), cB + hstep + kstep);
    PG8_WAIT_V(6); PG8_BAR;
    for (;;) {
        const bool has_next = S.next(ui + 1, nxt);
        const char* nB = has_next ? S.b_base(nxt) : cB;
        if (has_next) PG8_OFFS(vn, nxt); else {
#pragma unroll
            for (int _h = 0; _h < 2; ++_h)
#pragma unroll
                for (int _i = 0; _i < 2; ++_i) vn[_h][_i] = vc[_h][_i]; }
        for (int t = 0; t < nt; t += 2) {
            const bool last = (t == nt - 2);
            const size_t k1 = (size_t)(t + 1) * kstep, k2 = last ? 0 : (size_t)(t + 2) * kstep, k3 = k2 + kstep;
            const char* b2 = last ? nB : cB + (size_t)(t + 2) * kstep; const char* b3 = b2 + kstep;
            unsigned w0[2], w1[2];
#pragma unroll
            for (int _i = 0; _i < 2; ++_i) { w0[_i] = last ? vn[0][_i] : vc[0][_i]; w1[_i] = last ? vn[1][_i] : vc[1][_i]; }
            PG8_LDB(B0, 0, 0); PG8_LDB(B1, 0, 1); PG8_SCHED; PG8_LDA(At, 0, 0); PG8_STAGE_A(PG8_SA(1, 1), k1, vc[1]);
            PG8_WAIT_V(8); PG8_WAIT_L(0); PG8_BAR; PG8_MMA(0, 0, At, B0); PG8_MMA(0, 1, At, B1); PG8_BAR; PG8_SCHED;
            PG8_LDA(At, 0, 1); PG8_STAGE(PG8_SB(0, 0), b2); PG8_STAGE(PG8_SB(0, 1), b2 + hstep); PG8_STAGE_A(PG8_SA(0, 0), k2, w0);
            PG8_WAIT_V(8); PG8_WAIT_L(0); PG8_BAR; PG8_MMA(1, 0, At, B0); PG8_MMA(1, 1, At, B1); PG8_BAR; PG8_SCHED;
            PG8_LDB(B0, 1, 0); PG8_LDB(B1, 1, 1); PG8_SCHED; PG8_LDA(At, 1, 0); PG8_STAGE_A(PG8_SA(0, 1), k2, w1);
            PG8_WAIT_V(8); PG8_WAIT_L(0); PG8_BAR; PG8_MMA(0, 0, At, B0); PG8_MMA(0, 1, At, B1); PG8_BAR; PG8_SCHED;
            PG8_LDA(At, 1, 1); PG8_STAGE(PG8_SB(1, 0), b3); PG8_STAGE(PG8_SB(1, 1), b3 + hstep); PG8_STAGE_A(PG8_SA(1, 0), k3, w0);
            PG8_WAIT_V(8); PG8_WAIT_L(0); PG8_BAR; PG8_MMA(1, 0, At, B0); PG8_MMA(1, 1, At, B1); PG8_BAR; PG8_SCHED;
        }
        if (wr == 0) PG8_BAR;
        epi_apply(acc, cur, wr, wc, fr, fq, E, tid);
        if (!has_next) break;
#pragma unroll
        for (int a = 0; a < 2; ++a)
#pragma unroll
            for (int b = 0; b < 2; ++b)
#pragma unroll
                for (int m = 0; m < 4; ++m)
#pragma unroll
                    for (int n = 0; n < 2; ++n) acc[a][b][m][n] = (f32x4){0.f, 0.f, 0.f, 0.f};
        cur = nxt; cB = nB; ++ui;
#pragma unroll
        for (int _h = 0; _h < 2; ++_h)
#pragma unroll
            for (int _i = 0; _i < 2; ++_i) vc[_h][_i] = vn[_h][_i];
        if (wr == 1) PG8_BAR;
    }
    PG8_WAIT_V(0);
    PG8_BAR;
#undef PG8_OFFS
#undef PG8_STAGE_A
#undef PG8_SA
#undef PG8_SB
#undef PG8_STAGE
#undef PG8_LDA
#undef PG8_LDB
#undef PG8_MMA
#undef PG8_WAIT_V
#undef PG8_WAIT_L
#undef PG8_BAR
#undef PG8_SCHED
}
}
struct EpiQKVT { bf16* QB; bf16* KH; bf16* VT8; const float* SSP; const float* bias  ;
    static constexpr bool UNIT_END = false; typedef RowColCtx Ctx;
    __device__ __forceinline__ Ctx unit_ctx(int pm, int pn, int wr, int wc, int fr, int fq) const { Ctx c;
        if (pm < 68) { const float* b = bias + row_bm(pm * 256) * 3072;
#pragma unroll
            for (int ri = 0; ri < 8; ++ri) c.r[ri] = rstd_of(SSP, UNIT_ROW(pm, wr, fr, ri));
#pragma unroll
            for (int bj = 0; bj < 2; ++bj)
#pragma unroll
                for (int n = 0; n < 2; ++n) c.x[bj][n] = *(const f32x4*)(b + UNIT_COL(pn, wc, fq, bj, n));
        } else { const float* b = bias + row_bm(pn * 256) * 3072 + 2048;
#pragma unroll
            for (int ri = 0; ri < 8; ++ri) c.r[ri] = b[UNIT_ROW(pm - 68, wr, fr, ri)];
#pragma unroll
            for (int bj = 0; bj < 2; ++bj)
#pragma unroll
                for (int n = 0; n < 2; ++n)
#pragma unroll
                    for (int i = 0; i < 4; ++i) c.x[bj][n][i] = rstd_of(SSP, UNIT_COL(pn, wc, fq, bj, n) + i);
        }
        return c; }
    __device__ __forceinline__ void operator()(const Ctx& c, int row, int col, int ri, int bj, f32x4 v0, f32x4 v1) const {
        if (row < MT) {
            v0 = v0 * c.r[ri] + c.x[bj][0]; v1 = v1 * c.r[ri] + c.x[bj][1];
            if (col < 1024) { bf16* p = QB + (size_t)row * 1024 + col; st4bf(p, v0 * QSCALE); st4bf(p + 16, v1 * QSCALE); }
            else { const int cc = col - 1024, h = cc >> 6, d = cc & 63; bf16* p = KH + ((size_t)h * MT + row) * 64 + d; st4bf(p, v0); st4bf(p + 16, v1); }
        } else {
            const int ch = row - MT, h = ch >> 6, d = ch & 63;
            v0 = v0 * c.x[bj][0] + c.r[ri]; v1 = v1 * c.x[bj][1] + c.r[ri];
            bf16* p = VT8 + (((size_t)h * (MT / 8) + (col >> 3)) * 64 + d) * 8 + (col & 7); st4bf(p, v0);
            bf16* q = VT8 + (((size_t)h * (MT / 8) + ((col + 16) >> 3)) * 64 + d) * 8 + (col & 7); st4bf(q, v1);
        } } };

__device__ __forceinline__ void mods_phase(const Frame& F) {
    LAS float* sl = (LAS float*)F.lds;
    LAS float* red = sl + 5 * 1024;
    const int tid = F.tid;
    for (int i = tid; i < 5 * 1024; i += 512) { const int b = i >> 10, k = i & 1023; const float v = b < 4 ? F.in(I_C)[b * 1024 + k] : F.in(I_CCTX)[k]; sl[i] = v / (1.f + expf(-v)); }
    __syncthreads();
    const int l16 = tid & 15, kg = tid >> 4;
    for (int it = F.blk; it < 4 * 96; it += F.G) {
        const int layer = it / 96, cc = it % 96;
        const float* W = F.in(I_WMOD) + (size_t)layer * 1024 * 6144 + cc * 64 + l16 * 4;
        f32x4 acc[5];
#pragma unroll
        for (int b = 0; b < 5; ++b) acc[b] = (f32x4){0.f, 0.f, 0.f, 0.f};
#pragma unroll 8
        for (int kk = 0; kk < 32; ++kk) { const int k = kg * 32 + kk; const f32x4 w = *(const f32x4*)(W + (size_t)k * 6144);
#pragma unroll
            for (int b = 0; b < 5; ++b) acc[b] += sl[b * 1024 + k] * w; }
#pragma unroll
        for (int b = 0; b < 5; ++b) *(LAS f32x4*)(red + ((kg * 5 + b) * 64 + l16 * 4)) = acc[b];
        __syncthreads();
        if (tid < 320) { const int b = tid >> 6, col = tid & 63; float s = 0.f;
            for (int g = 0; g < 32; ++g) s += red[(g * 5 + b) * 64 + col];
            F.mods()[((size_t)layer * 5 + b) * 6144 + cc * 64 + col] = s + F.in(I_BMOD)[layer * 6144 + cc * 64 + col]; }
        __syncthreads();
    }
}
__device__ __forceinline__ void rpb_phase(const Frame& F) {
    const int gt = F.blk * 512 + F.tid, ngt = F.G * 512;
    for (int i = gt; i < 2 * 16 * 15 * 64; i += ngt) { const int c = i & 63, r = (i >> 6) % 15, h = (i / (64 * 15)) & 15, jj = i / (64 * 15 * 16);
        const int dc = c - 32; float v = 0.f; if (dc >= -15 && dc <= 15) v = F.in(I_RPB)[((size_t)(jj * 16 + h) * 15 + r) * 31 + dc + 15] * LOG2E;
        F.rpbt()[i] = v; }
}
__device__ __forceinline__ void poolfold_phase(const Frame& F, int j) {
    const float* pw = F.in(I_POOLW) + (size_t)j * 4 * 128 * 128; const float* ps = F.in(I_POOLS) + (size_t)j * 512; const float* wo = F.in(I_WOUT) + (size_t)j * 1024 * 1024 + (size_t)512 * 1024;
    bf16* dst = F.wb(j) + WB_WOUT;
    const int gt = F.blk * 512 + F.tid, ngt = F.G * 512;
    for (int it = gt; it < 4 * 32 * 1024; it += ngt) {
        const int n = it & 1023, c4 = (it >> 10) & 31, g = it >> 15;
        const float* pr = pw + ((size_t)g * 128 + c4 * 4) * 128; const float* wr = wo + (size_t)g * 128 * 1024 + n; const float* sr = ps + g * 128;
        float acc[4] = {0.f, 0.f, 0.f, 0.f};
#pragma unroll 4
        for (int d = 0; d < 128; ++d) { const float w = wr[(size_t)d * 1024] * sr[d];
#pragma unroll
            for (int q = 0; q < 4; ++q) acc[q] += pr[q * 128 + d] * w; }
        u32x2 o; o.x = cvt_pk_bf16(acc[0], acc[1]); o.y = cvt_pk_bf16(acc[2], acc[3]);
        *(u32x2*)(dst + (size_t)n * 1024 + 512 + g * 128 + c4 * 4) = o;
    }
}
__device__ __forceinline__ void bias_phase(const Frame& F, int j) {
    const int lane = F.lane;
    for (int it = F.gw; it < 5632 + 3072; it += F.ngw) {
        const bool gu = it < 5632; const int n = gu ? it : it - 5632;
        const bf16* wrow = F.wb(j) + (gu ? WB_WGU : WB_WQKV) + (size_t)n * 1024;
        const float* sh = F.mods() + (size_t)(gu ? 2 * j : 2 * j + 1) * 5 * 6144 + (gu ? 3 * 1024 : 0);
        float w[16];
#pragma unroll
        for (int jj = 0; jj < 2; ++jj) { const bf16x8 v = *(const bf16x8*)(wrow + 8 * lane + 512 * jj);
#pragma unroll
            for (int e = 0; e < 8; ++e) w[8 * jj + e] = bf2f(v[e]); }
        float* out = F.bias() + (gu ? BIAS_GU + (size_t)j * 5 * 5632 : BIAS_QKV + (size_t)j * 5 * 3072);
#pragma unroll
        for (int bm = 0; bm < 5; ++bm) { float s = 0.f;
#pragma unroll
            for (int jj = 0; jj < 2; ++jj) { const f32x4 a = *(const f32x4*)(sh + bm * 6144 + 8 * lane + 512 * jj), b = *(const f32x4*)(sh + bm * 6144 + 8 * lane + 512 * jj + 4);
                s += (a[0] * w[8 * jj] + a[1] * w[8 * jj + 1]) + (a[2] * w[8 * jj + 2] + a[3] * w[8 * jj + 3]) + (b[0] * w[8 * jj + 4] + b[1] * w[8 * jj + 5]) + (b[2] * w[8 * jj + 6] + b[3] * w[8 * jj + 7]); }
            s = wave_sum(s);
            if (lane == 0) out[bm * (gu ? 5632 : 3072) + n] = s; }
    }
}
__device__ __forceinline__ void conv_tile(const float* src, int ldn, bf16* dst, int pitch, int k0, int n0, int mode, LAS unsigned* T, int lane) {
    const int c4 = (lane & 15) * 4;
#pragma unroll
    for (int it = 0; it < 8; ++it) { const int r = it * 4 + (lane >> 4);
        const f32x4 a = __builtin_nontemporal_load((const f32x4*)(src + (size_t)(k0 + 2 * r) * ldn + n0 + c4)), b = __builtin_nontemporal_load((const f32x4*)(src + (size_t)(k0 + 2 * r + 1) * ldn + n0 + c4));
#pragma unroll
        for (int c = 0; c < 4; ++c) T[(c4 + c) * 33 + r] = cvt_pk_bf16(a[c], b[c]); }
    asm volatile("s_waitcnt lgkmcnt(0)" ::: "memory");
#pragma unroll
    for (int it = 0; it < 8; ++it) { const int n = it * 8 + (lane >> 3), q = lane & 7; const int gn = n0 + n;
        const int drow = mode == 0 ? gn : ((gn >> 4) << 5) + (gn & 15) + (mode == 2 ? 16 : 0);
        u32x4 v; v.x = T[n * 33 + 4 * q]; v.y = T[n * 33 + 4 * q + 1]; v.z = T[n * 33 + 4 * q + 2]; v.w = T[n * 33 + 4 * q + 3];
        __builtin_nontemporal_store(v, (u32x4*)(dst + (size_t)drow * pitch + k0 + 8 * q)); }
    asm volatile("s_waitcnt lgkmcnt(0)" ::: "memory");
}
constexpr int CT0 = 512, CT1 = CT0 + 128, CT2 = CT1 + 704, CT3 = CT2 + 704, CT4 = CT3 + 704, CT5 = CT4 + 768, CT6 = CT5 + 256, CT7 = CT6 + 7168, CT8 = CT7 + 7168, CT9 = CT8 + 7168;
constexpr int CQ_P0M = CT9 - CT6, CQ_P1D = CQ_P0M + CT6, CQ_END = CQ_P1D + (CT9 - CT6);
static_assert(CQ_P0M % 8 == 0 && CQ_P1D % 8 == 0 && CQ_END % 8 == 0, "queue chunks");
__device__ __forceinline__ void conv_item(const Frame& F, int j, int it, LAS unsigned* T) {
    const float* src; int K, N, mode = 0, r; bf16* dst; size_t se = 0, de = 0; int tpe;
    if (it < CT0)      { r = it;       src = F.in(I_WIN) + (size_t)j * 1024 * 2048;  K = 1024; N = 2048; dst = F.wb(j) + WB_WIN; tpe = CT0; }
    else if (it < CT1) { r = it - CT0; src = F.in(I_WOUT) + (size_t)j * 1024 * 1024; K = 1024; N = 1024; dst = F.wb(j) + WB_WOUT; tpe = 128; }
    else if (it < CT2) { r = it - CT1; src = F.in(I_WFG) + (size_t)j * 1024 * DFF;   K = 1024; N = DFF; dst = F.wb(j) + WB_WGU; mode = 1; tpe = 704; }
    else if (it < CT3) { r = it - CT2; src = F.in(I_WFU) + (size_t)j * 1024 * DFF;   K = 1024; N = DFF; dst = F.wb(j) + WB_WGU; mode = 2; tpe = 704; }
    else if (it < CT4) { r = it - CT3; src = F.in(I_WFD) + (size_t)j * DFF * 1024;   K = DFF; N = 1024; dst = F.wb(j) + WB_WD; tpe = 704; }
    else if (it < CT5) { r = it - CT4; src = F.in(I_WQKV) + (size_t)j * 1024 * 3072; K = 1024; N = 3072; dst = F.wb(j) + WB_WQKV; tpe = 768; }
    else if (it < CT6) { r = it - CT5; src = F.in(I_WONA) + (size_t)j * 1024 * 1024; K = 1024; N = 1024; dst = F.wb(j) + WB_WO; tpe = 256; }
    else if (it < CT7) { r = it - CT6; src = F.in(I_WEG) + (size_t)j * NE * 1024 * DFE; K = 1024; N = DFE; dst = F.wb(j) + WB_WEGU; mode = 1; tpe = 896; se = (size_t)1024 * DFE; de = (size_t)7168 * 1024; }
    else if (it < CT8) { r = it - CT7; src = F.in(I_WEU) + (size_t)j * NE * 1024 * DFE; K = 1024; N = DFE; dst = F.wb(j) + WB_WEGU; mode = 2; tpe = 896; se = (size_t)1024 * DFE; de = (size_t)7168 * 1024; }
    else               { r = it - CT8; src = F.in(I_WED) + (size_t)j * NE * DFE * 1024; K = DFE; N = 1024; dst = F.wb(j) + WB_WED; tpe = 896; se = (size_t)DFE * 1024; de = (size_t)1024 * DFE; }
    const int e = r / tpe, rr = r % tpe, nb = N / 64, kb = rr / nb, nbi = rr % nb;
    conv_tile(src + e * se, N, dst + e * de, K, kb * 64, nbi * 64, mode, T, F.lane);
}
__device__ __forceinline__ void conv_dense0(const Frame& F) {
    LAS unsigned* T = (LAS unsigned*)(F.lds + F.wave * 8448);
    for (int it = F.gw; it < CT6; it += F.ngw) conv_item(F, 0, it, T);
}
__device__ __forceinline__ void conv_queue(const Frame& F, int limit, int max_chunks) {
    LAS unsigned* T = (LAS unsigned*)(F.lds + F.wave * 8448);
    volatile LAS int* qslot = (volatile LAS int*)(F.lds + 8 * 8448);
    unsigned* head = F.ctl() + CW_QHEAD;
    for (int n = 0; n < max_chunks; ++n) {
        __syncthreads();
        if (F.tid == 0) { int v = -1; if ((int)__hip_atomic_load(head, __ATOMIC_RELAXED, __HIP_MEMORY_SCOPE_AGENT) < limit) v = (int)__hip_atomic_fetch_add(head, 8u, __ATOMIC_RELAXED, __HIP_MEMORY_SCOPE_AGENT); *qslot = v; }
        __syncthreads();
        const int q0 = *qslot;
        if (q0 < 0 || q0 >= CQ_END) break;
        const int q = q0 + F.wave;
        if (q < CQ_P0M) conv_item(F, 0, CT6 + q, T); else if (q < CQ_P1D) conv_item(F, 1, q - CQ_P0M, T); else conv_item(F, 1, CT6 + (q - CQ_P1D), T);
    }
    __syncthreads();
}
__device__ __forceinline__ bool tail_idle(int nwg, int G, int c) { const int mine = c < nwg ? (nwg - c + G - 1) / G : 0; return mine < (nwg + G - 1) / G; }

__device__ __forceinline__ f32x4 bf4_to_f32(u32x2 u) { return (f32x4){__uint_as_float(u.x << 16), __uint_as_float(u.x & 0xffff0000u), __uint_as_float(u.y << 16), __uint_as_float(u.y & 0xffff0000u)}; }
__device__ __forceinline__ f32x4 moe_row4(const Frame& F, int rr, int c) {
    return bf4_to_f32(*(const u32x2*)(F.YPAIR() + (size_t)rr * D + c)) + bf4_to_f32(*(const u32x2*)(F.YPB() + (size_t)rr * D + c));
}
template <bool FIRST, bool COMBINE, bool ROUTER, bool FINAL>
__device__ __forceinline__ void norm_phase(const Frame& F, int Mrows, const float* g, const float* modbase  , int shift_idx, const float* prev_gate  ,
                                           const float* wr  , unsigned* cnt  ) {
    const int lane = F.lane;
    int2* tok_e = (int2*)F.tok(); int2* tok_pos = tok_e + MT; float2* tok_w = (float2*)(tok_pos + MT); int* rowsrc = (int*)(F.ws() + WS_TOK + 2 * MiB);
    constexpr int NR = 2;
    LAS int* lcnt = (LAS int*)F.lds; LAS int* lbase = lcnt + 8; LAS int* rec = lcnt + 16 + F.wave * 64;
    int nrec = 0;
    if (ROUTER) { if (F.tid < 8) lcnt[F.tid] = 0; __syncthreads(); }
    MoeTiles mtc; if (COMBINE) mtc.init(cnt);
    for (int row0 = F.gw * NR; row0 < Mrows; row0 += F.ngw * NR) {
        f32x4 v[NR][4];
#pragma unroll
        for (int q = 0; q < NR; ++q) { const int row = row0 + q;
            const float* src = FIRST ? (row < ML ? F.in(I_X) + (size_t)row * D : F.in(I_CTX) + (size_t)(row - ML) * D) : F.H() + (size_t)row * D;
#pragma unroll
            for (int jj = 0; jj < 4; ++jj) v[q][jj] = *(const f32x4*)(src + 4 * lane + 256 * jj); }
        if (COMBINE) {
#pragma unroll
            for (int q = 0; q < NR; ++q) { const int row = row0 + q; const int bm = row_bm(row);
                const int2 ee = tok_e[row], pp = tok_pos[row]; const int2 rr = make_int2(mtc.row_offset(ee.x) + pp.x, mtc.row_offset(ee.y) + pp.y); const float2 ww = tok_w[row];
                const float* pg = prev_gate + bm * 6144;
#pragma unroll
                for (int jj = 0; jj < 4; ++jj) { const int c = 4 * lane + 256 * jj; const f32x4 gg = *(const f32x4*)(pg + c);
                    const f32x4 a = moe_row4(F, rr.x, c), b = moe_row4(F, rr.y, c);
                    v[q][jj] += gg * (ww.x * a + ww.y * b); } }
        }
#pragma unroll
        for (int q = 0; q < NR; ++q) {
            const int row = row0 + q; const int bm = row_bm(row);
            if ((FIRST || COMBINE) && !FINAL) {
#pragma unroll
                for (int jj = 0; jj < 4; ++jj) *(f32x4*)(F.H() + (size_t)row * D + 4 * lane + 256 * jj) = v[q][jj];
            }
            float ss = 0.f;
#pragma unroll
            for (int jj = 0; jj < 4; ++jj) ss += (v[q][jj][0] * v[q][jj][0] + v[q][jj][1] * v[q][jj][1]) + (v[q][jj][2] * v[q][jj][2] + v[q][jj][3] * v[q][jj][3]);
            ss = wave_sum(ss);
            const float rstd = 1.0f / sqrtf(ss * (1.0f / D) + EPS);
            if (FINAL) {
#pragma unroll
                for (int jj = 0; jj < 4; ++jj) { const int c = 4 * lane + 256 * jj; *(f32x4*)(F.out() + (size_t)row * D + c) = v[q][jj] * rstd * *(const f32x4*)(g + c); }
                continue;
            }
            const float* sh = modbase + bm * 6144 + shift_idx * 1024; const float* sc = sh + 1024;
            float lg[NE];
#pragma unroll
            for (int e = 0; e < NE; ++e) lg[e] = 0.f;
#pragma unroll
            for (int jj = 0; jj < 4; ++jj) { const int c = 4 * lane + 256 * jj;
                const f32x4 y = v[q][jj] * rstd * *(const f32x4*)(g + c);
                const f32x4 a = y * (1.0f + *(const f32x4*)(sc + c)) + *(const f32x4*)(sh + c);
                u32x2 w; w.x = cvt_pk_bf16(a[0], a[1]); w.y = cvt_pk_bf16(a[2], a[3]);
                *(u32x2*)(F.AF() + (size_t)row * D + c) = w;
                if (ROUTER) {
#pragma unroll
                    for (int i = 0; i < 4; ++i) { const f32x4 w0 = *(const f32x4*)(wr + (size_t)(c + i) * 8), w1 = *(const f32x4*)(wr + (size_t)(c + i) * 8 + 4);
                        lg[0] += a[i] * w0[0]; lg[1] += a[i] * w0[1]; lg[2] += a[i] * w0[2]; lg[3] += a[i] * w0[3]; lg[4] += a[i] * w1[0]; lg[5] += a[i] * w1[1]; lg[6] += a[i] * w1[2]; lg[7] += a[i] * w1[3]; }
                }
            }
            if (ROUTER) {
#pragma unroll
                for (int e = 0; e < NE; ++e) lg[e] = wave_sum(lg[e]);
                int e0 = 0; float v0 = lg[0];
#pragma unroll
                for (int e = 1; e < NE; ++e) if (lg[e] > v0) { v0 = lg[e]; e0 = e; }
                int e1 = -1; float v1 = -3.0e38f;
#pragma unroll
                for (int e = 0; e < NE; ++e) if (e != e0 && lg[e] > v1) { v1 = lg[e]; e1 = e; }
                const float t = __expf(v1 - v0), w0 = 1.0f / (1.0f + t), w1 = t / (1.0f + t);
                if (lane == 0) {
                    const int p0 = __hip_atomic_fetch_add(lcnt + e0, 1, __ATOMIC_RELAXED, __HIP_MEMORY_SCOPE_WORKGROUP);
                    const int p1 = __hip_atomic_fetch_add(lcnt + e1, 1, __ATOMIC_RELAXED, __HIP_MEMORY_SCOPE_WORKGROUP);
                    rec[nrec * 4 + 0] = e0; rec[nrec * 4 + 1] = e1; rec[nrec * 4 + 2] = p0; rec[nrec * 4 + 3] = p1;
                    tok_e[row] = make_int2(e0, e1); tok_w[row] = make_float2(w0, w1);
                }
                ++nrec;
            }
        }
    }
    if (ROUTER) {
        __syncthreads();
        if (F.tid < 8) lbase[F.tid] = (int)__hip_atomic_fetch_add(cnt + F.tid, (unsigned)lcnt[F.tid], __ATOMIC_RELAXED, __HIP_MEMORY_SCOPE_AGENT);
        __syncthreads();
        if (lane < nrec) {
            const int row = F.gw * NR + (lane / NR) * F.ngw * NR + (lane % NR);
            const int e0 = rec[lane * 4 + 0], e1 = rec[lane * 4 + 1], p0 = lbase[e0] + rec[lane * 4 + 2], p1 = lbase[e1] + rec[lane * 4 + 3];
            tok_pos[row] = make_int2(p0, p1); rowsrc[(size_t)e0 * MT + p0] = row; rowsrc[(size_t)e1 * MT + p1] = row;
        }
    }
}

template <int WIN>
__device__ __forceinline__ void pool_rows8(const bf16* U, bf16* Y1, int r0, int t0, int L, int c0) {
    constexpr int A = WIN / 2, NRW = 8 + WIN - 1;
    bf16x8 raw[NRW];
#pragma unroll
    for (int k = 0; k < NRW; ++k) { const int tt = t0 - A + k; raw[k] = (bf16x8){0, 0, 0, 0, 0, 0, 0, 0};
        if (tt >= 0 && tt < L) raw[k] = *(const bf16x8*)(U + (size_t)(r0 - A + k) * 2048 + 1536 + c0); }
#pragma unroll
    for (int i = 0; i < 8; ++i) {
        float s[8];
#pragma unroll
        for (int e = 0; e < 8; ++e) s[e] = 0.f;
#pragma unroll
        for (int k = 0; k < WIN; ++k)
#pragma unroll
            for (int e = 0; e < 8; ++e) s[e] += bf2f(raw[i + k][e]);
        const int t = t0 + i, lo = max(t - A, 0), hi = min(t + (WIN - 1 - A), L - 1); const float inv = 1.0f / (float)(hi - lo + 1);
        float d[8];
#pragma unroll
        for (int e = 0; e < 8; ++e) d[e] = s[e] * inv - bf2f(raw[i + A][e]);
        u32x4 w; w.x = cvt_pk_bf16(d[0], d[1]); w.y = cvt_pk_bf16(d[2], d[3]); w.z = cvt_pk_bf16(d[4], d[5]); w.w = cvt_pk_bf16(d[6], d[7]);
        *(u32x4*)(Y1 + (size_t)(r0 + i) * D + 512 + c0) = w;
    }
}
__device__ __forceinline__ void conv_rows8(const bf16* U, bf16* Y1, const float* cw, int r0, int t0, int L, int c0) {
    bf16x8 gc[10], vl[10], gb[8];
#pragma unroll
    for (int k = 0; k < 10; ++k) { const int tt = t0 - 1 + k; gc[k] = (bf16x8){0, 0, 0, 0, 0, 0, 0, 0}; vl[k] = gc[k];
        if (tt >= 0 && tt < L) { const bf16* ur = U + (size_t)(r0 - 1 + k) * 2048; gc[k] = *(const bf16x8*)(ur + 512 + c0); vl[k] = *(const bf16x8*)(ur + 1024 + c0); } }
#pragma unroll
    for (int i = 0; i < 8; ++i) gb[i] = *(const bf16x8*)(U + (size_t)(r0 + i) * 2048 + c0);
    f32x4 w[3][2];
#pragma unroll
    for (int k = 0; k < 3; ++k) { w[k][0] = *(const f32x4*)(cw + k * 512 + c0); w[k][1] = *(const f32x4*)(cw + k * 512 + c0 + 4); }
#pragma unroll
    for (int i = 0; i < 8; ++i) {
        float o[8];
#pragma unroll
        for (int e = 0; e < 8; ++e) o[e] = 0.f;
#pragma unroll
        for (int k = 0; k < 3; ++k)
#pragma unroll
            for (int e = 0; e < 8; ++e) o[e] += (bf2f(gc[i + k][e]) * bf2f(vl[i + k][e])) * w[k][e >> 2][e & 3];
        u32x4 y; y.x = cvt_pk_bf16(bf2f(gb[i][0]) * o[0], bf2f(gb[i][1]) * o[1]); y.y = cvt_pk_bf16(bf2f(gb[i][2]) * o[2], bf2f(gb[i][3]) * o[3]);
        y.z = cvt_pk_bf16(bf2f(gb[i][4]) * o[4], bf2f(gb[i][5]) * o[5]); y.w = cvt_pk_bf16(bf2f(gb[i][6]) * o[6], bf2f(gb[i][7]) * o[7]);
        *(u32x4*)(Y1 + (size_t)(r0 + i) * D + c0) = y;
    }
}
__device__ __forceinline__ void mix_phase(const Frame& F, int j) {
    const bf16* U = F.BIG(); bf16* Y1 = F.Y1(); const float* cw = F.in(I_CONVW) + (size_t)j * 3 * 512;
    const int sub = F.lane >> 4, c16 = F.lane & 15;
    for (int wi = F.gw; wi < 8 * (MT / 32); wi += F.ngw) {
        const int cg = wi & 7, r0 = (wi >> 3) * 32 + sub * 8;
        int t0, L; if (r0 < ML) { t0 = r0 & 4095; L = SEQ; } else { t0 = (r0 - ML) & 255; L = CTXL; }
        const int c0 = ((cg & 3) * 16 + c16) * 8;
        if (cg < 4) conv_rows8(U, Y1, cw, r0, t0, L, c0);
        else if (cg == 4) pool_rows8<2>(U, Y1, r0, t0, L, c0);
        else if (cg == 5) pool_rows8<4>(U, Y1, r0, t0, L, c0);
        else if (cg == 6) pool_rows8<8>(U, Y1, r0, t0, L, c0);
        else pool_rows8<16>(U, Y1, r0, t0, L, c0);
    }
}

struct AttnState { f32x4 O[4]; float m, l; };
struct KVFrag { bf16x8 kf[2][2], vf[4]; };
__device__ __forceinline__ void attn_load(KVFrag& f, const bf16* kp  , const bf16* vp  ) {
#pragma unroll
    for (int t = 0; t < 2; ++t)
#pragma unroll
        for (int ks = 0; ks < 2; ++ks) f.kf[t][ks] = *(const bf16x8*)(kp + t * 4 * 64 + 32 * ks);
#pragma unroll
    for (int dt = 0; dt < 4; ++dt) f.vf[dt] = *(const bf16x8*)(vp + dt * 16 * 8);
}
template <bool LOCAL>
__device__ __forceinline__ void attn_compute(AttnState& st, const KVFrag& f, const bf16x8 (&qf)[2], const LAS float* brow, const float (&maskadd)[8]) {
    f32x4 S0 = (f32x4){0.f, 0.f, 0.f, 0.f}, S1 = (f32x4){0.f, 0.f, 0.f, 0.f};
    S0 = __builtin_amdgcn_mfma_f32_16x16x32_bf16(f.kf[0][0], qf[0], S0, 0, 0, 0); S0 = __builtin_amdgcn_mfma_f32_16x16x32_bf16(f.kf[0][1], qf[1], S0, 0, 0, 0);
    S1 = __builtin_amdgcn_mfma_f32_16x16x32_bf16(f.kf[1][0], qf[0], S1, 0, 0, 0); S1 = __builtin_amdgcn_mfma_f32_16x16x32_bf16(f.kf[1][1], qf[1], S1, 0, 0, 0);
    float s[8];
#pragma unroll
    for (int i = 0; i < 4; ++i) { s[i] = S0[i]; s[4 + i] = S1[i]; }
    if (LOCAL) {
#pragma unroll
        for (int i = 0; i < 8; ++i) s[i] += brow[i] + maskadd[i];
    }
    float mx = fmaxf(fmaxf(fmaxf(s[0], s[1]), fmaxf(s[2], s[3])), fmaxf(fmaxf(s[4], s[5]), fmaxf(s[6], s[7])));
    mx = fmaxf(mx, __shfl_xor(mx, 16)); mx = fmaxf(mx, __shfl_xor(mx, 32));
    const float mnew = fmaxf(st.m, mx), alpha = __builtin_amdgcn_exp2f(st.m - mnew);
    st.m = mnew;
    float p[8], ps = 0.f;
#pragma unroll
    for (int i = 0; i < 8; ++i) { p[i] = __builtin_amdgcn_exp2f(s[i] - mnew); ps += p[i]; }
    st.l = st.l * alpha + ps;
    u32x4 pw; pw.x = cvt_pk_bf16(p[0], p[1]); pw.y = cvt_pk_bf16(p[2], p[3]); pw.z = cvt_pk_bf16(p[4], p[5]); pw.w = cvt_pk_bf16(p[6], p[7]);
    const bf16x8 pb = __builtin_bit_cast(bf16x8, pw);
#pragma unroll
    for (int dt = 0; dt < 4; ++dt) { st.O[dt] = st.O[dt] * alpha; st.O[dt] = __builtin_amdgcn_mfma_f32_16x16x32_bf16(f.vf[dt], pb, st.O[dt], 0, 0, 0); }
}
__device__ __forceinline__ void attn_finish(AttnState& st, bf16* orow  ) {
    float l = st.l; l += __shfl_xor(l, 16); l += __shfl_xor(l, 32);
    const float inv = 1.0f / l;
#pragma unroll
    for (int dt = 0; dt < 4; ++dt) { const f32x4 o = st.O[dt] * inv; u32x2 w; w.x = cvt_pk_bf16(o[0], o[1]); w.y = cvt_pk_bf16(o[2], o[3]); *(u32x2*)(orow + 16 * dt) = w; }
}
template <int NL>
__device__ __forceinline__ void attn_unit(const bf16* kl, const bf16* vl, const bf16* kc, const bf16* vc, const bf16x8 (&qf)[2], const LAS float* brow0  ,
                                          const float (&maskadd)[8], bf16* orow) {
    constexpr int NC = NL + 8;
    AttnState st;
#pragma unroll
    for (int dt = 0; dt < 4; ++dt) st.O[dt] = (f32x4){0.f, 0.f, 0.f, 0.f};
    st.m = -1.0e30f; st.l = 0.f;
    KVFrag fr[3];
#define ATT_KP(c) ((c) < NL ? kl + (c) * 64 * 64 : kc + ((c) - NL) * 32 * 64)
#define ATT_VP(c) ((c) < NL ? vl + (c) * 8 * 512 : vc + ((c) - NL) * 4 * 512)
    attn_load(fr[0], ATT_KP(0), ATT_VP(0)); attn_load(fr[1], ATT_KP(1), ATT_VP(1));
#pragma unroll
    for (int c = 0; c < NC; ++c) {
        if (c + 2 < NC) attn_load(fr[(c + 2) % 3], ATT_KP(c + 2), ATT_VP(c + 2));
        __builtin_amdgcn_sched_barrier(0);
        if (c < NL) attn_compute<true>(st, fr[c % 3], qf, brow0 + c * 64, maskadd); else attn_compute<false>(st, fr[c % 3], qf, brow0, maskadd);
        __builtin_amdgcn_sched_barrier(0);
    }
#undef ATT_KP
#undef ATT_VP
    attn_finish(st, orow);
}
__device__ __forceinline__ void attn_fast(const Frame& F, const float* rpbt, bool do_ctx) {
    const bf16* QB = F.BIG(); const bf16* KH = F.BIG() + (size_t)MT * 1024; const bf16* VT8 = F.VT(); bf16* AO = F.Y1();
    LAS float* tbl = (LAS float*)F.lds;
    const int lane = F.lane, fr = lane & 15, fq = lane >> 4, wave = F.wave;
    const int krow = 8 * (fr >> 2) + (fr & 3);
    const int per = (2048 + F.G - 1) / F.G;
    int cur_h = -1;
    const int vb = (F.G % 8 == 0) ? (F.blk % 8) * (F.G / 8) + F.blk / 8 : F.blk;
    const int bu_end = min((vb + 1) * per, 2048);
    for (int bu = vb * per; bu < bu_end; ++bu) {
        const int bh = bu >> 5, rp = bu & 31, b = bh >> 4, h = bh & 15;
        if (h != cur_h) { __syncthreads(); for (int i = F.tid; i < 15 * 64; i += 512) tbl[i] = rpbt[h * 15 * 64 + i]; cur_h = h; __syncthreads(); }
        const int r = 2 * rp + (wave >> 2), jb = wave & 3;
        const int w0 = jb == 0 ? 0 : (jb == 1 ? 8 : (jb == 2 ? 24 : 32));
        const int jq = 16 * jb + fr, cs = min(max(jq - 8, 0), 48), rs = min(max(r - 4, 0), 56);
        const int qrow = b * 4096 + r * 64 + jq;
        bf16x8 qf[2];
#pragma unroll
        for (int ks = 0; ks < 2; ++ks) qf[ks] = *(const bf16x8*)(QB + (size_t)qrow * 1024 + h * 64 + 32 * ks + 8 * fq);
        float maskadd[8];
#pragma unroll
        for (int i = 0; i < 8; ++i) { const int col = w0 + 8 * fq + i; maskadd[i] = (col >= cs && col < cs + 16) ? 0.f : -1.0e30f; }
        const int boff = w0 + 8 * fq - jq + 32;
        const int tl = b * 4096 + rs * 64 + w0, tc = ML + b * 256;
        const bf16* kl = KH + ((size_t)h * MT + tl + krow) * 64 + 8 * fq;
        const bf16* vl = VT8 + (((size_t)h * (MT / 8) + (tl >> 3) + fq) * 64 + fr) * 8;
        const bf16* kc = KH + ((size_t)h * MT + tc + krow) * 64 + 8 * fq;
        const bf16* vc = VT8 + (((size_t)h * (MT / 8) + (tc >> 3) + fq) * 64 + fr) * 8;
        attn_unit<8>(kl, vl, kc, vc, qf, tbl + (rs - r + 7) * 64 + boff, maskadd, AO + (size_t)qrow * D + h * 64 + 4 * fq);
    }
    if (do_ctx) {
        for (int wu = F.gw; wu < 1024; wu += F.ngw) {
            const int bh = wu >> 4, qb = wu & 15, b = bh >> 4, h = bh & 15;
            const int qrow = ML + b * 256 + 16 * qb + fr;
            bf16x8 qf[2];
#pragma unroll
            for (int ks = 0; ks < 2; ++ks) qf[ks] = *(const bf16x8*)(QB + (size_t)qrow * 1024 + h * 64 + 32 * ks + 8 * fq);
            float maskadd[8];
#pragma unroll
            for (int i = 0; i < 8; ++i) maskadd[i] = 0.f;
            const int tc = ML + b * 256;
            const bf16* kc = KH + ((size_t)h * MT + tc + krow) * 64 + 8 * fq;
            const bf16* vc = VT8 + (((size_t)h * (MT / 8) + (tc >> 3) + fq) * 64 + fr) * 8;
            attn_unit<0>(kc, vc, kc, vc, qf, tbl, maskadd, AO + (size_t)qrow * D + h * 64 + 4 * fq);
        }
    }
}

__global__ void __launch_bounds__(512, 2) fwd_kernel(Args args) {
    extern __shared__ __attribute__((aligned(16))) unsigned char lds_raw[];
    Frame F;
    F.lds = (LAS unsigned char*)lds_raw;
    F.renew();
    volatile LAS unsigned* MISC = (volatile LAS unsigned*)(F.lds + MISC_OFF);
    if (F.tid < 32) MISC[F.tid] = 0u;
    __syncthreads();
    XcdBarrier bar = xcd_barrier_post(F.ctl() + CW_BAR, MISC + 8);
#define GRID_BAR() do { xcd_barrier(bar); F.renew(); } while (0)
#define MODS(layer) (F.mods() + (size_t)(layer) * 5 * 6144)
#define CNT(jj) (F.ctl() + CW_CNT + 64 * (jj))
#define TAIL_CONV(nwg, q) do { if (tail_idle((nwg), F.G, F.blk)) conv_queue(F, CQ_END, (q)); } while (0)

    mods_phase(F); rpb_phase(F); poolfold_phase(F, 0); conv_dense0(F);
    GRID_BAR();

    for (int j = 0; j < 2; ++j) {
        const int le = 2 * j, lo = 2 * j + 1;
        const bool last = (j == 1);
        if (j == 0) norm_phase<true, false, false, false>(F, MT, F.in(I_GMIX) + le * D, MODS(le), 0, nullptr, nullptr, nullptr);
        else { norm_phase<false, true, false, false>(F, MT, F.in(I_GMIX) + le * D, MODS(le), 0, MODS(le - 1) + 5 * 1024, nullptr, CNT(j - 1));
               __syncthreads(); poolfold_phase(F, 1); conv_queue(F, CQ_P1D, 1 << 20); }
        GRID_BAR();
        { pg8::SchedStatic S; S.init(F.AF(), F.wb(j) + WB_WIN, MT, 2048, 1024, F.G, F.blk); EpiStoreBf16 E{F.BIG(), 2048}; pg8::gemm_phase(F.lds, F.tid, 1024, 1024, S, E); }
        TAIL_CONV(68 * 8, 3);
        GRID_BAR();
        mix_phase(F, j); bias_phase(F, j);
        GRID_BAR();
        { pg8::SchedStatic S; S.init(F.Y1(), F.wb(j) + WB_WOUT, MT, 1024, 1024, F.G, F.blk); EpiResGateNorm E{F.H(), MODS(le) + 2 * 1024, F.in(I_GFFN) + le * D, MODS(le) + 4 * 1024, F.AF(), F.ssp(2 * j), (LAS float*)(F.lds + PART_OFF)}; pg8::gemm_phase(F.lds, F.tid, 1024, 1024, S, E); }
        TAIL_CONV(68 * 4, 3);
        GRID_BAR();
        { pg8::SchedStatic S; S.init(F.AF(), F.wb(j) + WB_WGU, MT, 2 * DFF, 1024, F.G, F.blk); EpiSwiGLUNorm E{F.BIG(), DFF, F.ssp(2 * j), F.bias() + BIAS_GU + (size_t)j * 5 * 5632}; pg8::gemm_phase(F.lds, F.tid, 1024, 1024, S, E); }
        GRID_BAR();
        { pg8::SchedStatic S; S.init(F.BIG(), F.wb(j) + WB_WD, MT, 1024, DFF, F.G, F.blk); EpiResGateNorm E{F.H(), MODS(le) + 5 * 1024, F.in(I_GMIX) + lo * D, MODS(lo) + 1 * 1024, F.AF(), F.ssp(2 * j + 1), (LAS float*)(F.lds + PART_OFF)}; pg8::gemm_phase(F.lds, F.tid, DFF, DFF, S, E); }
        TAIL_CONV(68 * 4, 9);
        GRID_BAR();
        const int Mo = last ? ML : MT;
        { pg8::SchedQKVT S; S.AF = (const char*)F.AF(); S.WQK = (const char*)(F.wb(j) + WB_WQKV); S.WV = (const char*)(F.wb(j) + WB_WQKV + (size_t)2048 * 1024); S.G = F.G; S.c = F.blk; S.tstep = (size_t)256 * 1024 * 2;
          EpiQKVT E{F.BIG(), F.BIG() + (size_t)MT * 1024, F.VT(), F.ssp(2 * j + 1), F.bias() + BIAS_QKV + (size_t)j * 5 * 3072}; pg8::gemm_phase(F.lds, F.tid, 1024, 1024, S, E); }
        TAIL_CONV(pg8::SchedQKVT::NQK + pg8::SchedQKVT::NVT, 3);
        GRID_BAR();
        attn_fast(F, F.rpbt() + (size_t)j * 16 * 15 * 64, !last);
        GRID_BAR();
        { pg8::SchedStatic S; S.init(F.Y1(), F.wb(j) + WB_WO, Mo, 1024, 1024, F.G, F.blk); EpiResGate E{F.H(), MODS(lo) + 2 * 1024}; pg8::gemm_phase(F.lds, F.tid, 1024, 1024, S, E); }
        TAIL_CONV((Mo / 256) * 4, 3);
        GRID_BAR();
        norm_phase<false, false, true, false>(F, Mo, F.in(I_GFFN) + lo * D, MODS(lo), 3, nullptr, F.in(I_WR) + (size_t)j * 1024 * 8, CNT(j));
        conv_queue(F, j == 0 ? CQ_P0M : CQ_END, 1 << 20);
        GRID_BAR();
        { pg8::SchedMoe S; S.init(F.AF(), F.wb(j) + WB_WEGU, (size_t)7168 * 1024, CNT(j), (const int*)(F.ws() + WS_TOK + 2 * MiB), 2 * DFE, 1024, F.G, F.blk); EpiSwiGLU E{F.BIG(), DFE}; pg8::gemm_phase_gather(F.lds, F.tid, 1024, 1024, S, E); }
        GRID_BAR();
        { pg8::SchedDownK2 S; S.init(F.BIG(), F.wb(j) + WB_WED, CNT(j), F.G, F.blk); EpiDownK2 E{F.YPAIR(), F.YPB()}; pg8::gemm_phase(F.lds, F.tid, pg8::DOWN_KH, DFE, S, E);
          TAIL_CONV(S.nwg, 6); }
        GRID_BAR();
    }
    norm_phase<false, true, false, true>(F, ML, F.in(I_GFINAL), nullptr, 0, MODS(3) + 5 * 1024, nullptr, CNT(1));
}

extern "C" void kernel_launch(void* const* d_in, const int* in_sizes, int n_in, void* d_out, int out_size, void* d_ws, size_t ws_size, hipStream_t stream) {
    static int grid = 0;
    if (grid == 0) {
        if (n_in != 24 || out_size != ML * D || ws_size < WS_END) { fprintf(stderr, "kernel_launch: unexpected shapes (n_in %d out %d ws %zu)\n", n_in, out_size, ws_size); grid = -1; return; }
        int dev = 0, cus = 0, per_cu = 0;
        if (hipGetDevice(&dev) != hipSuccess || hipDeviceGetAttribute(&cus, hipDeviceAttributeMultiprocessorCount, dev) != hipSuccess) { grid = -1; return; }
        if (hipFuncSetAttribute((const void*)fwd_kernel, hipFuncAttributeMaxDynamicSharedMemorySize, LDS_BYTES) != hipSuccess) { fprintf(stderr, "kernel_launch: hipFuncSetAttribute failed\n"); grid = -1; return; }
        if (hipOccupancyMaxActiveBlocksPerMultiprocessor(&per_cu, (const void*)fwd_kernel, 512, LDS_BYTES) != hipSuccess || per_cu < 1) { fprintf(stderr, "kernel_launch: occupancy query says %d\n", per_cu); grid = -1; return; }
        (void)hipGetLastError();
        grid = cus;
    }
    if (grid < 0) return;
    if (hipMemsetAsync((char*)d_ws + WS_CTL, 0, CTL_BYTES, stream) != hipSuccess) return;
    Args a{};
    for (int i = 0; i < 24; ++i) a.in[i] = (const float*)d_in[i];
    a.out = (float*)d_out; a.ws = (unsigned char*)d_ws;
    hipLaunchKernelGGL(fwd_kernel, dim3(grid), dim3(512), LDS_BYTES, stream, a);
}
```

```cpp
#include <hip/hip_runtime.h>
#include <cstdio>
#include <cstdint>

#define GAS __attribute__((address_space(1)))
#define LAS __attribute__((address_space(3)))
typedef unsigned short bf16;
typedef short bf16x8 __attribute__((ext_vector_type(8)));
typedef float f32x4 __attribute__((ext_vector_type(4)));
typedef float f32x2 __attribute__((ext_vector_type(2)));
typedef unsigned u32x4 __attribute__((ext_vector_type(4)));
typedef unsigned u32x2 __attribute__((ext_vector_type(2)));

constexpr int D = 1024, NB = 4, SEQ = 4096, CTXL = 256, GW = 64;
constexpr int ML = NB * SEQ, MC = NB * CTXL, MT = ML + MC;
constexpr int DFF = 2816, NE = 8, DFE = 3584, NH = 16, HD = 64;
constexpr int MPAIR_MAX = 36864;
constexpr float EPS = 1e-6f;
constexpr float QSCALE = 0.18033688011112042f;
constexpr float LOG2E = 1.4426950408889634f;

constexpr size_t MiB = 1u << 20;
constexpr size_t WS_CTL = 0, CTL_BYTES = 1 * MiB;
constexpr size_t WS_MODS = 1 * MiB;
constexpr size_t WS_RPB = 2 * MiB;
constexpr size_t WS_TOK = 4 * MiB;
constexpr size_t WS_WB = 8 * MiB, WB_STRIDE = 200 * MiB;
constexpr size_t WS_H = 408 * MiB;
constexpr size_t WS_AF = 476 * MiB;
constexpr size_t WS_Y1 = 510 * MiB;
constexpr size_t WS_VT = 544 * MiB;
constexpr size_t WS_YPB = WS_Y1;
constexpr size_t WS_YPAIR = 582 * MiB;
constexpr size_t WS_BIG = 654 * MiB;
constexpr size_t WS_END = 906 * MiB;
static_assert(WS_YPB + (size_t)MPAIR_MAX * 1024 * 2 <= WS_YPAIR && WS_YPAIR + (size_t)MPAIR_MAX * 1024 * 2 <= WS_BIG, "expert output buffers");
constexpr size_t WB_WIN = 0;
constexpr size_t WB_WOUT = WB_WIN + (size_t)2048 * 1024;
constexpr size_t WB_WGU = WB_WOUT + (size_t)1024 * 1024;
constexpr size_t WB_WD = WB_WGU + (size_t)5632 * 1024;
constexpr size_t WB_WQKV = WB_WD + (size_t)1024 * 2816;
constexpr size_t WB_WO = WB_WQKV + (size_t)3072 * 1024;
constexpr size_t WB_WEGU = WB_WO + (size_t)1024 * 1024;
constexpr size_t WB_WED = WB_WEGU + (size_t)8 * 7168 * 1024;
constexpr size_t WB_END = WB_WED + (size_t)8 * 1024 * 3584;
static_assert(WB_END * 2 <= WB_STRIDE && WS_WB + 2 * WB_STRIDE <= WS_H, "weights fit");
static_assert(WS_BIG + (size_t)MPAIR_MAX * 3584 * 2 <= WS_END, "big fits");
constexpr int CW_CNT = 64;
constexpr int CW_QHEAD = 1024;
constexpr int CW_SS = 32768;
constexpr size_t WS_BIAS = WS_MODS + 512 * 1024;
constexpr int BIAS_GU = 0, BIAS_QKV = 2 * 5 * 5632;
constexpr int CW_BAR = 4096;

constexpr int LDS_BYTES = 147456;
constexpr int MISC_OFF = 131072 + 320;
constexpr int PART_OFF = 131072 + 1024;

#ifndef FAST_MASK
#define FAST_MASK 0x3FF
#endif
#define FAST(k) ((FAST_MASK >> (k)) & 1)
#ifndef REP_MASK
#define REP_MASK 0
#endif
#define REPN(k) (1 + ((REP_MASK >> (k)) & 1))
struct Args { const float* in[24]; float* out; unsigned char* ws; };

__device__ __forceinline__ unsigned cvt_pk_bf16(float lo, float hi) { unsigned r; asm("v_cvt_pk_bf16_f32 %0, %1, %2" : "=v"(r) : "v"(lo), "v"(hi)); return r; }
__device__ __forceinline__ float bf2f(short s) { return __uint_as_float(((unsigned)(unsigned short)s) << 16); }
__device__ __forceinline__ float bfu2f(bf16 s) { return __uint_as_float(((unsigned)s) << 16); }
__device__ __forceinline__ float wave_sum(float v) {
#pragma unroll
    for (int o = 1; o < 64; o <<= 1) v += __shfl_xor(v, o);
    return v;
}
__device__ __forceinline__ float wave_max(float v) {
#pragma unroll
    for (int o = 1; o < 64; o <<= 1) v = fmaxf(v, __shfl_xor(v, o));
    return v;
}
__device__ __forceinline__ float silu_f(float g) { return g * __builtin_amdgcn_rcpf(1.f + __builtin_amdgcn_exp2f(-1.4426950408889634f * g)); }

#define XB_TMO      128
#define XB_XCNT(j)  (256  + 64 * (j))
#define XB_XSUB(j)  (1280 + 64 * (j))
#define XB_XGEN(j)  (2304 + 64 * (j))
#define XB_TOP      3328
#define XB_TOPGEN   3392
#define XCD_BAR_WORDS 3456
#define XB_SPIN_CAP (1u << 22)
__device__ __forceinline__ unsigned xb_ld(unsigned* p)              { return __hip_atomic_load(p, __ATOMIC_RELAXED, __HIP_MEMORY_SCOPE_AGENT); }
__device__ __forceinline__ unsigned xb_add(unsigned* p, unsigned v) { return __hip_atomic_fetch_add(p, v, __ATOMIC_RELAXED, __HIP_MEMORY_SCOPE_AGENT); }
__device__ __forceinline__ unsigned xb_xcc_id() { return (unsigned)__builtin_amdgcn_s_getreg((3 << 11) | 20) & 0xFu; }
#define XB_SPIN(cond, bar) do { unsigned _sp = 0; while (cond) { __builtin_amdgcn_s_sleep(1); \
    if ((++_sp & 255u) == 0u) { if (xb_ld(&(bar)[XB_TMO])) break; if (_sp > XB_SPIN_CAP) { atomicAdd(&(bar)[XB_TMO], 1u); break; } } } } while (0)
struct XcdBarrier { unsigned* bar; unsigned x; volatile LAS unsigned* st; };
__device__ __forceinline__ XcdBarrier xcd_barrier_post(unsigned* bar, volatile LAS unsigned* st) {
    XcdBarrier b; b.bar = bar; b.x = xb_xcc_id(); b.st = st;
    if (threadIdx.x == 0) (void)xb_add(&bar[XB_XCNT(b.x)], 1u);
    return b;
}
__device__ __forceinline__ void xcd_barrier_complete(unsigned* bar, unsigned x, unsigned& nloc, unsigned& nx) {
    const unsigned G = gridDim.x * gridDim.y * gridDim.z;
    unsigned sum, cnt, mine, sp = 0u;
    for (;;) {
        sum = 0u; cnt = 0u; mine = 0u;
#pragma unroll
        for (unsigned j = 0; j < 16; ++j) { const unsigned c = xb_ld(&bar[XB_XCNT(j)]); sum += c; cnt += (c > 0u) ? 1u : 0u; mine = (j == x) ? c : mine; }
        if (sum == G) break;
        __builtin_amdgcn_s_sleep(1);
        if ((++sp & 255u) == 0u) { if (xb_ld(&bar[XB_TMO])) break; if (sp > XB_SPIN_CAP) { atomicAdd(&bar[XB_TMO], 1u); break; } }
    }
    nloc = mine > 0u ? mine : 1u; nx = cnt > 0u ? cnt : 1u;
}
__device__ __forceinline__ void xcd_barrier(const XcdBarrier& b) {
    asm volatile("s_waitcnt vmcnt(0)" ::: "memory");
    __syncthreads();
    if (threadIdx.x == 0) {
        unsigned* bar = b.bar;
        __builtin_amdgcn_s_waitcnt(0);
        unsigned nloc = b.st[0], nx = b.st[1];
        if (nloc == 0u) { xcd_barrier_complete(bar, b.x, nloc, nx); b.st[0] = nloc; b.st[1] = nx; }
        const unsigned old = xb_add(&bar[XB_XSUB(b.x)], 1u);
        const unsigned gen = old / nloc;
        if (old + 1u == (gen + 1u) * nloc) {
            __builtin_amdgcn_fence(__ATOMIC_RELEASE, "agent");
            asm volatile("s_waitcnt vmcnt(0)" ::: "memory");
            const unsigned og = xb_add(&bar[XB_TOP], 1u);
            const unsigned tg = og / nx;
            if (og + 1u == (tg + 1u) * nx) xb_add(&bar[XB_TOPGEN], 1u);
            else XB_SPIN(xb_ld(&bar[XB_TOPGEN]) == tg, bar);
            __builtin_amdgcn_fence(__ATOMIC_ACQUIRE, "agent");
            xb_add(&bar[XB_XGEN(b.x)], 1u);
            asm volatile("s_waitcnt vmcnt(0)" ::: "memory");
        } else {
            XB_SPIN(xb_ld(&bar[XB_XGEN(b.x)]) == gen, bar);
            __builtin_amdgcn_fence(__ATOMIC_ACQUIRE, "agent");
            asm volatile("s_waitcnt vmcnt(0)" ::: "memory");
        }
    }
    __syncthreads();
}

typedef const __attribute__((address_space(4))) Args* KArgs;
constexpr int KARG_OFF = 131072 + 320 + 64;
__device__ __forceinline__ KArgs kargs(LAS unsigned char* lds) { volatile LAS unsigned* m = (volatile LAS unsigned*)(lds + KARG_OFF);
    const unsigned lo = __builtin_amdgcn_readfirstlane(m[0]), hi = __builtin_amdgcn_readfirstlane(m[1]); return (KArgs)(((unsigned long long)hi << 32) | lo); }
struct Frame {
    LAS unsigned char* lds;
    KArgs K;
    int tid, lane, wave, blk, G, gw, ngw;
    __device__ __forceinline__ void renew() { K = kargs(lds); int t = threadIdx.x; asm volatile("" : "+v"(t)); tid = t; lane = t & 63; wave = __builtin_amdgcn_readfirstlane(t >> 6);
        int b = blockIdx.x, g = gridDim.x; asm volatile("" : "+s"(b), "+s"(g)); blk = b; G = g; gw = b * 8 + wave; ngw = g * 8; }
    __device__ __forceinline__ const float* in(int i) const { return K->in[i]; }
    __device__ __forceinline__ float* out() const { return K->out; }
    __device__ __forceinline__ unsigned char* ws() const { return K->ws; }
    __device__ __forceinline__ unsigned* ctl() const { return (unsigned*)(ws() + WS_CTL); }
    __device__ __forceinline__ float* mods() const { return (float*)(ws() + WS_MODS); }
    __device__ __forceinline__ float* ssp(int use) const { return (float*)(ws() + 2 * MiB + 512 * 1024) + (size_t)use * MT * 4; }
    __device__ __forceinline__ float* bias() const { return (float*)(ws() + WS_BIAS); }
    __device__ __forceinline__ float* rpbt() const { return (float*)(ws() + WS_RPB); }
    __device__ __forceinline__ int* tok() const { return (int*)(ws() + WS_TOK); }
    __device__ __forceinline__ bf16* wb(int j) const { return (bf16*)(ws() + WS_WB + (size_t)j * WB_STRIDE); }
    __device__ __forceinline__ float* H() const { return (float*)(ws() + WS_H); }
    __device__ __forceinline__ bf16* AF() const { return (bf16*)(ws() + WS_AF); }
    __device__ __forceinline__ bf16* Y1() const { return (bf16*)(ws() + WS_Y1); }
    __device__ __forceinline__ bf16* VT() const { return (bf16*)(ws() + WS_VT); }
    __device__ __forceinline__ bf16* YPAIR() const { return (bf16*)(ws() + WS_YPAIR); }
    __device__ __forceinline__ bf16* YPB() const { return (bf16*)(ws() + WS_YPB); }
    __device__ __forceinline__ bf16* BIG() const { return (bf16*)(ws() + WS_BIG); }
};
enum { I_X = 0, I_C, I_CTX, I_CCTX, I_WMOD, I_BMOD, I_GMIX, I_GFFN, I_GFINAL, I_WIN, I_CONVW, I_POOLW, I_POOLS, I_WOUT, I_WFG, I_WFU, I_WFD, I_WQKV, I_RPB, I_WONA, I_WR, I_WEG, I_WEU, I_WED };

__device__ __forceinline__ int row_bm(int row) { return row < ML ? (row >> 12) : 4; }

constexpr size_t WS_SSP = 2 * MiB + 512 * 1024;
struct NoCtx {};
struct ColCtx { f32x4 x[2][2]; };
struct RowColCtx { float r[8]; f32x4 x[2][2]; };
__device__ __forceinline__ void st8bf(bf16* p, f32x4 a, f32x4 b) { u32x4 w; w.x = cvt_pk_bf16(a[0], a[1]); w.y = cvt_pk_bf16(a[2], a[3]); w.z = cvt_pk_bf16(b[0], b[1]); w.w = cvt_pk_bf16(b[2], b[3]); *(u32x4*)p = w; }
__device__ __forceinline__ float rstd_of(const float* SSP, int row) { const f32x4 s = *(const f32x4*)(SSP + (size_t)row * 4); return 1.0f / sqrtf(((s[0] + s[1]) + (s[2] + s[3])) * (1.0f / D) + EPS); }
#define UNIT_ROW(pm, wr, fr, ri) ((pm) * 256 + ((ri) >> 2) * 128 + (wr) * 64 + (((ri) >> 1) & 1) * 32 + 8 * ((fr) >> 2) + 4 * ((ri) & 1) + ((fr) & 3))
#define UNIT_COL(pn, wc, fq, bj, n) ((pn) * 256 + (bj) * 128 + (wc) * 32 + 8 * (fq) + 4 * (n))
struct EpiStoreBf16 { bf16* O; int ldc; static constexpr bool UNIT_END = false; typedef NoCtx Ctx;
    __device__ __forceinline__ Ctx unit_ctx(int, int, int, int, int, int) const { return Ctx{}; }
    __device__ __forceinline__ void operator()(const Ctx&, int row, int col, int, f32x4 v00, f32x4 v01, f32x4 v10, f32x4 v11) const { bf16* p = O + (size_t)row * ldc + col; st8bf(p, v00, v01); st8bf(p + 128, v10, v11); } };
struct EpiDownK2 { bf16* Y0; bf16* Y1; static constexpr bool UNIT_END = false; typedef NoCtx Ctx;
    __device__ __forceinline__ Ctx unit_ctx(int, int, int, int, int, int) const { return Ctx{}; }
    __device__ __forceinline__ void operator()(const Ctx&, int row, int col, int, f32x4 v00, f32x4 v01, f32x4 v10, f32x4 v11) const {
        bf16* p = ((col >> 10) ? Y1 : Y0) + (size_t)row * 1024 + (col & 1023); st8bf(p, v00, v01); st8bf(p + 128, v10, v11); } };
struct EpiResGate { float* H; const float* gate; static constexpr bool UNIT_END = false; typedef ColCtx Ctx;
    __device__ __forceinline__ Ctx unit_ctx(int pm, int pn, int, int wc, int, int fq) const { Ctx c; const float* g = gate + row_bm(pm * 256) * 6144;
#pragma unroll
        for (int bj = 0; bj < 2; ++bj)
#pragma unroll
            for (int n = 0; n < 2; ++n) c.x[bj][n] = *(const f32x4*)(g + UNIT_COL(pn, wc, fq, bj, n));
        return c; }
    __device__ __forceinline__ void operator()(const Ctx& c, int row, int col, int, f32x4 v00, f32x4 v01, f32x4 v10, f32x4 v11) const {
        float* p = H + (size_t)row * D + col;
        *(f32x4*)p = *(const f32x4*)p + c.x[0][0] * v00; *(f32x4*)(p + 4) = *(const f32x4*)(p + 4) + c.x[0][1] * v01;
        *(f32x4*)(p + 128) = *(const f32x4*)(p + 128) + c.x[1][0] * v10; *(f32x4*)(p + 132) = *(const f32x4*)(p + 132) + c.x[1][1] * v11; } };
struct GateNormCtx { f32x4 g[2][2], G[2][2]; };
__device__ __forceinline__ float sq4(f32x4 h) { return (h[0] * h[0] + h[1] * h[1]) + (h[2] * h[2] + h[3] * h[3]); }
struct EpiResGateNorm { float* H; const float* gate; const float* gn; const float* scn  ; bf16* AFn; float* SSP; LAS float* part  ;
    static constexpr bool UNIT_END = true; typedef GateNormCtx Ctx;
    __device__ __forceinline__ Ctx unit_ctx(int pm, int pn, int, int wc, int, int fq) const { Ctx c; const int bm = row_bm(pm * 256);
#pragma unroll
        for (int bj = 0; bj < 2; ++bj)
#pragma unroll
            for (int n = 0; n < 2; ++n) { const int col = UNIT_COL(pn, wc, fq, bj, n); c.g[bj][n] = *(const f32x4*)(gate + bm * 6144 + col); c.G[bj][n] = *(const f32x4*)(gn + col) * (1.0f + *(const f32x4*)(scn + bm * 6144 + col)); }
        return c; }
    __device__ __forceinline__ void operator()(const Ctx& c, int row, int col, int, f32x4 v00, f32x4 v01, f32x4 v10, f32x4 v11) const {
        float* p = H + (size_t)row * D + col; bf16* q = AFn + (size_t)row * D + col;
        const f32x4 h00 = *(const f32x4*)p + c.g[0][0] * v00, h01 = *(const f32x4*)(p + 4) + c.g[0][1] * v01;
        *(f32x4*)p = h00; *(f32x4*)(p + 4) = h01; st8bf(q, h00 * c.G[0][0], h01 * c.G[0][1]);
        float s = sq4(h00) + sq4(h01);
        asm volatile("" ::: "memory");
        const f32x4 h10 = *(const f32x4*)(p + 128) + c.g[1][0] * v10, h11 = *(const f32x4*)(p + 132) + c.g[1][1] * v11;
        *(f32x4*)(p + 128) = h10; *(f32x4*)(p + 132) = h11; st8bf(q + 128, h10 * c.G[1][0], h11 * c.G[1][1]);
        s += sq4(h10) + sq4(h11);
        s += __shfl_xor(s, 16); s += __shfl_xor(s, 32);
        if ((threadIdx.x & 48) == 0) part[(row & 255) * 4 + ((col >> 5) & 3)] = s; }
    __device__ __forceinline__ void unit_end(int pm, int pn, int tid) const {
        if (tid < 256) { const f32x4 a = *(const LAS f32x4*)(part + tid * 4); SSP[(size_t)(pm * 256 + tid) * 4 + pn] = (a[0] + a[1]) + (a[2] + a[3]); } } };
struct EpiSwiGLU { bf16* O; int ldc; static constexpr bool UNIT_END = false; typedef NoCtx Ctx;
    __device__ __forceinline__ Ctx unit_ctx(int, int, int, int, int, int) const { return Ctx{}; }
    __device__ __forceinline__ void store(int row, int col, f32x4 g0, f32x4 g1, f32x4 u0, f32x4 u1) const {
        const int rc = ((col >> 8) << 7) + (col & 127);
        f32x4 r0, r1;
#pragma unroll
        for (int i = 0; i < 4; ++i) { r0[i] = silu_f(g0[i]) * u0[i]; r1[i] = silu_f(g1[i]) * u1[i]; }
        st8bf(O + (size_t)row * ldc + rc, r0, r1); }
    __device__ __forceinline__ void operator()(const Ctx&, int row, int col, int, f32x4 v00, f32x4 v01, f32x4 v10, f32x4 v11) const { store(row, col, v00, v01, v10, v11); } };
struct EpiSwiGLUNorm { bf16* O; int ldc; const float* SSP; const float* bias  ; static constexpr bool UNIT_END = false; typedef RowColCtx Ctx;
    __device__ __forceinline__ Ctx unit_ctx(int pm, int pn, int wr, int wc, int fr, int fq) const { Ctx c; const float* b = bias + row_bm(pm * 256) * 5632;
#pragma unroll
        for (int ri = 0; ri < 8; ++ri) c.r[ri] = rstd_of(SSP, UNIT_ROW(pm, wr, fr, ri));
#pragma unroll
        for (int bj = 0; bj < 2; ++bj)
#pragma unroll
            for (int n = 0; n < 2; ++n) c.x[bj][n] = *(const f32x4*)(b + UNIT_COL(pn, wc, fq, bj, n));
        return c; }
    __device__ __forceinline__ void operator()(const Ctx& c, int row, int col, int ri, f32x4 v00, f32x4 v01, f32x4 v10, f32x4 v11) const {
        const float r = c.r[ri]; EpiSwiGLU e{O, ldc}; e.store(row, col, v00 * r + c.x[0][0], v01 * r + c.x[0][1], v10 * r + c.x[1][0], v11 * r + c.x[1][1]); } };

struct MoeTiles {
    int c0, c1, c2, c3, c4, c5, c6, c7, total;
    __device__ __forceinline__ static int ld(const unsigned* p) { return __builtin_amdgcn_readfirstlane((int)__hip_atomic_load(p, __ATOMIC_RELAXED, __HIP_MEMORY_SCOPE_AGENT)); }
    __device__ __forceinline__ static int t(int c) { return (c + 255) >> 8; }
    __device__ __forceinline__ void init(const unsigned* cnt) { c0 = ld(cnt); c1 = ld(cnt + 1); c2 = ld(cnt + 2); c3 = ld(cnt + 3); c4 = ld(cnt + 4); c5 = ld(cnt + 5); c6 = ld(cnt + 6); c7 = ld(cnt + 7);
        total = t(c0) + t(c1) + t(c2) + t(c3) + t(c4) + t(c5) + t(c6) + t(c7); }
    __device__ __forceinline__ void tile_info(int tile, int& ex, int& pos0, int& count) const {
        int cum = 0, e = 0, first = 0, c = c0;
#define MT_STEP(k, ck, cn) cum += t(ck); if (tile >= cum) { e = k + 1; first = cum; c = cn; }
        MT_STEP(0, c0, c1) MT_STEP(1, c1, c2) MT_STEP(2, c2, c3) MT_STEP(3, c3, c4) MT_STEP(4, c4, c5) MT_STEP(5, c5, c6) MT_STEP(6, c6, c7)
#undef MT_STEP
        ex = e; pos0 = (tile - first) * 256; count = c; }
    __device__ __forceinline__ int expert_of_tile(int tile) const { int ex, pos0, count; tile_info(tile, ex, pos0, count); return ex; }
    __device__ __forceinline__ int row_offset(int ex) const {
        return ((ex > 0 ? t(c0) : 0) + (ex > 1 ? t(c1) : 0) + (ex > 2 ? t(c2) : 0) + (ex > 3 ? t(c3) : 0) + (ex > 4 ? t(c4) : 0) + (ex > 5 ? t(c5) : 0) + (ex > 6 ? t(c6) : 0)) * 256; }
};
namespace pg8 {
constexpr int BM = 256, BK = 64, HALF = 128, HTB = HALF * BK * 2, STAGE_BYTES = 8 * HTB, NXCD = 8, WGM = 8;
__host__ __device__ __forceinline__ int lds_byte(int r, int c) { const int st = (r >> 4) * 2 + (c >> 5), rr = r & 15, cc = c & 31, ob = rr * 64 + cc * 2; return st * 1024 + (ob ^ (((ob >> 9) & 1) << 5)); }
__host__ __device__ __forceinline__ void stage_rc(int b, int& R, int& C) { const int st = b / 1024, sb = b % 1024, swz = sb ^ (((sb >> 9) & 1) << 5); R = (st >> 1) * 16 + swz / 64; C = (st & 1) * 32 + (swz % 64) / 2; }
__host__ __device__ __forceinline__ int perm32(int rho) { const int n = rho >> 4, i = rho & 15; return 8 * (i >> 2) + 4 * n + (i & 3); }
struct Unit { int pm, pn; };
__device__ __forceinline__ void tile_of(int L, int nwg, int nM, int nN, int& pm, int& pn) {
    int wgid = L; { const int q = nwg / NXCD, r = nwg % NXCD, xcd = wgid % NXCD, off = wgid / NXCD; wgid = (xcd < r ? xcd * (q + 1) : r * (q + 1) + (xcd - r) * q) + off; }
    const int nig = WGM * nN, gid = wgid / nig, fm = gid * WGM, gsz = (nM - fm) < WGM ? (nM - fm) : WGM;
    pm = fm + ((wgid % nig) % gsz); pn = (wgid % nig) / gsz;
}
struct SchedStatic {
    const char* A; const char* B; int nM, nN, nwg, G, c; size_t tstep;
    __device__ __forceinline__ void init(const bf16* A_, const bf16* B_, int M, int N, int K, int G_, int c_) { A = (const char*)A_; B = (const char*)B_; nM = M / BM; nN = N / BM; nwg = nM * nN; G = G_; c = c_; tstep = (size_t)BM * K * 2; }
    __device__ __forceinline__ bool next(int i, Unit& u) const { const int L = i * G + c; if (L >= nwg) return false; tile_of(L, nwg, nM, nN, u.pm, u.pn); return true; }
    __device__ __forceinline__ const char* a_base(const Unit& u) const { return A + (size_t)u.pm * tstep; }
    __device__ __forceinline__ const char* b_base(const Unit& u) const { return B + (size_t)u.pn * tstep; }
};
struct SchedQKVT {
    const char* AF; const char* WQK; const char* WV; int G, c; size_t tstep;
    static constexpr int NQK = 68 * 8, NVT = 4 * 68;
    __device__ __forceinline__ bool next(int i, Unit& u) const { const int L = i * G + c; if (L >= NQK + NVT) return false;
        int wgid = L; { const int nwg = NQK + NVT, q = nwg / NXCD, r = nwg % NXCD, xcd = wgid % NXCD, off = wgid / NXCD; wgid = (xcd < r ? xcd * (q + 1) : r * (q + 1) + (xcd - r) * q) + off; }
        if (wgid < NQK) { const int nig = WGM * 8, gid = wgid / nig, fm = gid * WGM, gsz = (68 - fm) < WGM ? (68 - fm) : WGM; u.pm = fm + ((wgid % nig) % gsz); u.pn = (wgid % nig) / gsz; }
        else { const int w = wgid - NQK; u.pm = 68 + (w & 3); u.pn = w >> 2; }
        return true; }
    __device__ __forceinline__ const char* a_base(const Unit& u) const { return u.pm < 68 ? AF + (size_t)u.pm * tstep : WV + (size_t)(u.pm - 68) * tstep; }
    __device__ __forceinline__ const char* b_base(const Unit& u) const { return u.pm < 68 ? WQK + (size_t)u.pn * tstep : AF + (size_t)u.pn * tstep; }
};
struct SchedMoe {
    const char* A; const char* B; const int* rowsrc; MoeTiles mt; int nN, nwg, G, c; size_t tstep, estride;
    __device__ __forceinline__ void init(const bf16* A_, const bf16* B_, size_t estride_elems, const unsigned* cnt, const int* rowsrc_, int N, int K, int G_, int c_) { A = (const char*)A_; B = (const char*)B_; rowsrc = rowsrc_; mt.init(cnt); nN = N / BM; nwg = mt.total * nN; G = G_; c = c_; tstep = (size_t)BM * K * 2; estride = estride_elems * 2; }
    __device__ __forceinline__ bool next(int i, Unit& u) const { const int L = i * G + c; if (L >= nwg) return false; tile_of(L, nwg, mt.total, nN, u.pm, u.pn); return true; }
    __device__ __forceinline__ const char* a_base(const Unit& u) const { return A + (size_t)u.pm * tstep; }
    __device__ __forceinline__ const char* b_base(const Unit& u) const { return B + (size_t)mt.expert_of_tile(u.pm) * estride + (size_t)u.pn * tstep; }
    __device__ __forceinline__ const char* a_matrix() const { return A; }
    __device__ __forceinline__ void rows_of(const Unit& u, const int (&r)[4], int (&row)[4]) const { int ex, pos0, count; mt.tile_info(u.pm, ex, pos0, count); const int* rs = rowsrc + (size_t)ex * MT + pos0;
#pragma unroll
        for (int q = 0; q < 4; ++q) row[q] = (pos0 + r[q] < count) ? rs[r[q]] : 0; }
};
constexpr int DOWN_KH = 1792;
struct SchedDownK2 {
    const char* A; const char* B; MoeTiles mt; int nwg, G, c; size_t tstep, estride;
    __device__ __forceinline__ void init(const bf16* A_, const bf16* B_, const unsigned* cnt, int G_, int c_) { A = (const char*)A_; B = (const char*)B_; mt.init(cnt); nwg = mt.total * 8; G = G_; c = c_; tstep = (size_t)BM * DFE * 2; estride = (size_t)1024 * DFE * 2; }
    __device__ __forceinline__ bool next(int i, Unit& u) const { const int L = i * G + c; if (L >= nwg) return false; tile_of(L, nwg, mt.total, 8, u.pm, u.pn); return true; }
    __device__ __forceinline__ const char* a_base(const Unit& u) const { return A + (size_t)u.pm * tstep + (size_t)(u.pn >> 2) * DOWN_KH * 2; }
    __device__ __forceinline__ const char* b_base(const Unit& u) const { return B + (size_t)mt.expert_of_tile(u.pm) * estride + (size_t)(u.pn & 3) * tstep + (size_t)(u.pn >> 2) * DOWN_KH * 2; }
};
template <class Epi>
__device__ __forceinline__ void epi_apply(const f32x4 (&acc)[2][2][4][2], const Unit& u, int wr, int wc, int fr, int fq, const Epi& E, int tid) {
    const typename Epi::Ctx ctx = E.unit_ctx(u.pm, u.pn, wr, wc, fr, fq);
    const int col = u.pn * BM + wc * 32 + 8 * fq;
#pragma unroll
    for (int ai = 0; ai < 2; ++ai)
#pragma unroll
        for (int m = 0; m < 4; ++m) {
            E(ctx, UNIT_ROW(u.pm, wr, fr, ai * 4 + m), col, ai * 4 + m, acc[ai][0][m][0], acc[ai][0][m][1], acc[ai][1][m][0], acc[ai][1][m][1]);
            if (m & 1) asm volatile("" ::: "memory"); }
    if constexpr (Epi::UNIT_END) {
        asm volatile("s_waitcnt lgkmcnt(0)" ::: "memory"); __builtin_amdgcn_s_barrier(); asm volatile("" ::: "memory");
        E.unit_end(u.pm, u.pn, tid);
    }
}
template <class Epi, class Sched>
__device__ __forceinline__ void gemm_phase(LAS unsigned char* lds, const int tid, const int K, const int LD  , const Sched& S, const Epi& E) {
    const int wid = __builtin_amdgcn_readfirstlane(tid >> 6), lane = tid & 63, wr = wid >> 2, wc = wid & 3, fr = lane & 15, fq = lane >> 4;
    const int nt = K / BK;
    unsigned voff[2];
#pragma unroll
    for (int i = 0; i < 2; ++i) { int R, C; stage_rc(tid * 16 + i * 8192, R, C); R = (R & ~31) + perm32(R & 31); voff[i] = (unsigned)(R * LD + C) * 2u; }
    const size_t kstep = (size_t)(BK * 2);
    const size_t hstep = (size_t)HALF * LD * 2;
    const unsigned ldsw = (unsigned)wid * 1024u;
    const int aoff = lds_byte(wr * 64 + fr, fq * 8), boff = lds_byte(wc * 32 + fr, fq * 8);
#define PG8_SA(b, h) (((b) * 2 + (h)) * HTB)
#define PG8_SB(b, h) ((4 + (b) * 2 + (h)) * HTB)
#define PG8_STAGE(bufoff, gbase) do { _Pragma("unroll") for (int _i = 0; _i < 2; ++_i) \
        __builtin_amdgcn_global_load_lds((const unsigned*)((const char*)(gbase) + voff[_i]), (LAS unsigned*)(lds + (bufoff) + ldsw + _i * 8192), 16, 0, 0); } while (0)
#define PG8_LDA(dst, b, h) do { _Pragma("unroll") for (int m = 0; m < 4; ++m) _Pragma("unroll") for (int k = 0; k < 2; ++k) dst[m][k] = *(const LAS bf16x8*)(lds + PG8_SA(b, h) + aoff + m * 2048 + k * 1024); } while (0)
#define PG8_LDB(dst, b, h) do { _Pragma("unroll") for (int n = 0; n < 2; ++n) _Pragma("unroll") for (int k = 0; k < 2; ++k) dst[n][k] = *(const LAS bf16x8*)(lds + PG8_SB(b, h) + boff + n * 2048 + k * 1024); } while (0)
#define PG8_MMA(ai, bj, At, Bt) do { __builtin_amdgcn_s_setprio(1); _Pragma("unroll") for (int m = 0; m < 4; ++m) _Pragma("unroll") for (int n = 0; n < 2; ++n) _Pragma("unroll") for (int k = 0; k < 2; ++k) \
        acc[ai][bj][m][n] = __builtin_amdgcn_mfma_f32_16x16x32_bf16(Bt[n][k], At[m][k], acc[ai][bj][m][n], 0, 0, 0); __builtin_amdgcn_s_setprio(0); } while (0)
#define PG8_WAIT_V(n) asm volatile("s_waitcnt vmcnt(" #n ")" ::: "memory")
#define PG8_WAIT_L(n) asm volatile("s_waitcnt lgkmcnt(" #n ")" ::: "memory")
#define PG8_BAR __builtin_amdgcn_s_barrier()
#define PG8_SCHED __builtin_amdgcn_sched_barrier(0)
    Unit cur, nxt; int ui = 0;
    if (!S.next(0, cur)) return;
    f32x4 acc[2][2][4][2];
#pragma unroll
    for (int a = 0; a < 2; ++a)
#pragma unroll
        for (int b = 0; b < 2; ++b)
#pragma unroll
            for (int m = 0; m < 4; ++m)
#pragma unroll
                for (int n = 0; n < 2; ++n) acc[a][b][m][n] = (f32x4){0.f, 0.f, 0.f, 0.f};
    bf16x8 At[4][2], B0[2][2], B1[2][2];
    const char* cA = S.a_base(cur); const char* cB = S.b_base(cur);
    PG8_STAGE(PG8_SB(0, 0), cB); PG8_STAGE(PG8_SB(0, 1), cB + hstep); PG8_STAGE(PG8_SA(0, 0), cA); PG8_STAGE(PG8_SA(0, 1), cA + hstep);
    if (wr == 1) PG8_BAR;
    PG8_WAIT_V(2); PG8_BAR;
    PG8_STAGE(PG8_SB(1, 0), cB + kstep); PG8_STAGE(PG8_SA(1, 0), cA + kstep); PG8_STAGE(PG8_SB(1, 1), cB + hstep + kstep);
    PG8_WAIT_V(6); PG8_BAR;
    for (;;) {
        const bool has_next = S.next(ui + 1, nxt);
        const char* nA = has_next ? S.a_base(nxt) : cA; const char* nB = has_next ? S.b_base(nxt) : cB;
        for (int t = 0; t < nt; t += 2) {
            const bool last = (t == nt - 2);
            const char* a1 = cA + (size_t)(t + 1) * kstep;
            const char* a2 = last ? nA : cA + (size_t)(t + 2) * kstep; const char* b2 = last ? nB : cB + (size_t)(t + 2) * kstep;
            const char* a3 = a2 + kstep; const char* b3 = b2 + kstep;
            PG8_LDB(B0, 0, 0); PG8_LDB(B1, 0, 1); PG8_SCHED; PG8_LDA(At, 0, 0); PG8_STAGE(PG8_SA(1, 1), a1 + hstep);
            PG8_WAIT_V(8); PG8_WAIT_L(0); PG8_BAR; PG8_MMA(0, 0, At, B0); PG8_MMA(0, 1, At, B1); PG8_BAR; PG8_SCHED;
            PG8_LDA(At, 0, 1); PG8_STAGE(PG8_SB(0, 0), b2); PG8_STAGE(PG8_SB(0, 1), b2 + hstep); PG8_STAGE(PG8_SA(0, 0), a2);
            PG8_WAIT_V(8); PG8_WAIT_L(0); PG8_BAR; PG8_MMA(1, 0, At, B0); PG8_MMA(1, 1, At, B1); PG8_BAR; PG8_SCHED;
            PG8_LDB(B0, 1, 0); PG8_LDB(B1, 1, 1); PG8_SCHED; PG8_LDA(At, 1, 0); PG8_STAGE(PG8_SA(0, 1), a2 + hstep);
            PG8_WAIT_V(8); PG8_WAIT_L(0); PG8_BAR; PG8_MMA(0, 0, At, B0); PG8_MMA(0, 1, At, B1); PG8_BAR; PG8_SCHED;
            PG8_LDA(At, 1, 1); PG8_STAGE(PG8_SB(1, 0), b3); PG8_STAGE(PG8_SB(1, 1), b3 + hstep); PG8_STAGE(PG8_SA(1, 0), a3);
            PG8_WAIT_V(8); PG8_WAIT_L(0); PG8_BAR; PG8_MMA(1, 0, At, B0); PG8_MMA(1, 1, At, B1); PG8_BAR; PG8_SCHED;
        }
        if (wr == 0) PG8_BAR;
        epi_apply(acc, cur, wr, wc, fr, fq, E, tid);
        if (!has_next) break;
#pragma unroll
        for (int a = 0; a < 2; ++a)
#pragma unroll
            for (int b = 0; b < 2; ++b)
#pragma unroll
                for (int m = 0; m < 4; ++m)
#pragma unroll
                    for (int n = 0; n < 2; ++n) acc[a][b][m][n] = (f32x4){0.f, 0.f, 0.f, 0.f};
        cur = nxt; cA = nA; cB = nB; ++ui;
        if (wr == 1) PG8_BAR;
    }
    PG8_WAIT_V(0);
    PG8_BAR;
#undef PG8_SA
#undef PG8_SB
#undef PG8_STAGE
#undef PG8_LDA
#undef PG8_LDB
#undef PG8_MMA
#undef PG8_WAIT_V
#undef PG8_WAIT_L
#undef PG8_BAR
#undef PG8_SCHED
}
template <class Epi, class Sched>
__device__ __forceinline__ void gemm_phase_gather(LAS unsigned char* lds, const int tid, const int K, const int LD, const Sched& S, const Epi& E) {
    const int wid = __builtin_amdgcn_readfirstlane(tid >> 6), lane = tid & 63, wr = wid >> 2, wc = wid & 3, fr = lane & 15, fq = lane >> 4;
    const int nt = K / BK;
    unsigned voff[2];
#pragma unroll
    for (int i = 0; i < 2; ++i) { int R, C; stage_rc(tid * 16 + i * 8192, R, C); R = (R & ~31) + perm32(R & 31); voff[i] = (unsigned)(R * LD + C) * 2u; }
    int rloc[4];
#pragma unroll
    for (int i = 0; i < 2; ++i) { int R, C; stage_rc(tid * 16 + i * 8192, R, C); R = (R & ~31) + perm32(R & 31); rloc[i] = R; rloc[2 + i] = HALF + R; }
    unsigned vc[2][2], vn[2][2];
    const char* Am = S.a_matrix();
#define PG8_OFFS(dst, u) do { int _row[4]; S.rows_of(u, rloc, _row); _Pragma("unroll") for (int _h = 0; _h < 2; ++_h) _Pragma("unroll") for (int _i = 0; _i < 2; ++_i) \
        dst[_h][_i] = (unsigned)_row[2 * _h + _i] * (unsigned)(LD * 2) + (voff[_i] - (unsigned)(rloc[_i] * LD * 2)); } while (0)
#define PG8_STAGE_A(bufoff, koff, v) do { _Pragma("unroll") for (int _i = 0; _i < 2; ++_i) \
        __builtin_amdgcn_global_load_lds((const unsigned*)(Am + (koff) + (v)[_i]), (LAS unsigned*)(lds + (bufoff) + ldsw + _i * 8192), 16, 0, 0); } while (0)
    const size_t kstep = (size_t)(BK * 2);
    const size_t hstep = (size_t)HALF * LD * 2;
    const unsigned ldsw = (unsigned)wid * 1024u;
    const int aoff = lds_byte(wr * 64 + fr, fq * 8), boff = lds_byte(wc * 32 + fr, fq * 8);
#define PG8_SA(b, h) (((b) * 2 + (h)) * HTB)
#define PG8_SB(b, h) ((4 + (b) * 2 + (h)) * HTB)
#define PG8_STAGE(bufoff, gbase) do { _Pragma("unroll") for (int _i = 0; _i < 2; ++_i) \
        __builtin_amdgcn_global_load_lds((const unsigned*)((const char*)(gbase) + voff[_i]), (LAS unsigned*)(lds + (bufoff) + ldsw + _i * 8192), 16, 0, 0); } while (0)
#define PG8_LDA(dst, b, h) do { _Pragma("unroll") for (int m = 0; m < 4; ++m) _Pragma("unroll") for (int k = 0; k < 2; ++k) dst[m][k] = *(const LAS bf16x8*)(lds + PG8_SA(b, h) + aoff + m * 2048 + k * 1024); } while (0)
#define PG8_LDB(dst, b, h) do { _Pragma("unroll") for (int n = 0; n < 2; ++n) _Pragma("unroll") for (int k = 0; k < 2; ++k) dst[n][k] = *(const LAS bf16x8*)(lds + PG8_SB(b, h) + boff + n * 2048 + k * 1024); } while (0)
#define PG8_MMA(ai, bj, At, Bt) do { __builtin_amdgcn_s_setprio(1); _Pragma("unroll") for (int m = 0; m < 4; ++m) _Pragma("unroll") for (int n = 0; n < 2; ++n) _Pragma("unroll") for (int k = 0; k < 2; ++k) \
        acc[ai][bj][m][n] = __builtin_amdgcn_mfma_f32_16x16x32_bf16(Bt[n][k], At[m][k], acc[ai][bj][m][n], 0, 0, 0); __builtin_amdgcn_s_setprio(0); } while (0)
#define PG8_WAIT_V(n) asm volatile("s_waitcnt vmcnt(" #n ")" ::: "memory")
#define PG8_WAIT_L(n) asm volatile("s_waitcnt lgkmcnt(" #n ")" ::: "memory")
#define PG8_BAR __builtin_amdgcn_s_barrier()
#define PG8_SCHED __builtin_amdgcn_sched_barrier(0)
    Unit cur, nxt; int ui = 0;
    if (!S.next(0, cur)) return;
    f32x4 acc[2][2][4][2];
#pragma unroll
    for (int a = 0; a < 2; ++a)
#pragma unroll
        for (int b = 0; b < 2; ++b)
#pragma unroll
            for (int m = 0; m < 4; ++m)
#pragma unroll
                for (int n = 0; n < 2; ++n) acc[a][b][m][n] = (f32x4){0.f, 0.f, 0.f, 0.f};
    bf16x8 At[4][2], B0[2][2], B1[2][2];
    const char* cB = S.b_base(cur);
    PG8_OFFS(vc, cur);
    PG8_STAGE(PG8_SB(0, 0), cB); PG8_STAGE(PG8_SB(0, 1), cB + hstep); PG8_STAGE_A(PG8_SA(0, 0), 0, vc[0]); PG8_STAGE_A(PG8_SA(0, 1), 0, vc[1]);
    if (wr == 1) PG8_BAR;
    PG8_WAIT_V(2); PG8_BAR;
    PG8_STAGE(PG8_SB(1, 0), cB + kstep); PG8_STAGE_A(PG8_SA(1, 0), kstep, vc[0]); PG8_STAGE(PG8_SB(1, 1), cB + hstep + kstep);
    PG8_WAIT_V(6); PG8_BAR;
    for (;;) {
        const bool has_next = S.next(ui + 1, nxt);
        const char* nB = has_next ? S.b_base(nxt) : cB;
        if (has_next) PG8_OFFS(vn, nxt); else {
#pragma unroll
            for (int _h = 0; _h < 2; ++_h)
#pragma unroll
                for (int _i = 0; _i < 2; ++_i) vn[_h][_i] = vc[_h][_i]; }
        for (int t = 0; t < nt; t += 2) {
            const bool last = (t == nt - 2);
            const size_t k1 = (size_t)(t + 1) * kstep, k2 = last ? 0 : (size_t)(t + 2) * kstep, k3 = k2 + kstep;
            const char* b2 = last ? nB : cB + (size_t)(t + 2) * kstep; const char* b3 = b2 + kstep;
            unsigned w0[2], w1[2];
#pragma unroll
            for (int _i = 0; _i < 2; ++_i) { w0[_i] = last ? vn[0][_i] : vc[0][_i]; w1[_i] = last ? vn[1][_i] : vc[1][_i]; }
            PG8_LDB(B0, 0, 0); PG8_LDB(B1, 0, 1); PG8_SCHED; PG8_LDA(At, 0, 0); PG8_STAGE_A(PG8_SA(1, 1), k1, vc[1]);
            PG8_WAIT_V(8); PG8_WAIT_L(0); PG8_BAR; PG8_MMA(0, 0, At, B0); PG8_MMA(0, 1, At, B1); PG8_BAR; PG8_SCHED;
            PG8_LDA(At, 0, 1); PG8_STAGE(PG8_SB(0, 0), b2); PG8_STAGE(PG8_SB(0, 1), b2 + hstep); PG8_STAGE_A(PG8_SA(0, 0), k2, w0);
            PG8_WAIT_V(8); PG8_WAIT_L(0); PG8_BAR; PG8_MMA(1, 0, At, B0); PG8_MMA(1, 1, At, B1); PG8_BAR; PG8_SCHED;
            PG8_LDB(B0, 1, 0); PG8_LDB(B1, 1, 1); PG8_SCHED; PG8_LDA(At, 1, 0); PG8_STAGE_A(PG8_SA(0, 1), k2, w1);
            PG8_WAIT_V(8); PG8_WAIT_L(0); PG8_BAR; PG8_MMA(0, 0, At, B0); PG8_MMA(0, 1, At, B1); PG8_BAR; PG8_SCHED;
            PG8_LDA(At, 1, 1); PG8_STAGE(PG8_SB(1, 0), b3); PG8_STAGE(PG8_SB(1, 1), b3 + hstep); PG8_STAGE_A(PG8_SA(1, 0), k3, w0);
            PG8_WAIT_V(8); PG8_WAIT_L(0); PG8_BAR; PG8_MMA(1, 0, At, B0); PG8_MMA(1, 1, At, B1); PG8_BAR; PG8_SCHED;
        }
        if (wr == 0) PG8_BAR;
        epi_apply(acc, cur, wr, wc, fr, fq, E, tid);
        if (!has_next) break;
#pragma unroll
        for (int a = 0; a < 2; ++a)
#pragma unroll
            for (int b = 0; b < 2; ++b)
#pragma unroll
                for (int m = 0; m < 4; ++m)
#pragma unroll
                    for (int n = 0; n < 2; ++n) acc[a][b][m][n] = (f32x4){0.f, 0.f, 0.f, 0.f};
        cur = nxt; cB = nB; ++ui;
#pragma unroll
        for (int _h = 0; _h < 2; ++_h)
#pragma unroll
            for (int _i = 0; _i < 2; ++_i) vc[_h][_i] = vn[_h][_i];
        if (wr == 1) PG8_BAR;
    }
    PG8_WAIT_V(0);
    PG8_BAR;
#undef PG8_OFFS
#undef PG8_STAGE_A
#undef PG8_SA
#undef PG8_SB
#undef PG8_STAGE
#undef PG8_LDA
#undef PG8_LDB
#undef PG8_MMA
#undef PG8_WAIT_V
#undef PG8_WAIT_L
#undef PG8_BAR
#undef PG8_SCHED
}
}
struct EpiQKVT { bf16* QB; bf16* KH; bf16* VT8; const float* SSP; const float* bias  ;
    static constexpr bool UNIT_END = false; typedef RowColCtx Ctx;
    __device__ __forceinline__ Ctx unit_ctx(int pm, int pn, int wr, int wc, int fr, int fq) const { Ctx c;
        if (pm < 68) { const float* b = bias + row_bm(pm * 256) * 3072;
#pragma unroll
            for (int ri = 0; ri < 8; ++ri) c.r[ri] = rstd_of(SSP, UNIT_ROW(pm, wr, fr, ri));
#pragma unroll
            for (int bj = 0; bj < 2; ++bj)
#pragma unroll
                for (int n = 0; n < 2; ++n) c.x[bj][n] = *(const f32x4*)(b + UNIT_COL(pn, wc, fq, bj, n));
        } else { const float* b = bias + row_bm(pn * 256) * 3072 + 2048;
#pragma unroll
            for (int ri = 0; ri < 8; ++ri) c.r[ri] = b[UNIT_ROW(pm - 68, wr, fr, ri)];
#pragma unroll
            for (int bj = 0; bj < 2; ++bj)
#pragma unroll
                for (int n = 0; n < 2; ++n)
#pragma unroll
                    for (int i = 0; i < 4; ++i) c.x[bj][n][i] = rstd_of(SSP, UNIT_COL(pn, wc, fq, bj, n) + i);
        }
        return c; }
    __device__ __forceinline__ void st(int row, int col, f32x4 a, f32x4 b) const {
        if (col < 1024) st8bf(QB + (size_t)row * 1024 + col, a * QSCALE, b * QSCALE);
        else { const int cc = col - 1024; st8bf(KH + ((size_t)(cc >> 6) * MT + row) * 64 + (cc & 63), a, b); } }
    __device__ __forceinline__ void operator()(const Ctx& c, int row, int col, int ri, f32x4 v00, f32x4 v01, f32x4 v10, f32x4 v11) const {
        if (row < MT) { const float r = c.r[ri];
            st(row, col, v00 * r + c.x[0][0], v01 * r + c.x[0][1]); st(row, col + 128, v10 * r + c.x[1][0], v11 * r + c.x[1][1]);
        } else { const int ch = row - MT, h = ch >> 6, d = ch & 63; const float bb = c.r[ri];
            st8bf(VT8 + (((size_t)h * (MT / 8) + (col >> 3)) * 64 + d) * 8, v00 * c.x[0][0] + bb, v01 * c.x[0][1] + bb);
            st8bf(VT8 + (((size_t)h * (MT / 8) + ((col + 128) >> 3)) * 64 + d) * 8, v10 * c.x[1][0] + bb, v11 * c.x[1][1] + bb);
        } } };

__device__ __forceinline__ void mods_phase(const Frame& F) {
    LAS float* sl = (LAS float*)F.lds;
    LAS float* red = sl + 5 * 1024;
    const int tid = F.tid;
    for (int i = tid; i < 5 * 1024; i += 512) { const int b = i >> 10, k = i & 1023; const float v = b < 4 ? F.in(I_C)[b * 1024 + k] : F.in(I_CCTX)[k]; sl[i] = v / (1.f + expf(-v)); }
    __syncthreads();
    const int l16 = tid & 15, kg = tid >> 4;
    for (int it = F.blk; it < 4 * 96; it += F.G) {
        const int layer = it / 96, cc = it % 96;
        const float* W = F.in(I_WMOD) + (size_t)layer * 1024 * 6144 + cc * 64 + l16 * 4;
        f32x4 acc[5];
#pragma unroll
        for (int b = 0; b < 5; ++b) acc[b] = (f32x4){0.f, 0.f, 0.f, 0.f};
#pragma unroll 8
        for (int kk = 0; kk < 32; ++kk) { const int k = kg * 32 + kk; const f32x4 w = *(const f32x4*)(W + (size_t)k * 6144);
#pragma unroll
            for (int b = 0; b < 5; ++b) acc[b] += sl[b * 1024 + k] * w; }
#pragma unroll
        for (int b = 0; b < 5; ++b) *(LAS f32x4*)(red + ((kg * 5 + b) * 64 + l16 * 4)) = acc[b];
        __syncthreads();
        if (tid < 320) { const int b = tid >> 6, col = tid & 63; float s = 0.f;
            for (int g = 0; g < 32; ++g) s += red[(g * 5 + b) * 64 + col];
            F.mods()[((size_t)layer * 5 + b) * 6144 + cc * 64 + col] = s + F.in(I_BMOD)[layer * 6144 + cc * 64 + col]; }
        __syncthreads();
    }
}
__device__ __forceinline__ void rpb_phase(const Frame& F) {
    const int gt = F.blk * 512 + F.tid, ngt = F.G * 512;
    for (int i = gt; i < 2 * 16 * 15 * 64; i += ngt) { const int c = i & 63, r = (i >> 6) % 15, h = (i / (64 * 15)) & 15, jj = i / (64 * 15 * 16);
        const int dc = c - 32; float v = 0.f; if (dc >= -15 && dc <= 15) v = F.in(I_RPB)[((size_t)(jj * 16 + h) * 15 + r) * 31 + dc + 15] * LOG2E;
        F.rpbt()[i] = v; }
}
__device__ __forceinline__ void poolfold_phase(const Frame& F, int j) {
    const float* pw = F.in(I_POOLW) + (size_t)j * 4 * 128 * 128; const float* ps = F.in(I_POOLS) + (size_t)j * 512; const float* wo = F.in(I_WOUT) + (size_t)j * 1024 * 1024 + (size_t)512 * 1024;
    bf16* dst = F.wb(j) + WB_WOUT;
    const int gt = F.blk * 512 + F.tid, ngt = F.G * 512;
    for (int it = gt; it < 4 * 32 * 1024; it += ngt) {
        const int n = it & 1023, c4 = (it >> 10) & 31, g = it >> 15;
        const float* pr = pw + ((size_t)g * 128 + c4 * 4) * 128; const float* wr = wo + (size_t)g * 128 * 1024 + n; const float* sr = ps + g * 128;
        float acc[4] = {0.f, 0.f, 0.f, 0.f};
#pragma unroll 4
        for (int d = 0; d < 128; ++d) { const float w = wr[(size_t)d * 1024] * sr[d];
#pragma unroll
            for (int q = 0; q < 4; ++q) acc[q] += pr[q * 128 + d] * w; }
        u32x2 o; o.x = cvt_pk_bf16(acc[0], acc[1]); o.y = cvt_pk_bf16(acc[2], acc[3]);
        *(u32x2*)(dst + (size_t)n * 1024 + 512 + g * 128 + c4 * 4) = o;
    }
}
__device__ __forceinline__ void bias_phase(const Frame& F, int j) {
    const int lane = F.lane;
    for (int it = F.gw; it < 5632 + 3072; it += F.ngw) {
        const bool gu = it < 5632; const int n = gu ? it : it - 5632;
        const bf16* wrow = F.wb(j) + (gu ? WB_WGU : WB_WQKV) + (size_t)n * 1024;
        const float* sh = F.mods() + (size_t)(gu ? 2 * j : 2 * j + 1) * 5 * 6144 + (gu ? 3 * 1024 : 0);
        float w[16];
#pragma unroll
        for (int jj = 0; jj < 2; ++jj) { const bf16x8 v = *(const bf16x8*)(wrow + 8 * lane + 512 * jj);
#pragma unroll
            for (int e = 0; e < 8; ++e) w[8 * jj + e] = bf2f(v[e]); }
        float* out = F.bias() + (gu ? BIAS_GU + (size_t)j * 5 * 5632 : BIAS_QKV + (size_t)j * 5 * 3072);
#pragma unroll
        for (int bm = 0; bm < 5; ++bm) { float s = 0.f;
#pragma unroll
            for (int jj = 0; jj < 2; ++jj) { const f32x4 a = *(const f32x4*)(sh + bm * 6144 + 8 * lane + 512 * jj), b = *(const f32x4*)(sh + bm * 6144 + 8 * lane + 512 * jj + 4);
                s += (a[0] * w[8 * jj] + a[1] * w[8 * jj + 1]) + (a[2] * w[8 * jj + 2] + a[3] * w[8 * jj + 3]) + (b[0] * w[8 * jj + 4] + b[1] * w[8 * jj + 5]) + (b[2] * w[8 * jj + 6] + b[3] * w[8 * jj + 7]); }
            s = wave_sum(s);
            if (lane == 0) out[bm * (gu ? 5632 : 3072) + n] = s; }
    }
}
__device__ __forceinline__ void conv_tile(const float* src, int ldn, bf16* dst, int pitch, int k0, int n0, int mode, LAS unsigned* T, int lane) {
    const int c4 = (lane & 15) * 4;
#pragma unroll
    for (int it = 0; it < 8; ++it) { const int r = it * 4 + (lane >> 4);
        const f32x4 a = __builtin_nontemporal_load((const f32x4*)(src + (size_t)(k0 + 2 * r) * ldn + n0 + c4)), b = __builtin_nontemporal_load((const f32x4*)(src + (size_t)(k0 + 2 * r + 1) * ldn + n0 + c4));
#pragma unroll
        for (int c = 0; c < 4; ++c) T[(c4 + c) * 33 + r] = cvt_pk_bf16(a[c], b[c]); }
    asm volatile("s_waitcnt lgkmcnt(0)" ::: "memory");
#pragma unroll
    for (int it = 0; it < 8; ++it) { const int n = it * 8 + (lane >> 3), q = lane & 7; const int gn = n0 + n;
        const int drow = mode == 0 ? gn : ((gn >> 7) << 8) + (gn & 127) + (mode == 2 ? 128 : 0);
        u32x4 v; v.x = T[n * 33 + 4 * q]; v.y = T[n * 33 + 4 * q + 1]; v.z = T[n * 33 + 4 * q + 2]; v.w = T[n * 33 + 4 * q + 3];
        __builtin_nontemporal_store(v, (u32x4*)(dst + (size_t)drow * pitch + k0 + 8 * q)); }
    asm volatile("s_waitcnt lgkmcnt(0)" ::: "memory");
}
constexpr int CT0 = 512, CT1 = CT0 + 128, CT2 = CT1 + 704, CT3 = CT2 + 704, CT4 = CT3 + 704, CT5 = CT4 + 768, CT6 = CT5 + 256, CT7 = CT6 + 7168, CT8 = CT7 + 7168, CT9 = CT8 + 7168;
constexpr int CQ_P0M = CT9 - CT6, CQ_P1D = CQ_P0M + CT6, CQ_END = CQ_P1D + (CT9 - CT6);
static_assert(CQ_P0M % 8 == 0 && CQ_P1D % 8 == 0 && CQ_END % 8 == 0, "queue chunks");
__device__ __forceinline__ void conv_item(const Frame& F, int j, int it, LAS unsigned* T) {
    const float* src; int K, N, mode = 0, r; bf16* dst; size_t se = 0, de = 0; int tpe;
    if (it < CT0)      { r = it;       src = F.in(I_WIN) + (size_t)j * 1024 * 2048;  K = 1024; N = 2048; dst = F.wb(j) + WB_WIN; tpe = CT0; }
    else if (it < CT1) { r = it - CT0; src = F.in(I_WOUT) + (size_t)j * 1024 * 1024; K = 1024; N = 1024; dst = F.wb(j) + WB_WOUT; tpe = 128; }
    else if (it < CT2) { r = it - CT1; src = F.in(I_WFG) + (size_t)j * 1024 * DFF;   K = 1024; N = DFF; dst = F.wb(j) + WB_WGU; mode = 1; tpe = 704; }
    else if (it < CT3) { r = it - CT2; src = F.in(I_WFU) + (size_t)j * 1024 * DFF;   K = 1024; N = DFF; dst = F.wb(j) + WB_WGU; mode = 2; tpe = 704; }
    else if (it < CT4) { r = it - CT3; src = F.in(I_WFD) + (size_t)j * DFF * 1024;   K = DFF; N = 1024; dst = F.wb(j) + WB_WD; tpe = 704; }
    else if (it < CT5) { r = it - CT4; src = F.in(I_WQKV) + (size_t)j * 1024 * 3072; K = 1024; N = 3072; dst = F.wb(j) + WB_WQKV; tpe = 768; }
    else if (it < CT6) { r = it - CT5; src = F.in(I_WONA) + (size_t)j * 1024 * 1024; K = 1024; N = 1024; dst = F.wb(j) + WB_WO; tpe = 256; }
    else if (it < CT7) { r = it - CT6; src = F.in(I_WEG) + (size_t)j * NE * 1024 * DFE; K = 1024; N = DFE; dst = F.wb(j) + WB_WEGU; mode = 1; tpe = 896; se = (size_t)1024 * DFE; de = (size_t)7168 * 1024; }
    else if (it < CT8) { r = it - CT7; src = F.in(I_WEU) + (size_t)j * NE * 1024 * DFE; K = 1024; N = DFE; dst = F.wb(j) + WB_WEGU; mode = 2; tpe = 896; se = (size_t)1024 * DFE; de = (size_t)7168 * 1024; }
    else               { r = it - CT8; src = F.in(I_WED) + (size_t)j * NE * DFE * 1024; K = DFE; N = 1024; dst = F.wb(j) + WB_WED; tpe = 896; se = (size_t)DFE * 1024; de = (size_t)1024 * DFE; }
    const int e = r / tpe, rr = r % tpe, nb = N / 64, kb = rr / nb, nbi = rr % nb;
    conv_tile(src + e * se, N, dst + e * de, K, kb * 64, nbi * 64, mode, T, F.lane);
}
__device__ __forceinline__ void conv_dense0(const Frame& F) {
    LAS unsigned* T = (LAS unsigned*)(F.lds + F.wave * 8448);
    for (int it = F.gw; it < CT6; it += F.ngw) conv_item(F, 0, it, T);
}
__device__ __forceinline__ void conv_queue(const Frame& F, int limit, int max_chunks) {
    LAS unsigned* T = (LAS unsigned*)(F.lds + F.wave * 8448);
    volatile LAS int* qslot = (volatile LAS int*)(F.lds + 8 * 8448);
    unsigned* head = F.ctl() + CW_QHEAD;
    for (int n = 0; n < max_chunks; ++n) {
        __syncthreads();
        if (F.tid == 0) { int v = -1; if ((int)__hip_atomic_load(head, __ATOMIC_RELAXED, __HIP_MEMORY_SCOPE_AGENT) < limit) v = (int)__hip_atomic_fetch_add(head, 8u, __ATOMIC_RELAXED, __HIP_MEMORY_SCOPE_AGENT); *qslot = v; }
        __syncthreads();
        const int q0 = *qslot;
        if (q0 < 0 || q0 >= CQ_END) break;
        const int q = q0 + F.wave;
        if (q < CQ_P0M) conv_item(F, 0, CT6 + q, T); else if (q < CQ_P1D) conv_item(F, 1, q - CQ_P0M, T); else conv_item(F, 1, CT6 + (q - CQ_P1D), T);
    }
    __syncthreads();
}
__device__ __forceinline__ bool tail_idle(int nwg, int G, int c) { const int mine = c < nwg ? (nwg - c + G - 1) / G : 0; return mine < (nwg + G - 1) / G; }

__device__ __forceinline__ f32x4 bf4_to_f32(u32x2 u) { return (f32x4){__uint_as_float(u.x << 16), __uint_as_float(u.x & 0xffff0000u), __uint_as_float(u.y << 16), __uint_as_float(u.y & 0xffff0000u)}; }
__device__ __forceinline__ f32x4 moe_row4(const Frame& F, int rr, int c) {
    return bf4_to_f32(*(const u32x2*)(F.YPAIR() + (size_t)rr * D + c)) + bf4_to_f32(*(const u32x2*)(F.YPB() + (size_t)rr * D + c));
}
template <bool FIRST, bool COMBINE, bool ROUTER, bool FINAL>
__device__ __forceinline__ void norm_phase(const Frame& F, int Mrows, const float* g, const float* modbase  , int shift_idx, const float* prev_gate  ,
                                           const float* wr  , unsigned* cnt  ) {
    const int lane = F.lane;
    int2* tok_e = (int2*)F.tok(); int2* tok_pos = tok_e + MT; float2* tok_w = (float2*)(tok_pos + MT); int* rowsrc = (int*)(F.ws() + WS_TOK + 2 * MiB);
    constexpr int NR = 2;
    LAS int* lcnt = (LAS int*)F.lds; LAS int* lbase = lcnt + 8; LAS int* rec = lcnt + 16 + F.wave * 64;
    int nrec = 0;
    if (ROUTER) { if (F.tid < 8) lcnt[F.tid] = 0; __syncthreads(); }
    MoeTiles mtc; if (COMBINE) mtc.init(cnt);
    for (int row0 = F.gw * NR; row0 < Mrows; row0 += F.ngw * NR) {
        f32x4 v[NR][4];
#pragma unroll
        for (int q = 0; q < NR; ++q) { const int row = row0 + q;
            const float* src = FIRST ? (row < ML ? F.in(I_X) + (size_t)row * D : F.in(I_CTX) + (size_t)(row - ML) * D) : F.H() + (size_t)row * D;
#pragma unroll
            for (int jj = 0; jj < 4; ++jj) v[q][jj] = *(const f32x4*)(src + 4 * lane + 256 * jj); }
        if (COMBINE) {
#pragma unroll
            for (int q = 0; q < NR; ++q) { const int row = row0 + q; const int bm = row_bm(row);
                const int2 ee = tok_e[row], pp = tok_pos[row]; const int2 rr = make_int2(mtc.row_offset(ee.x) + pp.x, mtc.row_offset(ee.y) + pp.y); const float2 ww = tok_w[row];
                const float* pg = prev_gate + bm * 6144;
#pragma unroll
                for (int jj = 0; jj < 4; ++jj) { const int c = 4 * lane + 256 * jj; const f32x4 gg = *(const f32x4*)(pg + c);
                    const f32x4 a = moe_row4(F, rr.x, c), b = moe_row4(F, rr.y, c);
                    v[q][jj] += gg * (ww.x * a + ww.y * b); } }
        }
#pragma unroll
        for (int q = 0; q < NR; ++q) {
            const int row = row0 + q; const int bm = row_bm(row);
            if ((FIRST || COMBINE) && !FINAL) {
#pragma unroll
                for (int jj = 0; jj < 4; ++jj) *(f32x4*)(F.H() + (size_t)row * D + 4 * lane + 256 * jj) = v[q][jj];
            }
            float ss = 0.f;
#pragma unroll
            for (int jj = 0; jj < 4; ++jj) ss += (v[q][jj][0] * v[q][jj][0] + v[q][jj][1] * v[q][jj][1]) + (v[q][jj][2] * v[q][jj][2] + v[q][jj][3] * v[q][jj][3]);
            ss = wave_sum(ss);
            const float rstd = 1.0f / sqrtf(ss * (1.0f / D) + EPS);
            if (FINAL) {
#pragma unroll
                for (int jj = 0; jj < 4; ++jj) { const int c = 4 * lane + 256 * jj; *(f32x4*)(F.out() + (size_t)row * D + c) = v[q][jj] * rstd * *(const f32x4*)(g + c); }
                continue;
            }
            const float* sh = modbase + bm * 6144 + shift_idx * 1024; const float* sc = sh + 1024;
            float lg[NE];
#pragma unroll
            for (int e = 0; e < NE; ++e) lg[e] = 0.f;
#pragma unroll
            for (int jj = 0; jj < 4; ++jj) { const int c = 4 * lane + 256 * jj;
                const f32x4 y = v[q][jj] * rstd * *(const f32x4*)(g + c);
                const f32x4 a = y * (1.0f + *(const f32x4*)(sc + c)) + *(const f32x4*)(sh + c);
                u32x2 w; w.x = cvt_pk_bf16(a[0], a[1]); w.y = cvt_pk_bf16(a[2], a[3]);
                *(u32x2*)(F.AF() + (size_t)row * D + c) = w;
                if (ROUTER) {
#pragma unroll
                    for (int i = 0; i < 4; ++i) { const f32x4 w0 = *(const f32x4*)(wr + (size_t)(c + i) * 8), w1 = *(const f32x4*)(wr + (size_t)(c + i) * 8 + 4);
                        lg[0] += a[i] * w0[0]; lg[1] += a[i] * w0[1]; lg[2] += a[i] * w0[2]; lg[3] += a[i] * w0[3]; lg[4] += a[i] * w1[0]; lg[5] += a[i] * w1[1]; lg[6] += a[i] * w1[2]; lg[7] += a[i] * w1[3]; }
                }
            }
            if (ROUTER) {
#pragma unroll
                for (int e = 0; e < NE; ++e) lg[e] = wave_sum(lg[e]);
                int e0 = 0; float v0 = lg[0];
#pragma unroll
                for (int e = 1; e < NE; ++e) if (lg[e] > v0) { v0 = lg[e]; e0 = e; }
                int e1 = -1; float v1 = -3.0e38f;
#pragma unroll
                for (int e = 0; e < NE; ++e) if (e != e0 && lg[e] > v1) { v1 = lg[e]; e1 = e; }
                const float t = __expf(v1 - v0), w0 = 1.0f / (1.0f + t), w1 = t / (1.0f + t);
                if (lane == 0) {
                    const int p0 = __hip_atomic_fetch_add(lcnt + e0, 1, __ATOMIC_RELAXED, __HIP_MEMORY_SCOPE_WORKGROUP);
                    const int p1 = __hip_atomic_fetch_add(lcnt + e1, 1, __ATOMIC_RELAXED, __HIP_MEMORY_SCOPE_WORKGROUP);
                    rec[nrec * 4 + 0] = e0; rec[nrec * 4 + 1] = e1; rec[nrec * 4 + 2] = p0; rec[nrec * 4 + 3] = p1;
                    tok_e[row] = make_int2(e0, e1); tok_w[row] = make_float2(w0, w1);
                }
                ++nrec;
            }
        }
    }
    if (ROUTER) {
        __syncthreads();
        if (F.tid < 8) lbase[F.tid] = (int)__hip_atomic_fetch_add(cnt + F.tid, (unsigned)lcnt[F.tid], __ATOMIC_RELAXED, __HIP_MEMORY_SCOPE_AGENT);
        __syncthreads();
        if (lane < nrec) {
            const int row = F.gw * NR + (lane / NR) * F.ngw * NR + (lane % NR);
            const int e0 = rec[lane * 4 + 0], e1 = rec[lane * 4 + 1], p0 = lbase[e0] + rec[lane * 4 + 2], p1 = lbase[e1] + rec[lane * 4 + 3];
            tok_pos[row] = make_int2(p0, p1); rowsrc[(size_t)e0 * MT + p0] = row; rowsrc[(size_t)e1 * MT + p1] = row;
        }
    }
}

template <int WIN>
__device__ __forceinline__ void pool_rows8(const bf16* U, bf16* Y1, int r0, int t0, int L, int c0) {
    constexpr int A = WIN / 2, NRW = 8 + WIN - 1;
    bf16x8 raw[NRW];
#pragma unroll
    for (int k = 0; k < NRW; ++k) { const int tt = t0 - A + k; raw[k] = (bf16x8){0, 0, 0, 0, 0, 0, 0, 0};
        if (tt >= 0 && tt < L) raw[k] = *(const bf16x8*)(U + (size_t)(r0 - A + k) * 2048 + 1536 + c0); }
#pragma unroll
    for (int i = 0; i < 8; ++i) {
        float s[8];
#pragma unroll
        for (int e = 0; e < 8; ++e) s[e] = 0.f;
#pragma unroll
        for (int k = 0; k < WIN; ++k)
#pragma unroll
            for (int e = 0; e < 8; ++e) s[e] += bf2f(raw[i + k][e]);
        const int t = t0 + i, lo = max(t - A, 0), hi = min(t + (WIN - 1 - A), L - 1); const float inv = 1.0f / (float)(hi - lo + 1);
        float d[8];
#pragma unroll
        for (int e = 0; e < 8; ++e) d[e] = s[e] * inv - bf2f(raw[i + A][e]);
        u32x4 w; w.x = cvt_pk_bf16(d[0], d[1]); w.y = cvt_pk_bf16(d[2], d[3]); w.z = cvt_pk_bf16(d[4], d[5]); w.w = cvt_pk_bf16(d[6], d[7]);
        *(u32x4*)(Y1 + (size_t)(r0 + i) * D + 512 + c0) = w;
    }
}
__device__ __forceinline__ void conv_rows8(const bf16* U, bf16* Y1, const float* cw, int r0, int t0, int L, int c0) {
    bf16x8 gc[10], vl[10], gb[8];
#pragma unroll
    for (int k = 0; k < 10; ++k) { const int tt = t0 - 1 + k; gc[k] = (bf16x8){0, 0, 0, 0, 0, 0, 0, 0}; vl[k] = gc[k];
        if (tt >= 0 && tt < L) { const bf16* ur = U + (size_t)(r0 - 1 + k) * 2048; gc[k] = *(const bf16x8*)(ur + 512 + c0); vl[k] = *(const bf16x8*)(ur + 1024 + c0); } }
#pragma unroll
    for (int i = 0; i < 8; ++i) gb[i] = *(const bf16x8*)(U + (size_t)(r0 + i) * 2048 + c0);
    f32x4 w[3][2];
#pragma unroll
    for (int k = 0; k < 3; ++k) { w[k][0] = *(const f32x4*)(cw + k * 512 + c0); w[k][1] = *(const f32x4*)(cw + k * 512 + c0 + 4); }
#pragma unroll
    for (int i = 0; i < 8; ++i) {
        float o[8];
#pragma unroll
        for (int e = 0; e < 8; ++e) o[e] = 0.f;
#pragma unroll
        for (int k = 0; k < 3; ++k)
#pragma unroll
            for (int e = 0; e < 8; ++e) o[e] += (bf2f(gc[i + k][e]) * bf2f(vl[i + k][e])) * w[k][e >> 2][e & 3];
        u32x4 y; y.x = cvt_pk_bf16(bf2f(gb[i][0]) * o[0], bf2f(gb[i][1]) * o[1]); y.y = cvt_pk_bf16(bf2f(gb[i][2]) * o[2], bf2f(gb[i][3]) * o[3]);
        y.z = cvt_pk_bf16(bf2f(gb[i][4]) * o[4], bf2f(gb[i][5]) * o[5]); y.w = cvt_pk_bf16(bf2f(gb[i][6]) * o[6], bf2f(gb[i][7]) * o[7]);
        *(u32x4*)(Y1 + (size_t)(r0 + i) * D + c0) = y;
    }
}
__device__ __forceinline__ void mix_phase(const Frame& F, int j) {
    const bf16* U = F.BIG(); bf16* Y1 = F.Y1(); const float* cw = F.in(I_CONVW) + (size_t)j * 3 * 512;
    const int sub = F.lane >> 4, c16 = F.lane & 15;
    for (int wi = F.gw; wi < 8 * (MT / 32); wi += F.ngw) {
        const int cg = wi & 7, r0 = (wi >> 3) * 32 + sub * 8;
        int t0, L; if (r0 < ML) { t0 = r0 & 4095; L = SEQ; } else { t0 = (r0 - ML) & 255; L = CTXL; }
        const int c0 = ((cg & 3) * 16 + c16) * 8;
        if (cg < 4) conv_rows8(U, Y1, cw, r0, t0, L, c0);
        else if (cg == 4) pool_rows8<2>(U, Y1, r0, t0, L, c0);
        else if (cg == 5) pool_rows8<4>(U, Y1, r0, t0, L, c0);
        else if (cg == 6) pool_rows8<8>(U, Y1, r0, t0, L, c0);
        else pool_rows8<16>(U, Y1, r0, t0, L, c0);
    }
}

struct AttnState { f32x4 O[4]; float m, l; };
struct KVFrag { bf16x8 kf[2][2], vf[4]; };
__device__ __forceinline__ void attn_load(KVFrag& f, const bf16* kp  , const bf16* vp  ) {
#pragma unroll
    for (int t = 0; t < 2; ++t)
#pragma unroll
        for (int ks = 0; ks < 2; ++ks) f.kf[t][ks] = *(const bf16x8*)(kp + t * 4 * 64 + 32 * ks);
#pragma unroll
    for (int dt = 0; dt < 4; ++dt) f.vf[dt] = *(const bf16x8*)(vp + dt * 16 * 8);
}
template <bool LOCAL>
__device__ __forceinline__ void attn_compute(AttnState& st, const KVFrag& f, const bf16x8 (&qf)[2], const LAS float* brow, const float (&maskadd)[8]) {
    f32x4 S0 = (f32x4){0.f, 0.f, 0.f, 0.f}, S1 = (f32x4){0.f, 0.f, 0.f, 0.f};
    S0 = __builtin_amdgcn_mfma_f32_16x16x32_bf16(f.kf[0][0], qf[0], S0, 0, 0, 0); S0 = __builtin_amdgcn_mfma_f32_16x16x32_bf16(f.kf[0][1], qf[1], S0, 0, 0, 0);
    S1 = __builtin_amdgcn_mfma_f32_16x16x32_bf16(f.kf[1][0], qf[0], S1, 0, 0, 0); S1 = __builtin_amdgcn_mfma_f32_16x16x32_bf16(f.kf[1][1], qf[1], S1, 0, 0, 0);
    float s[8];
#pragma unroll
    for (int i = 0; i < 4; ++i) { s[i] = S0[i]; s[4 + i] = S1[i]; }
    if (LOCAL) {
#pragma unroll
        for (int i = 0; i < 8; ++i) s[i] += brow[i] + maskadd[i];
    }
    float mx = fmaxf(fmaxf(fmaxf(s[0], s[1]), fmaxf(s[2], s[3])), fmaxf(fmaxf(s[4], s[5]), fmaxf(s[6], s[7])));
    mx = fmaxf(mx, __shfl_xor(mx, 16)); mx = fmaxf(mx, __shfl_xor(mx, 32));
    const float mnew = fmaxf(st.m, mx), alpha = __builtin_amdgcn_exp2f(st.m - mnew);
    st.m = mnew;
    float p[8], ps = 0.f;
#pragma unroll
    for (int i = 0; i < 8; ++i) { p[i] = __builtin_amdgcn_exp2f(s[i] - mnew); ps += p[i]; }
    st.l = st.l * alpha + ps;
    u32x4 pw; pw.x = cvt_pk_bf16(p[0], p[1]); pw.y = cvt_pk_bf16(p[2], p[3]); pw.z = cvt_pk_bf16(p[4], p[5]); pw.w = cvt_pk_bf16(p[6], p[7]);
    const bf16x8 pb = __builtin_bit_cast(bf16x8, pw);
#pragma unroll
    for (int dt = 0; dt < 4; ++dt) { st.O[dt] = st.O[dt] * alpha; st.O[dt] = __builtin_amdgcn_mfma_f32_16x16x32_bf16(f.vf[dt], pb, st.O[dt], 0, 0, 0); }
}
__device__ __forceinline__ void attn_finish(AttnState& st, bf16* orow  ) {
    float l = st.l; l += __shfl_xor(l, 16); l += __shfl_xor(l, 32);
    const float inv = 1.0f / l;
#pragma unroll
    for (int dt = 0; dt < 4; ++dt) { const f32x4 o = st.O[dt] * inv; u32x2 w; w.x = cvt_pk_bf16(o[0], o[1]); w.y = cvt_pk_bf16(o[2], o[3]); *(u32x2*)(orow + 16 * dt) = w; }
}
template <int NL>
__device__ __forceinline__ void attn_unit(const bf16* kl, const bf16* vl, const bf16* kc, const bf16* vc, const bf16x8 (&qf)[2], const LAS float* brow0  ,
                                          const float (&maskadd)[8], bf16* orow) {
    constexpr int NC = NL + 8;
    AttnState st;
#pragma unroll
    for (int dt = 0; dt < 4; ++dt) st.O[dt] = (f32x4){0.f, 0.f, 0.f, 0.f};
    st.m = -1.0e30f; st.l = 0.f;
    KVFrag fr[3];
#define ATT_KP(c) ((c) < NL ? kl + (c) * 64 * 64 : kc + ((c) - NL) * 32 * 64)
#define ATT_VP(c) ((c) < NL ? vl + (c) * 8 * 512 : vc + ((c) - NL) * 4 * 512)
    attn_load(fr[0], ATT_KP(0), ATT_VP(0)); attn_load(fr[1], ATT_KP(1), ATT_VP(1));
#pragma unroll
    for (int c = 0; c < NC; ++c) {
        if (c + 2 < NC) attn_load(fr[(c + 2) % 3], ATT_KP(c + 2), ATT_VP(c + 2));
        __builtin_amdgcn_sched_barrier(0);
        if (c < NL) attn_compute<true>(st, fr[c % 3], qf, brow0 + c * 64, maskadd); else attn_compute<false>(st, fr[c % 3], qf, brow0, maskadd);
        __builtin_amdgcn_sched_barrier(0);
    }
#undef ATT_KP
#undef ATT_VP
    attn_finish(st, orow);
}
__device__ __forceinline__ void attn_fast(const Frame& F, const float* rpbt, bool do_ctx) {
    const bf16* QB = F.BIG(); const bf16* KH = F.BIG() + (size_t)MT * 1024; const bf16* VT8 = F.VT(); bf16* AO = F.Y1();
    LAS float* tbl = (LAS float*)F.lds;
    const int lane = F.lane, fr = lane & 15, fq = lane >> 4, wave = F.wave;
    const int krow = 8 * (fr >> 2) + (fr & 3);
    const int per = (2048 + F.G - 1) / F.G;
    int cur_h = -1;
    const int vb = (F.G % 8 == 0) ? (F.blk % 8) * (F.G / 8) + F.blk / 8 : F.blk;
    const int bu_end = min((vb + 1) * per, 2048);
    for (int bu = vb * per; bu < bu_end; ++bu) {
        const int bh = bu >> 5, rp = bu & 31, b = bh >> 4, h = bh & 15;
        if (h != cur_h) { __syncthreads(); for (int i = F.tid; i < 15 * 64; i += 512) tbl[i] = rpbt[h * 15 * 64 + i]; cur_h = h; __syncthreads(); }
        const int r = 2 * rp + (wave >> 2), jb = wave & 3;
        const int w0 = jb == 0 ? 0 : (jb == 1 ? 8 : (jb == 2 ? 24 : 32));
        const int jq = 16 * jb + fr, cs = min(max(jq - 8, 0), 48), rs = min(max(r - 4, 0), 56);
        const int qrow = b * 4096 + r * 64 + jq;
        bf16x8 qf[2];
#pragma unroll
        for (int ks = 0; ks < 2; ++ks) qf[ks] = *(const bf16x8*)(QB + (size_t)qrow * 1024 + h * 64 + 32 * ks + 8 * fq);
        float maskadd[8];
#pragma unroll
        for (int i = 0; i < 8; ++i) { const int col = w0 + 8 * fq + i; maskadd[i] = (col >= cs && col < cs + 16) ? 0.f : -1.0e30f; }
        const int boff = w0 + 8 * fq - jq + 32;
        const int tl = b * 4096 + rs * 64 + w0, tc = ML + b * 256;
        const bf16* kl = KH + ((size_t)h * MT + tl + krow) * 64 + 8 * fq;
        const bf16* vl = VT8 + (((size_t)h * (MT / 8) + (tl >> 3) + fq) * 64 + fr) * 8;
        const bf16* kc = KH + ((size_t)h * MT + tc + krow) * 64 + 8 * fq;
        const bf16* vc = VT8 + (((size_t)h * (MT / 8) + (tc >> 3) + fq) * 64 + fr) * 8;
        attn_unit<8>(kl, vl, kc, vc, qf, tbl + (rs - r + 7) * 64 + boff, maskadd, AO + (size_t)qrow * D + h * 64 + 4 * fq);
    }
    if (do_ctx) {
        for (int wu = F.gw; wu < 1024; wu += F.ngw) {
            const int bh = wu >> 4, qb = wu & 15, b = bh >> 4, h = bh & 15;
            const int qrow = ML + b * 256 + 16 * qb + fr;
            bf16x8 qf[2];
#pragma unroll
            for (int ks = 0; ks < 2; ++ks) qf[ks] = *(const bf16x8*)(QB + (size_t)qrow * 1024 + h * 64 + 32 * ks + 8 * fq);
            float maskadd[8];
#pragma unroll
            for (int i = 0; i < 8; ++i) maskadd[i] = 0.f;
            const int tc = ML + b * 256;
            const bf16* kc = KH + ((size_t)h * MT + tc + krow) * 64 + 8 * fq;
            const bf16* vc = VT8 + (((size_t)h * (MT / 8) + (tc >> 3) + fq) * 64 + fr) * 8;
            attn_unit<0>(kc, vc, kc, vc, qf, tbl, maskadd, AO + (size_t)qrow * D + h * 64 + 4 * fq);
        }
    }
}

__global__ void __launch_bounds__(512, 2) fwd_kernel(Args args) {
    extern __shared__ __attribute__((aligned(16))) unsigned char lds_raw[];
    Frame F;
    F.lds = (LAS unsigned char*)lds_raw;
    volatile LAS unsigned* MISC = (volatile LAS unsigned*)(F.lds + MISC_OFF);
    if (threadIdx.x < 32) { unsigned v = 0u; const unsigned long long ka = (unsigned long long)__builtin_amdgcn_kernarg_segment_ptr();
        if (threadIdx.x == 16) v = (unsigned)ka; if (threadIdx.x == 17) v = (unsigned)(ka >> 32); MISC[threadIdx.x] = v; }
    __syncthreads();
    F.renew();
    XcdBarrier bar = xcd_barrier_post(F.ctl() + CW_BAR, MISC + 8);
#define GRID_BAR() do { XcdBarrier b_ = bar; asm volatile("" : "+s"(b_.x)); xcd_barrier(b_); F.renew(); } while (0)
#define MODS(layer) (F.mods() + (size_t)(layer) * 5 * 6144)
#define CNT(jj) (F.ctl() + CW_CNT + 64 * (jj))
#define TAIL_CONV(nwg, q) do { if (tail_idle((nwg), F.G, F.blk)) conv_queue(F, CQ_END, (q)); } while (0)

    mods_phase(F); rpb_phase(F); poolfold_phase(F, 0); conv_dense0(F);
    GRID_BAR();

    for (int j = 0; j < 2; ++j) {
        const int le = 2 * j, lo = 2 * j + 1;
        const bool last = (j == 1);
        if (j == 0) norm_phase<true, false, false, false>(F, MT, F.in(I_GMIX) + le * D, MODS(le), 0, nullptr, nullptr, nullptr);
        else { norm_phase<false, true, false, false>(F, MT, F.in(I_GMIX) + le * D, MODS(le), 0, MODS(le - 1) + 5 * 1024, nullptr, CNT(j - 1));
               __syncthreads(); poolfold_phase(F, 1); conv_queue(F, CQ_P1D, 1 << 20); }
        GRID_BAR();
        { pg8::SchedStatic S; S.init(F.AF(), F.wb(j) + WB_WIN, MT, 2048, 1024, F.G, F.blk); EpiStoreBf16 E{F.BIG(), 2048}; pg8::gemm_phase(F.lds, F.tid, 1024, 1024, S, E); }
        TAIL_CONV(68 * 8, 3);
        GRID_BAR();
        mix_phase(F, j); bias_phase(F, j);
        GRID_BAR();
        { pg8::SchedStatic S; S.init(F.Y1(), F.wb(j) + WB_WOUT, MT, 1024, 1024, F.G, F.blk); EpiResGateNorm E{F.H(), MODS(le) + 2 * 1024, F.in(I_GFFN) + le * D, MODS(le) + 4 * 1024, F.AF(), F.ssp(2 * j), (LAS float*)(F.lds + PART_OFF)}; pg8::gemm_phase(F.lds, F.tid, 1024, 1024, S, E); }
        TAIL_CONV(68 * 4, 3);
        GRID_BAR();
        { pg8::SchedStatic S; S.init(F.AF(), F.wb(j) + WB_WGU, MT, 2 * DFF, 1024, F.G, F.blk); EpiSwiGLUNorm E{F.BIG(), DFF, F.ssp(2 * j), F.bias() + BIAS_GU + (size_t)j * 5 * 5632}; pg8::gemm_phase(F.lds, F.tid, 1024, 1024, S, E); }
        GRID_BAR();
        { pg8::SchedStatic S; S.init(F.BIG(), F.wb(j) + WB_WD, MT, 1024, DFF, F.G, F.blk); EpiResGateNorm E{F.H(), MODS(le) + 5 * 1024, F.in(I_GMIX) + lo * D, MODS(lo) + 1 * 1024, F.AF(), F.ssp(2 * j + 1), (LAS float*)(F.lds + PART_OFF)}; pg8::gemm_phase(F.lds, F.tid, DFF, DFF, S, E); }
        TAIL_CONV(68 * 4, 9);
        GRID_BAR();
        const int Mo = last ? ML : MT;
        { pg8::SchedQKVT S; S.AF = (const char*)F.AF(); S.WQK = (const char*)(F.wb(j) + WB_WQKV); S.WV = (const char*)(F.wb(j) + WB_WQKV + (size_t)2048 * 1024); S.G = F.G; S.c = F.blk; S.tstep = (size_t)256 * 1024 * 2;
          EpiQKVT E{F.BIG(), F.BIG() + (size_t)MT * 1024, F.VT(), F.ssp(2 * j + 1), F.bias() + BIAS_QKV + (size_t)j * 5 * 3072}; pg8::gemm_phase(F.lds, F.tid, 1024, 1024, S, E); }
        TAIL_CONV(pg8::SchedQKVT::NQK + pg8::SchedQKVT::NVT, 3);
        GRID_BAR();
        attn_fast(F, F.rpbt() + (size_t)j * 16 * 15 * 64, !last);
        GRID_BAR();
        { pg8::SchedStatic S; S.init(F.Y1(), F.wb(j) + WB_WO, Mo, 1024, 1024, F.G, F.blk); EpiResGate E{F.H(), MODS(lo) + 2 * 1024}; pg8::gemm_phase(F.lds, F.tid, 1024, 1024, S, E); }
        TAIL_CONV((Mo / 256) * 4, 3);
        GRID_BAR();
        norm_phase<false, false, true, false>(F, Mo, F.in(I_GFFN) + lo * D, MODS(lo), 3, nullptr, F.in(I_WR) + (size_t)j * 1024 * 8, CNT(j));
        conv_queue(F, j == 0 ? CQ_P0M : CQ_END, 1 << 20);
        GRID_BAR();
        { pg8::SchedMoe S; S.init(F.AF(), F.wb(j) + WB_WEGU, (size_t)7168 * 1024, CNT(j), (const int*)(F.ws() + WS_TOK + 2 * MiB), 2 * DFE, 1024, F.G, F.blk); EpiSwiGLU E{F.BIG(), DFE}; pg8::gemm_phase_gather(F.lds, F.tid, 1024, 1024, S, E); }
        GRID_BAR();
        { pg8::SchedDownK2 S; S.init(F.BIG(), F.wb(j) + WB_WED, CNT(j), F.G, F.blk); EpiDownK2 E{F.YPAIR(), F.YPB()}; pg8::gemm_phase(F.lds, F.tid, pg8::DOWN_KH, DFE, S, E);
          TAIL_CONV(S.nwg, 6); }
        GRID_BAR();
    }
    norm_phase<false, true, false, true>(F, ML, F.in(I_GFINAL), nullptr, 0, MODS(3) + 5 * 1024, nullptr, CNT(1));
}

extern "C" void kernel_launch(void* const* d_in, const int* in_sizes, int n_in, void* d_out, int out_size, void* d_ws, size_t ws_size, hipStream_t stream) {
    static int grid = 0;
    if (grid == 0) {
        if (n_in != 24 || out_size != ML * D || ws_size < WS_END) { fprintf(stderr, "kernel_launch: unexpected shapes (n_in %d out %d ws %zu)\n", n_in, out_size, ws_size); grid = -1; return; }
        int dev = 0, cus = 0, per_cu = 0;
        if (hipGetDevice(&dev) != hipSuccess || hipDeviceGetAttribute(&cus, hipDeviceAttributeMultiprocessorCount, dev) != hipSuccess) { grid = -1; return; }
        if (hipFuncSetAttribute((const void*)fwd_kernel, hipFuncAttributeMaxDynamicSharedMemorySize, LDS_BYTES) != hipSuccess) { fprintf(stderr, "kernel_launch: hipFuncSetAttribute failed\n"); grid = -1; return; }
        if (hipOccupancyMaxActiveBlocksPerMultiprocessor(&per_cu, (const void*)fwd_kernel, 512, LDS_BYTES) != hipSuccess || per_cu < 1) { fprintf(stderr, "kernel_launch: occupancy query says %d\n", per_cu); grid = -1; return; }
        (void)hipGetLastError();
        grid = cus;
    }
    if (grid < 0) return;
    if (hipMemsetAsync((char*)d_ws + WS_CTL, 0, CTL_BYTES, stream) != hipSuccess) return;
    Args a{};
    for (int i = 0; i < 24; ++i) a.in[i] = (const float*)d_in[i];
    a.out = (float*)d_out; a.ws = (unsigned char*)d_ws;
    hipLaunchKernelGGL(fwd_kernel, dim3(grid), dim3(512), LDS_BYTES, stream, a);
}
```

```cpp
#include <hip/hip_runtime.h>
#include <cstdio>
#include <cstdint>

#define GAS __attribute__((address_space(1)))
#define LAS __attribute__((address_space(3)))
typedef unsigned short bf16;
typedef short bf16x8 __attribute__((ext_vector_type(8)));
typedef float f32x4 __attribute__((ext_vector_type(4)));
typedef float f32x2 __attribute__((ext_vector_type(2)));
typedef unsigned u32x4 __attribute__((ext_vector_type(4)));
typedef unsigned u32x2 __attribute__((ext_vector_type(2)));

constexpr int D = 1024, NB = 4, SEQ = 4096, CTXL = 256, GW = 64;
constexpr int ML = NB * SEQ, MC = NB * CTXL, MT = ML + MC;
constexpr int DFF = 2816, NE = 8, DFE = 3584, NH = 16, HD = 64;
constexpr int MPAIR_MAX = 36864;
constexpr float EPS = 1e-6f;
constexpr float QSCALE = 0.18033688011112042f;
constexpr float LOG2E = 1.4426950408889634f;

constexpr size_t MiB = 1u << 20;
constexpr size_t WS_CTL = 0, CTL_BYTES = 1 * MiB;
constexpr size_t WS_MODS = 1 * MiB;
constexpr size_t WS_RPB = 2 * MiB;
constexpr size_t WS_TOK = 4 * MiB;
constexpr size_t WS_WB = 8 * MiB, WB_STRIDE = 200 * MiB;
constexpr size_t WS_H = 408 * MiB;
constexpr size_t WS_AF = 476 * MiB;
constexpr size_t WS_Y1 = 510 * MiB;
constexpr size_t WS_VT = 544 * MiB;
constexpr size_t WS_YPB = WS_Y1;
constexpr size_t WS_YPAIR = 582 * MiB;
constexpr size_t WS_BIG = 654 * MiB;
constexpr size_t WS_END = 906 * MiB;
static_assert(WS_YPB + (size_t)MPAIR_MAX * 1024 * 2 <= WS_YPAIR && WS_YPAIR + (size_t)MPAIR_MAX * 1024 * 2 <= WS_BIG, "expert output buffers");
constexpr size_t WB_WIN = 0;
constexpr size_t WB_WOUT = WB_WIN + (size_t)2048 * 1024;
constexpr size_t WB_WGU = WB_WOUT + (size_t)1024 * 1024;
constexpr size_t WB_WD = WB_WGU + (size_t)5632 * 1024;
constexpr size_t WB_WQKV = WB_WD + (size_t)1024 * 2816;
constexpr size_t WB_WO = WB_WQKV + (size_t)3072 * 1024;
constexpr size_t WB_WEGU = WB_WO + (size_t)1024 * 1024;
constexpr size_t WB_WED = WB_WEGU + (size_t)8 * 7168 * 1024;
constexpr size_t WB_END = WB_WED + (size_t)8 * 1024 * 3584;
static_assert(WB_END * 2 <= WB_STRIDE && WS_WB + 2 * WB_STRIDE <= WS_H, "weights fit");
static_assert(WS_BIG + (size_t)MPAIR_MAX * 3584 * 2 <= WS_END, "big fits");
constexpr int CW_CNT = 64;
constexpr int CW_QHEAD = 1024;
constexpr int CW_SS = 32768;
constexpr size_t WS_BIAS = WS_MODS + 512 * 1024;
constexpr int BIAS_GU = 0, BIAS_QKV = 2 * 5 * 5632;
constexpr int CW_BAR = 4096;

constexpr int LDS_BYTES = 147456;
constexpr int MISC_OFF = 131072 + 320;
constexpr int PART_OFF = 131072 + 1024;

#ifndef FAST_MASK
#define FAST_MASK 0x3FF
#endif
#define FAST(k) ((FAST_MASK >> (k)) & 1)
#ifndef REP_MASK
#define REP_MASK 0
#endif
#define REPN(k) (1 + ((REP_MASK >> (k)) & 1))
struct Args { const float* in[24]; float* out; unsigned char* ws; };

__device__ __forceinline__ unsigned cvt_pk_bf16(float lo, float hi) { unsigned r; asm("v_cvt_pk_bf16_f32 %0, %1, %2" : "=v"(r) : "v"(lo), "v"(hi)); return r; }
__device__ __forceinline__ float bf2f(short s) { return __uint_as_float(((unsigned)(unsigned short)s) << 16); }
__device__ __forceinline__ float bfu2f(bf16 s) { return __uint_as_float(((unsigned)s) << 16); }
__device__ __forceinline__ float wave_sum(float v) {
#pragma unroll
    for (int o = 1; o < 64; o <<= 1) v += __shfl_xor(v, o);
    return v;
}
__device__ __forceinline__ float wave_max(float v) {
#pragma unroll
    for (int o = 1; o < 64; o <<= 1) v = fmaxf(v, __shfl_xor(v, o));
    return v;
}
__device__ __forceinline__ float silu_f(float g) { return g * __builtin_amdgcn_rcpf(1.f + __builtin_amdgcn_exp2f(-1.4426950408889634f * g)); }

#define XB_TMO      128
#define XB_XCNT(j)  (256  + 64 * (j))
#define XB_XSUB(j)  (1280 + 64 * (j))
#define XB_XGEN(j)  (2304 + 64 * (j))
#define XB_TOP      3328
#define XB_TOPGEN   3392
#define XCD_BAR_WORDS 3456
#define XB_SPIN_CAP (1u << 22)
__device__ __forceinline__ unsigned xb_ld(unsigned* p)              { return __hip_atomic_load(p, __ATOMIC_RELAXED, __HIP_MEMORY_SCOPE_AGENT); }
__device__ __forceinline__ unsigned xb_add(unsigned* p, unsigned v) { return __hip_atomic_fetch_add(p, v, __ATOMIC_RELAXED, __HIP_MEMORY_SCOPE_AGENT); }
__device__ __forceinline__ unsigned xb_xcc_id() { return (unsigned)__builtin_amdgcn_s_getreg((3 << 11) | 20) & 0xFu; }
#define XB_SPIN(cond, bar) do { unsigned _sp = 0; while (cond) { __builtin_amdgcn_s_sleep(1); \
    if ((++_sp & 255u) == 0u) { if (xb_ld(&(bar)[XB_TMO])) break; if (_sp > XB_SPIN_CAP) { atomicAdd(&(bar)[XB_TMO], 1u); break; } } } } while (0)
struct XcdBarrier { unsigned* bar; unsigned x; volatile LAS unsigned* st; };
__device__ __forceinline__ XcdBarrier xcd_barrier_post(unsigned* bar, volatile LAS unsigned* st) {
    XcdBarrier b; b.bar = bar; b.x = xb_xcc_id(); b.st = st;
    if (threadIdx.x == 0) (void)xb_add(&bar[XB_XCNT(b.x)], 1u);
    return b;
}
__device__ __forceinline__ void xcd_barrier_complete(unsigned* bar, unsigned x, unsigned& nloc, unsigned& nx) {
    const unsigned G = gridDim.x * gridDim.y * gridDim.z;
    unsigned sum, cnt, mine, sp = 0u;
    for (;;) {
        sum = 0u; cnt = 0u; mine = 0u;
#pragma unroll
        for (unsigned j = 0; j < 16; ++j) { const unsigned c = xb_ld(&bar[XB_XCNT(j)]); sum += c; cnt += (c > 0u) ? 1u : 0u; mine = (j == x) ? c : mine; }
        if (sum == G) break;
        __builtin_amdgcn_s_sleep(1);
        if ((++sp & 255u) == 0u) { if (xb_ld(&bar[XB_TMO])) break; if (sp > XB_SPIN_CAP) { atomicAdd(&bar[XB_TMO], 1u); break; } }
    }
    nloc = mine > 0u ? mine : 1u; nx = cnt > 0u ? cnt : 1u;
}
__device__ __forceinline__ void xcd_barrier(const XcdBarrier& b) {
    asm volatile("s_waitcnt vmcnt(0)" ::: "memory");
    __syncthreads();
    if (threadIdx.x == 0) {
        unsigned* bar = b.bar;
        __builtin_amdgcn_s_waitcnt(0);
        unsigned nloc = b.st[0], nx = b.st[1];
        if (nloc == 0u) { xcd_barrier_complete(bar, b.x, nloc, nx); b.st[0] = nloc; b.st[1] = nx; }
        const unsigned old = xb_add(&bar[XB_XSUB(b.x)], 1u);
        const unsigned gen = old / nloc;
        if (old + 1u == (gen + 1u) * nloc) {
            __builtin_amdgcn_fence(__ATOMIC_RELEASE, "agent");
            asm volatile("s_waitcnt vmcnt(0)" ::: "memory");
            const unsigned og = xb_add(&bar[XB_TOP], 1u);
            const unsigned tg = og / nx;
            if (og + 1u == (tg + 1u) * nx) xb_add(&bar[XB_TOPGEN], 1u);
            else XB_SPIN(xb_ld(&bar[XB_TOPGEN]) == tg, bar);
            __builtin_amdgcn_fence(__ATOMIC_ACQUIRE, "agent");
            xb_add(&bar[XB_XGEN(b.x)], 1u);
            asm volatile("s_waitcnt vmcnt(0)" ::: "memory");
        } else {
            XB_SPIN(xb_ld(&bar[XB_XGEN(b.x)]) == gen, bar);
            __builtin_amdgcn_fence(__ATOMIC_ACQUIRE, "agent");
            asm volatile("s_waitcnt vmcnt(0)" ::: "memory");
        }
    }
    __syncthreads();
}

typedef const __attribute__((address_space(4))) Args* KArgs;
constexpr int KARG_OFF = 131072 + 320 + 64;
__device__ __forceinline__ KArgs kargs(LAS unsigned char* lds) { volatile LAS unsigned* m = (volatile LAS unsigned*)(lds + KARG_OFF);
    const unsigned lo = __builtin_amdgcn_readfirstlane(m[0]), hi = __builtin_amdgcn_readfirstlane(m[1]); return (KArgs)(((unsigned long long)hi << 32) | lo); }
struct Frame {
    LAS unsigned char* lds;
    KArgs K;
    int tid, lane, wave, blk, G, gw, ngw;
    __device__ __forceinline__ void renew() { K = kargs(lds); int t = threadIdx.x; asm volatile("" : "+v"(t)); tid = t; lane = t & 63; wave = __builtin_amdgcn_readfirstlane(t >> 6);
        int b = blockIdx.x, g = gridDim.x; asm volatile("" : "+s"(b), "+s"(g)); blk = b; G = g; gw = b * 8 + wave; ngw = g * 8; }
    __device__ __forceinline__ const float* in(int i) const { return K->in[i]; }
    __device__ __forceinline__ float* out() const { return K->out; }
    __device__ __forceinline__ unsigned char* ws() const { return K->ws; }
    __device__ __forceinline__ unsigned* ctl() const { return (unsigned*)(ws() + WS_CTL); }
    __device__ __forceinline__ float* mods() const { return (float*)(ws() + WS_MODS); }
    __device__ __forceinline__ float* ssp(int use) const { return (float*)(ws() + 2 * MiB + 512 * 1024) + (size_t)use * MT * 4; }
    __device__ __forceinline__ float* bias() const { return (float*)(ws() + WS_BIAS); }
    __device__ __forceinline__ float* rpbt() const { return (float*)(ws() + WS_RPB); }
    __device__ __forceinline__ int* tok() const { return (int*)(ws() + WS_TOK); }
    __device__ __forceinline__ bf16* wb(int j) const { return (bf16*)(ws() + WS_WB + (size_t)j * WB_STRIDE); }
    __device__ __forceinline__ float* H() const { return (float*)(ws() + WS_H); }
    __device__ __forceinline__ bf16* AF() const { return (bf16*)(ws() + WS_AF); }
    __device__ __forceinline__ bf16* Y1() const { return (bf16*)(ws() + WS_Y1); }
    __device__ __forceinline__ bf16* VT() const { return (bf16*)(ws() + WS_VT); }
    __device__ __forceinline__ bf16* YPAIR() const { return (bf16*)(ws() + WS_YPAIR); }
    __device__ __forceinline__ bf16* YPB() const { return (bf16*)(ws() + WS_YPB); }
    __device__ __forceinline__ bf16* BIG() const { return (bf16*)(ws() + WS_BIG); }
};
enum { I_X = 0, I_C, I_CTX, I_CCTX, I_WMOD, I_BMOD, I_GMIX, I_GFFN, I_GFINAL, I_WIN, I_CONVW, I_POOLW, I_POOLS, I_WOUT, I_WFG, I_WFU, I_WFD, I_WQKV, I_RPB, I_WONA, I_WR, I_WEG, I_WEU, I_WED };

__device__ __forceinline__ int row_bm(int row) { return row < ML ? (row >> 12) : 4; }

constexpr size_t WS_SSP = 2 * MiB + 512 * 1024;
struct NoCtx {};
struct ColCtx { f32x4 x[2][2]; };
struct RowColCtx { float r[8]; f32x4 x[2][2]; };
__device__ __forceinline__ void st8bf(bf16* p, f32x4 a, f32x4 b) { u32x4 w; w.x = cvt_pk_bf16(a[0], a[1]); w.y = cvt_pk_bf16(a[2], a[3]); w.z = cvt_pk_bf16(b[0], b[1]); w.w = cvt_pk_bf16(b[2], b[3]); *(u32x4*)p = w; }
__device__ __forceinline__ float rstd_of(const float* SSP, int row) { const f32x4 s = *(const f32x4*)(SSP + (size_t)row * 4); return 1.0f / sqrtf(((s[0] + s[1]) + (s[2] + s[3])) * (1.0f / D) + EPS); }
#define UNIT_ROW(pm, wr, fr, ri) ((pm) * 256 + ((ri) >> 2) * 128 + (wr) * 64 + (((ri) >> 1) & 1) * 32 + 8 * ((fr) >> 2) + 4 * ((ri) & 1) + ((fr) & 3))
#define UNIT_COL(pn, wc, fq, bj, n) ((pn) * 256 + (bj) * 128 + (wc) * 32 + 8 * (fq) + 4 * (n))
struct EpiStoreBf16 { bf16* O; int ldc; static constexpr bool UNIT_END = false; typedef NoCtx Ctx;
    __device__ __forceinline__ Ctx unit_ctx(int, int, int, int, int, int) const { return Ctx{}; }
    __device__ __forceinline__ void operator()(const Ctx&, int row, int col, int, f32x4 v00, f32x4 v01, f32x4 v10, f32x4 v11) const { bf16* p = O + (size_t)row * ldc + col; st8bf(p, v00, v01); st8bf(p + 128, v10, v11); } };
struct EpiDownK2 { bf16* Y0; bf16* Y1; static constexpr bool UNIT_END = false; typedef NoCtx Ctx;
    __device__ __forceinline__ Ctx unit_ctx(int, int, int, int, int, int) const { return Ctx{}; }
    __device__ __forceinline__ void operator()(const Ctx&, int row, int col, int, f32x4 v00, f32x4 v01, f32x4 v10, f32x4 v11) const {
        bf16* p = ((col >> 10) ? Y1 : Y0) + (size_t)row * 1024 + (col & 1023); st8bf(p, v00, v01); st8bf(p + 128, v10, v11); } };
struct EpiResGate { float* H; const float* gate; static constexpr bool UNIT_END = false; typedef ColCtx Ctx;
    __device__ __forceinline__ Ctx unit_ctx(int pm, int pn, int, int wc, int, int fq) const { Ctx c; const float* g = gate + row_bm(pm * 256) * 6144;
#pragma unroll
        for (int bj = 0; bj < 2; ++bj)
#pragma unroll
            for (int n = 0; n < 2; ++n) c.x[bj][n] = *(const f32x4*)(g + UNIT_COL(pn, wc, fq, bj, n));
        return c; }
    __device__ __forceinline__ void operator()(const Ctx& c, int row, int col, int, f32x4 v00, f32x4 v01, f32x4 v10, f32x4 v11) const {
        float* p = H + (size_t)row * D + col;
        *(f32x4*)p = *(const f32x4*)p + c.x[0][0] * v00; *(f32x4*)(p + 4) = *(const f32x4*)(p + 4) + c.x[0][1] * v01;
        *(f32x4*)(p + 128) = *(const f32x4*)(p + 128) + c.x[1][0] * v10; *(f32x4*)(p + 132) = *(const f32x4*)(p + 132) + c.x[1][1] * v11; } };
struct GateNormCtx { f32x4 g[2][2], G[2][2]; };
__device__ __forceinline__ float sq4(f32x4 h) { return (h[0] * h[0] + h[1] * h[1]) + (h[2] * h[2] + h[3] * h[3]); }
struct EpiResGateNorm { float* H; const float* gate; const float* gn; const float* scn  ; bf16* AFn; float* SSP; LAS float* part  ;
    static constexpr bool UNIT_END = true; typedef GateNormCtx Ctx;
    __device__ __forceinline__ Ctx unit_ctx(int pm, int pn, int, int wc, int, int fq) const { Ctx c; const int bm = row_bm(pm * 256);
#pragma unroll
        for (int bj = 0; bj < 2; ++bj)
#pragma unroll
            for (int n = 0; n < 2; ++n) { const int col = UNIT_COL(pn, wc, fq, bj, n); c.g[bj][n] = *(const f32x4*)(gate + bm * 6144 + col); c.G[bj][n] = *(const f32x4*)(gn + col) * (1.0f + *(const f32x4*)(scn + bm * 6144 + col)); }
        return c; }
    __device__ __forceinline__ void operator()(const Ctx& c, int row, int col, int, f32x4 v00, f32x4 v01, f32x4 v10, f32x4 v11) const {
        float* p = H + (size_t)row * D + col; bf16* q = AFn + (size_t)row * D + col;
        const f32x4 h00 = *(const f32x4*)p + c.g[0][0] * v00, h01 = *(const f32x4*)(p + 4) + c.g[0][1] * v01;
        *(f32x4*)p = h00; *(f32x4*)(p + 4) = h01; st8bf(q, h00 * c.G[0][0], h01 * c.G[0][1]);
        float s = sq4(h00) + sq4(h01);
        asm volatile("" ::: "memory");
        const f32x4 h10 = *(const f32x4*)(p + 128) + c.g[1][0] * v10, h11 = *(const f32x4*)(p + 132) + c.g[1][1] * v11;
        *(f32x4*)(p + 128) = h10; *(f32x4*)(p + 132) = h11; st8bf(q + 128, h10 * c.G[1][0], h11 * c.G[1][1]);
        s += sq4(h10) + sq4(h11);
        s += __shfl_xor(s, 16); s += __shfl_xor(s, 32);
        if ((threadIdx.x & 48) == 0) part[(row & 255) * 4 + ((col >> 5) & 3)] = s; }
    __device__ __forceinline__ void unit_end(int pm, int pn, int tid) const {
        if (tid < 256) { const f32x4 a = *(const LAS f32x4*)(part + tid * 4); SSP[(size_t)(pm * 256 + tid) * 4 + pn] = (a[0] + a[1]) + (a[2] + a[3]); } } };
struct EpiSwiGLU { bf16* O; int ldc; static constexpr bool UNIT_END = false; typedef NoCtx Ctx;
    __device__ __forceinline__ Ctx unit_ctx(int, int, int, int, int, int) const { return Ctx{}; }
    __device__ __forceinline__ void store(int row, int col, f32x4 g0, f32x4 g1, f32x4 u0, f32x4 u1) const {
        const int rc = ((col >> 8) << 7) + (col & 127);
        f32x4 r0, r1;
#pragma unroll
        for (int i = 0; i < 4; ++i) { r0[i] = silu_f(g0[i]) * u0[i]; r1[i] = silu_f(g1[i]) * u1[i]; }
        st8bf(O + (size_t)row * ldc + rc, r0, r1); }
    __device__ __forceinline__ void operator()(const Ctx&, int row, int col, int, f32x4 v00, f32x4 v01, f32x4 v10, f32x4 v11) const { store(row, col, v00, v01, v10, v11); } };
struct EpiSwiGLUNorm { bf16* O; int ldc; const float* SSP; const float* bias  ; static constexpr bool UNIT_END = false; typedef RowColCtx Ctx;
    __device__ __forceinline__ Ctx unit_ctx(int pm, int pn, int wr, int wc, int fr, int fq) const { Ctx c; const float* b = bias + row_bm(pm * 256) * 5632;
#pragma unroll
        for (int ri = 0; ri < 8; ++ri) c.r[ri] = rstd_of(SSP, UNIT_ROW(pm, wr, fr, ri));
#pragma unroll
        for (int bj = 0; bj < 2; ++bj)
#pragma unroll
            for (int n = 0; n < 2; ++n) c.x[bj][n] = *(const f32x4*)(b + UNIT_COL(pn, wc, fq, bj, n));
        return c; }
    __device__ __forceinline__ void operator()(const Ctx& c, int row, int col, int ri, f32x4 v00, f32x4 v01, f32x4 v10, f32x4 v11) const {
        const float r = c.r[ri]; EpiSwiGLU e{O, ldc}; e.store(row, col, v00 * r + c.x[0][0], v01 * r + c.x[0][1], v10 * r + c.x[1][0], v11 * r + c.x[1][1]); } };

struct MoeTiles {
    int c0, c1, c2, c3, c4, c5, c6, c7, total;
    __device__ __forceinline__ static int ld(const unsigned* p) { return __builtin_amdgcn_readfirstlane((int)__hip_atomic_load(p, __ATOMIC_RELAXED, __HIP_MEMORY_SCOPE_AGENT)); }
    __device__ __forceinline__ static int t(int c) { return (c + 255) >> 8; }
    __device__ __forceinline__ void init(const unsigned* cnt) { c0 = ld(cnt); c1 = ld(cnt + 1); c2 = ld(cnt + 2); c3 = ld(cnt + 3); c4 = ld(cnt + 4); c5 = ld(cnt + 5); c6 = ld(cnt + 6); c7 = ld(cnt + 7);
        total = t(c0) + t(c1) + t(c2) + t(c3) + t(c4) + t(c5) + t(c6) + t(c7); }
    __device__ __forceinline__ void tile_info(int tile, int& ex, int& pos0, int& count) const {
        int cum = 0, e = 0, first = 0, c = c0;
#define MT_STEP(k, ck, cn) cum += t(ck); if (tile >= cum) { e = k + 1; first = cum; c = cn; }
        MT_STEP(0, c0, c1) MT_STEP(1, c1, c2) MT_STEP(2, c2, c3) MT_STEP(3, c3, c4) MT_STEP(4, c4, c5) MT_STEP(5, c5, c6) MT_STEP(6, c6, c7)
#undef MT_STEP
        ex = e; pos0 = (tile - first) * 256; count = c; }
    __device__ __forceinline__ int expert_of_tile(int tile) const { int ex, pos0, count; tile_info(tile, ex, pos0, count); return ex; }
    __device__ __forceinline__ int row_offset(int ex) const {
        return ((ex > 0 ? t(c0) : 0) + (ex > 1 ? t(c1) : 0) + (ex > 2 ? t(c2) : 0) + (ex > 3 ? t(c3) : 0) + (ex > 4 ? t(c4) : 0) + (ex > 5 ? t(c5) : 0) + (ex > 6 ? t(c6) : 0)) * 256; }
};
namespace pg8 {
constexpr int BM = 256, BK = 64, HALF = 128, HTB = HALF * BK * 2, STAGE_BYTES = 8 * HTB, NXCD = 8, WGM = 8;
__host__ __device__ __forceinline__ int lds_byte(int r, int c) { const int st = (r >> 4) * 2 + (c >> 5), rr = r & 15, cc = c & 31, ob = rr * 64 + cc * 2; return st * 1024 + (ob ^ (((ob >> 9) & 1) << 5)); }
__host__ __device__ __forceinline__ void stage_rc(int b, int& R, int& C) { const int st = b / 1024, sb = b % 1024, swz = sb ^ (((sb >> 9) & 1) << 5); R = (st >> 1) * 16 + swz / 64; C = (st & 1) * 32 + (swz % 64) / 2; }
__host__ __device__ __forceinline__ int perm32(int rho) { const int n = rho >> 4, i = rho & 15; return 8 * (i >> 2) + 4 * n + (i & 3); }
struct Unit { int pm, pn; };
__device__ __forceinline__ void tile_of(int L, int nwg, int nM, int nN, int& pm, int& pn) {
    int wgid = L; { const int q = nwg / NXCD, r = nwg % NXCD, xcd = wgid % NXCD, off = wgid / NXCD; wgid = (xcd < r ? xcd * (q + 1) : r * (q + 1) + (xcd - r) * q) + off; }
    const int nig = WGM * nN, gid = wgid / nig, fm = gid * WGM, gsz = (nM - fm) < WGM ? (nM - fm) : WGM;
    pm = fm + ((wgid % nig) % gsz); pn = (wgid % nig) / gsz;
}
struct SchedStatic {
    const char* A; const char* B; int nM, nN, nwg, G, c; size_t tstep;
    __device__ __forceinline__ void init(const bf16* A_, const bf16* B_, int M, int N, int K, int G_, int c_) { A = (const char*)A_; B = (const char*)B_; nM = M / BM; nN = N / BM; nwg = nM * nN; G = G_; c = c_; tstep = (size_t)BM * K * 2; }
    __device__ __forceinline__ bool next(int i, Unit& u) const { const int L = i * G + c; if (L >= nwg) return false; tile_of(L, nwg, nM, nN, u.pm, u.pn); return true; }
    __device__ __forceinline__ const char* a_base(const Unit& u) const { return A + (size_t)u.pm * tstep; }
    __device__ __forceinline__ const char* b_base(const Unit& u) const { return B + (size_t)u.pn * tstep; }
};
struct SchedQKVT {
    const char* AF; const char* WQK; const char* WV; int G, c; size_t tstep;
    static constexpr int NQK = 68 * 8, NVT = 4 * 68;
    __device__ __forceinline__ bool next(int i, Unit& u) const { const int L = i * G + c; if (L >= NQK + NVT) return false;
        int wgid = L; { const int nwg = NQK + NVT, q = nwg / NXCD, r = nwg % NXCD, xcd = wgid % NXCD, off = wgid / NXCD; wgid = (xcd < r ? xcd * (q + 1) : r * (q + 1) + (xcd - r) * q) + off; }
        if (wgid < NQK) { const int nig = WGM * 8, gid = wgid / nig, fm = gid * WGM, gsz = (68 - fm) < WGM ? (68 - fm) : WGM; u.pm = fm + ((wgid % nig) % gsz); u.pn = (wgid % nig) / gsz; }
        else { const int w = wgid - NQK; u.pm = 68 + (w & 3); u.pn = w >> 2; }
        return true; }
    __device__ __forceinline__ const char* a_base(const Unit& u) const { return u.pm < 68 ? AF + (size_t)u.pm * tstep : WV + (size_t)(u.pm - 68) * tstep; }
    __device__ __forceinline__ const char* b_base(const Unit& u) const { return u.pm < 68 ? WQK + (size_t)u.pn * tstep : AF + (size_t)u.pn * tstep; }
};
struct SchedMoe {
    const char* A; const char* B; const int* rowsrc; MoeTiles mt; int nN, nwg, G, c; size_t tstep, estride;
    __device__ __forceinline__ void init(const bf16* A_, const bf16* B_, size_t estride_elems, const unsigned* cnt, const int* rowsrc_, int N, int K, int G_, int c_) { A = (const char*)A_; B = (const char*)B_; rowsrc = rowsrc_; mt.init(cnt); nN = N / BM; nwg = mt.total * nN; G = G_; c = c_; tstep = (size_t)BM * K * 2; estride = estride_elems * 2; }
    __device__ __forceinline__ bool next(int i, Unit& u) const { const int L = i * G + c; if (L >= nwg) return false; tile_of(L, nwg, mt.total, nN, u.pm, u.pn); return true; }
    __device__ __forceinline__ const char* a_base(const Unit& u) const { return A + (size_t)u.pm * tstep; }
    __device__ __forceinline__ const char* b_base(const Unit& u) const { return B + (size_t)mt.expert_of_tile(u.pm) * estride + (size_t)u.pn * tstep; }
    __device__ __forceinline__ const char* a_matrix() const { return A; }
    __device__ __forceinline__ void rows_of(const Unit& u, const int (&r)[4], int (&row)[4]) const { int ex, pos0, count; mt.tile_info(u.pm, ex, pos0, count); const int* rs = rowsrc + (size_t)ex * MT + pos0;
#pragma unroll
        for (int q = 0; q < 4; ++q) row[q] = (pos0 + r[q] < count) ? rs[r[q]] : 0; }
};
constexpr int DOWN_KH = 1792;
struct SchedDownK2 {
    const char* A; const char* B; MoeTiles mt; int nwg, G, c; size_t tstep, estride;
    __device__ __forceinline__ void init(const bf16* A_, const bf16* B_, const unsigned* cnt, int G_, int c_) { A = (const char*)A_; B = (const char*)B_; mt.init(cnt); nwg = mt.total * 8; G = G_; c = c_; tstep = (size_t)BM * DFE * 2; estride = (size_t)1024 * DFE * 2; }
    __device__ __forceinline__ bool next(int i, Unit& u) const { const int L = i * G + c; if (L >= nwg) return false; tile_of(L, nwg, mt.total, 8, u.pm, u.pn); return true; }
    __device__ __forceinline__ const char* a_base(const Unit& u) const { return A + (size_t)u.pm * tstep + (size_t)(u.pn >> 2) * DOWN_KH * 2; }
    __device__ __forceinline__ const char* b_base(const Unit& u) const { return B + (size_t)mt.expert_of_tile(u.pm) * estride + (size_t)(u.pn & 3) * tstep + (size_t)(u.pn >> 2) * DOWN_KH * 2; }
};
template <class Epi>
__device__ __forceinline__ void epi_apply(const f32x4 (&acc)[2][2][4][2], const Unit& u, int wr, int wc, int fr, int fq, const Epi& E, int tid) {
    const typename Epi::Ctx ctx = E.unit_ctx(u.pm, u.pn, wr, wc, fr, fq);
    const int col = u.pn * BM + wc * 32 + 8 * fq;
#pragma unroll
    for (int ai = 0; ai < 2; ++ai)
#pragma unroll
        for (int m = 0; m < 4; ++m) {
            E(ctx, UNIT_ROW(u.pm, wr, fr, ai * 4 + m), col, ai * 4 + m, acc[ai][0][m][0], acc[ai][0][m][1], acc[ai][1][m][0], acc[ai][1][m][1]);
            if (m & 1) asm volatile("" ::: "memory"); }
    if constexpr (Epi::UNIT_END) {
        asm volatile("s_waitcnt lgkmcnt(0)" ::: "memory"); __builtin_amdgcn_s_barrier(); asm volatile("" ::: "memory");
        E.unit_end(u.pm, u.pn, tid);
    }
}
template <class Epi, class Sched>
__device__ __forceinline__ void gemm_phase(LAS unsigned char* lds, const int tid, const int K, const int LD  , const Sched& S, const Epi& E) {
    const int wid = __builtin_amdgcn_readfirstlane(tid >> 6), lane = tid & 63, wr = wid >> 2, wc = wid & 3, fr = lane & 15, fq = lane >> 4;
    const int nt = K / BK;
    unsigned voff[2];
#pragma unroll
    for (int i = 0; i < 2; ++i) { int R, C; stage_rc(tid * 16 + i * 8192, R, C); R = (R & ~31) + perm32(R & 31); voff[i] = (unsigned)(R * LD + C) * 2u; }
    const size_t kstep = (size_t)(BK * 2);
    const size_t hstep = (size_t)HALF * LD * 2;
    const unsigned ldsw = (unsigned)wid * 1024u;
    const int aoff = lds_byte(wr * 64 + fr, fq * 8), boff = lds_byte(wc * 32 + fr, fq * 8);
#define PG8_SA(b, h) (((b) * 2 + (h)) * HTB)
#define PG8_SB(b, h) ((4 + (b) * 2 + (h)) * HTB)
#define PG8_STAGE(bufoff, gbase) do { _Pragma("unroll") for (int _i = 0; _i < 2; ++_i) \
        __builtin_amdgcn_global_load_lds((const unsigned*)((const char*)(gbase) + voff[_i]), (LAS unsigned*)(lds + (bufoff) + ldsw + _i * 8192), 16, 0, 0); } while (0)
#define PG8_LDA(dst, b, h) do { _Pragma("unroll") for (int m = 0; m < 4; ++m) _Pragma("unroll") for (int k = 0; k < 2; ++k) dst[m][k] = *(const LAS bf16x8*)(lds + PG8_SA(b, h) + aoff + m * 2048 + k * 1024); } while (0)
#define PG8_LDB(dst, b, h) do { _Pragma("unroll") for (int n = 0; n < 2; ++n) _Pragma("unroll") for (int k = 0; k < 2; ++k) dst[n][k] = *(const LAS bf16x8*)(lds + PG8_SB(b, h) + boff + n * 2048 + k * 1024); } while (0)
#define PG8_MMA(ai, bj, At, Bt) do { __builtin_amdgcn_s_setprio(1); _Pragma("unroll") for (int m = 0; m < 4; ++m) _Pragma("unroll") for (int n = 0; n < 2; ++n) _Pragma("unroll") for (int k = 0; k < 2; ++k) \
        acc[ai][bj][m][n] = __builtin_amdgcn_mfma_f32_16x16x32_bf16(Bt[n][k], At[m][k], acc[ai][bj][m][n], 0, 0, 0); __builtin_amdgcn_s_setprio(0); } while (0)
#define PG8_WAIT_V(n) asm volatile("s_waitcnt vmcnt(" #n ")" ::: "memory")
#define PG8_WAIT_L(n) asm volatile("s_waitcnt lgkmcnt(" #n ")" ::: "memory")
#define PG8_BAR __builtin_amdgcn_s_barrier()
#define PG8_SCHED __builtin_amdgcn_sched_barrier(0)
    Unit cur, nxt; int ui = 0;
    if (!S.next(0, cur)) return;
    f32x4 acc[2][2][4][2];
#pragma unroll
    for (int a = 0; a < 2; ++a)
#pragma unroll
        for (int b = 0; b < 2; ++b)
#pragma unroll
            for (int m = 0; m < 4; ++m)
#pragma unroll
                for (int n = 0; n < 2; ++n) acc[a][b][m][n] = (f32x4){0.f, 0.f, 0.f, 0.f};
    bf16x8 At[4][2], B0[2][2], B1[2][2];
    const char* cA = S.a_base(cur); const char* cB = S.b_base(cur);
    PG8_STAGE(PG8_SB(0, 0), cB); PG8_STAGE(PG8_SB(0, 1), cB + hstep); PG8_STAGE(PG8_SA(0, 0), cA); PG8_STAGE(PG8_SA(0, 1), cA + hstep);
    if (wr == 1) PG8_BAR;
    PG8_WAIT_V(2); PG8_BAR;
    PG8_STAGE(PG8_SB(1, 0), cB + kstep); PG8_STAGE(PG8_SA(1, 0), cA + kstep); PG8_STAGE(PG8_SB(1, 1), cB + hstep + kstep);
    PG8_WAIT_V(6); PG8_BAR;
    for (;;) {
        const bool has_next = S.next(ui + 1, nxt);
        const char* nA = has_next ? S.a_base(nxt) : cA; const char* nB = has_next ? S.b_base(nxt) : cB;
        for (int t = 0; t < nt; t += 2) {
            const bool last = (t == nt - 2);
            const char* a1 = cA + (size_t)(t + 1) * kstep;
            const char* a2 = last ? nA : cA + (size_t)(t + 2) * kstep; const char* b2 = last ? nB : cB + (size_t)(t + 2) * kstep;
            const char* a3 = a2 + kstep; const char* b3 = b2 + kstep;
            PG8_LDB(B0, 0, 0); PG8_LDB(B1, 0, 1); PG8_SCHED; PG8_LDA(At, 0, 0); PG8_STAGE(PG8_SA(1, 1), a1 + hstep);
            PG8_WAIT_V(8); PG8_WAIT_L(0); PG8_BAR; PG8_MMA(0, 0, At, B0); PG8_MMA(0, 1, At, B1); PG8_BAR; PG8_SCHED;
            PG8_LDA(At, 0, 1); PG8_STAGE(PG8_SB(0, 0), b2); PG8_STAGE(PG8_SB(0, 1), b2 + hstep); PG8_STAGE(PG8_SA(0, 0), a2);
            PG8_WAIT_V(8); PG8_WAIT_L(0); PG8_BAR; PG8_MMA(1, 0, At, B0); PG8_MMA(1, 1, At, B1); PG8_BAR; PG8_SCHED;
            PG8_LDB(B0, 1, 0); PG8_LDB(B1, 1, 1); PG8_SCHED; PG8_LDA(At, 1, 0); PG8_STAGE(PG8_SA(0, 1), a2 + hstep);
            PG8_WAIT_V(8); PG8_WAIT_L(0); PG8_BAR; PG8_MMA(0, 0, At, B0); PG8_MMA(0, 1, At, B1); PG8_BAR; PG8_SCHED;
            PG8_LDA(At, 1, 1); PG8_STAGE(PG8_SB(1, 0), b3); PG8_STAGE(PG8_SB(1, 1), b3 + hstep); PG8_STAGE(PG8_SA(1, 0), a3);
            PG8_WAIT_V(8); PG8_WAIT_L(0); PG8_BAR; PG8_MMA(1, 0, At, B0); PG8_MMA(1, 1, At, B1); PG8_BAR; PG8_SCHED;
        }
        if (wr == 0) PG8_BAR;
        epi_apply(acc, cur, wr, wc, fr, fq, E, tid);
        if (!has_next) break;
#pragma unroll
        for (int a = 0; a < 2; ++a)
#pragma unroll
            for (int b = 0; b < 2; ++b)
#pragma unroll
                for (int m = 0; m < 4; ++m)
#pragma unroll
                    for (int n = 0; n < 2; ++n) acc[a][b][m][n] = (f32x4){0.f, 0.f, 0.f, 0.f};
        cur = nxt; cA = nA; cB = nB; ++ui;
        if (wr == 1) PG8_BAR;
    }
    PG8_WAIT_V(0);
    PG8_BAR;
#undef PG8_SA
#undef PG8_SB
#undef PG8_STAGE
#undef PG8_LDA
#undef PG8_LDB
#undef PG8_MMA
#undef PG8_WAIT_V
#undef PG8_WAIT_L
#undef PG8_BAR
#undef PG8_SCHED
}
template <class Epi, class Sched>
__device__ __forceinline__ void gemm_phase_gather(LAS unsigned char* lds, const int tid, const int K, const int LD, const Sched& S, const Epi& E) {
    const int wid = __builtin_amdgcn_readfirstlane(tid >> 6), lane = tid & 63, wr = wid >> 2, wc = wid & 3, fr = lane & 15, fq = lane >> 4;
    const int nt = K / BK;
    unsigned voff[2];
#pragma unroll
    for (int i = 0; i < 2; ++i) { int R, C; stage_rc(tid * 16 + i * 8192, R, C); R = (R & ~31) + perm32(R & 31); voff[i] = (unsigned)(R * LD + C) * 2u; }
    int rloc[4];
#pragma unroll
    for (int i = 0; i < 2; ++i) { int R, C; stage_rc(tid * 16 + i * 8192, R, C); R = (R & ~31) + perm32(R & 31); rloc[i] = R; rloc[2 + i] = HALF + R; }
    unsigned vc[2][2], vn[2][2];
    const char* Am = S.a_matrix();
#define PG8_OFFS(dst, u) do { int _row[4]; S.rows_of(u, rloc, _row); _Pragma("unroll") for (int _h = 0; _h < 2; ++_h) _Pragma("unroll") for (int _i = 0; _i < 2; ++_i) \
        dst[_h][_i] = (unsigned)_row[2 * _h + _i] * (unsigned)(LD * 2) + (voff[_i] - (unsigned)(rloc[_i] * LD * 2)); } while (0)
#define PG8_STAGE_A(bufoff, koff, v) do { _Pragma("unroll") for (int _i = 0; _i < 2; ++_i) \
        __builtin_amdgcn_global_load_lds((const unsigned*)(Am + (koff) + (v)[_i]), (LAS unsigned*)(lds + (bufoff) + ldsw + _i * 8192), 16, 0, 0); } while (0)
    const size_t kstep = (size_t)(BK * 2);
    const size_t hstep = (size_t)HALF * LD * 2;
    const unsigned ldsw = (unsigned)wid * 1024u;
    const int aoff = lds_byte(wr * 64 + fr, fq * 8), boff = lds_byte(wc * 32 + fr, fq * 8);
#define PG8_SA(b, h) (((b) * 2 + (h)) * HTB)
#define PG8_SB(b, h) ((4 + (b) * 2 + (h)) * HTB)
#define PG8_STAGE(bufoff, gbase) do { _Pragma("unroll") for (int _i = 0; _i < 2; ++_i) \
        __builtin_amdgcn_global_load_lds((const unsigned*)((const char*)(gbase) + voff[_i]), (LAS unsigned*)(lds + (bufoff) + ldsw + _i * 8192), 16, 0, 0); } while (0)
#define PG8_LDA(dst, b, h) do { _Pragma("unroll") for (int m = 0; m < 4; ++m) _Pragma("unroll") for (int k = 0; k < 2; ++k) dst[m][k] = *(const LAS bf16x8*)(lds + PG8_SA(b, h) + aoff + m * 2048 + k * 1024); } while (0)
#define PG8_LDB(dst, b, h) do { _Pragma("unroll") for (int n = 0; n < 2; ++n) _Pragma("unroll") for (int k = 0; k < 2; ++k) dst[n][k] = *(const LAS bf16x8*)(lds + PG8_SB(b, h) + boff + n * 2048 + k * 1024); } while (0)
#define PG8_MMA(ai, bj, At, Bt) do { __builtin_amdgcn_s_setprio(1); _Pragma("unroll") for (int m = 0; m < 4; ++m) _Pragma("unroll") for (int n = 0; n < 2; ++n) _Pragma("unroll") for (int k = 0; k < 2; ++k) \
        acc[ai][bj][m][n] = __builtin_amdgcn_mfma_f32_16x16x32_bf16(Bt[n][k], At[m][k], acc[ai][bj][m][n], 0, 0, 0); __builtin_amdgcn_s_setprio(0); } while (0)
#define PG8_WAIT_V(n) asm volatile("s_waitcnt vmcnt(" #n ")" ::: "memory")
#define PG8_WAIT_L(n) asm volatile("s_waitcnt lgkmcnt(" #n ")" ::: "memory")
#define PG8_BAR __builtin_amdgcn_s_barrier()
#define PG8_SCHED __builtin_amdgcn_sched_barrier(0)
    Unit cur, nxt; int ui = 0;
    if (!S.next(0, cur)) return;
    f32x4 acc[2][2][4][2];
#pragma unroll
    for (int a = 0; a < 2; ++a)
#pragma unroll
        for (int b = 0; b < 2; ++b)
#pragma unroll
            for (int m = 0; m < 4; ++m)
#pragma unroll
                for (int n = 0; n < 2; ++n) acc[a][b][m][n] = (f32x4){0.f, 0.f, 0.f, 0.f};
    bf16x8 At[4][2], B0[2][2], B1[2][2];
    const char* cB = S.b_base(cur);
    PG8_OFFS(vc, cur);
    PG8_STAGE(PG8_SB(0, 0), cB); PG8_STAGE(PG8_SB(0, 1), cB + hstep); PG8_STAGE_A(PG8_SA(0, 0), 0, vc[0]); PG8_STAGE_A(PG8_SA(0, 1), 0, vc[1]);
    if (wr == 1) PG8_BAR;
    PG8_WAIT_V(2); PG8_BAR;
    PG8_STAGE(PG8_SB(1, 0), cB + kstep); PG8_STAGE_A(PG8_SA(1, 0), kstep, vc[0]); PG8_STAGE(PG8_SB(1, 1), cB + hstep + kstep);
    PG8_WAIT_V(6); PG8_BAR;
    for (;;) {
        const bool has_next = S.next(ui + 1, nxt);
        const char* nB = has_next ? S.b_base(nxt) : cB;
        if (has_next) PG8_OFFS(vn, nxt); else {
#pragma unroll
            for (int _h = 0; _h < 2; ++_h)
#pragma unroll
                for (int _i = 0; _i < 2; ++_i) vn[_h][_i] = vc[_h][_i]; }
        for (int t = 0; t < nt; t += 2) {
            const bool last = (t == nt - 2);
            const size_t k1 = (size_t)(t + 1) * kstep, k2 = last ? 0 : (size_t)(t + 2) * kstep, k3 = k2 + kstep;
            const char* b2 = last ? nB : cB + (size_t)(t + 2) * kstep; const char* b3 = b2 + kstep;
            unsigned w0[2], w1[2];
#pragma unroll
            for (int _i = 0; _i < 2; ++_i) { w0[_i] = last ? vn[0][_i] : vc[0][_i]; w1[_i] = last ? vn[1][_i] : vc[1][_i]; }
            PG8_LDB(B0, 0, 0); PG8_LDB(B1, 0, 1); PG8_SCHED; PG8_LDA(At, 0, 0); PG8_STAGE_A(PG8_SA(1, 1), k1, vc[1]);
            PG8_WAIT_V(8); PG8_WAIT_L(0); PG8_BAR; PG8_MMA(0, 0, At, B0); PG8_MMA(0, 1, At, B1); PG8_BAR; PG8_SCHED;
            PG8_LDA(At, 0, 1); PG8_STAGE(PG8_SB(0, 0), b2); PG8_STAGE(PG8_SB(0, 1), b2 + hstep); PG8_STAGE_A(PG8_SA(0, 0), k2, w0);
            PG8_WAIT_V(8); PG8_WAIT_L(0); PG8_BAR; PG8_MMA(1, 0, At, B0); PG8_MMA(1, 1, At, B1); PG8_BAR; PG8_SCHED;
            PG8_LDB(B0, 1, 0); PG8_LDB(B1, 1, 1); PG8_SCHED; PG8_LDA(At, 1, 0); PG8_STAGE_A(PG8_SA(0, 1), k2, w1);
            PG8_WAIT_V(8); PG8_WAIT_L(0); PG8_BAR; PG8_MMA(0, 0, At, B0); PG8_MMA(0, 1, At, B1); PG8_BAR; PG8_SCHED;
            PG8_LDA(At, 1, 1); PG8_STAGE(PG8_SB(1, 0), b3); PG8_STAGE(PG8_SB(1, 1), b3 + hstep); PG8_STAGE_A(PG8_SA(1, 0), k3, w0);
            PG8_WAIT_V(8); PG8_WAIT_L(0); PG8_BAR; PG8_MMA(1, 0, At, B0); PG8_MMA(1, 1, At, B1); PG8_BAR; PG8_SCHED;
        }
        if (wr == 0) PG8_BAR;
        epi_apply(acc, cur, wr, wc, fr, fq, E, tid);
        if (!has_next) break;
#pragma unroll
        for (int a = 0; a < 2; ++a)
#pragma unroll
            for (int b = 0; b < 2; ++b)
#pragma unroll
                for (int m = 0; m < 4; ++m)
#pragma unroll
                    for (int n = 0; n < 2; ++n) acc[a][b][m][n] = (f32x4){0.f, 0.f, 0.f, 0.f};
        cur = nxt; cB = nB; ++ui;
#pragma unroll
        for (int _h = 0; _h < 2; ++_h)
#pragma unroll
            for (int _i = 0; _i < 2; ++_i) vc[_h][_i] = vn[_h][_i];
        if (wr == 1) PG8_BAR;
    }
    PG8_WAIT_V(0);
    PG8_BAR;
#undef PG8_OFFS
#undef PG8_STAGE_A
#undef PG8_SA
#undef PG8_SB
#undef PG8_STAGE
#undef PG8_LDA
#undef PG8_LDB
#undef PG8_MMA
#undef PG8_WAIT_V
#undef PG8_WAIT_L
#undef PG8_BAR
#undef PG8_SCHED
}
}
struct EpiQKVT { bf16* QB; bf16* KH; bf16* VT8; const float* SSP; const float* bias  ;
    static constexpr bool UNIT_END = false; typedef RowColCtx Ctx;
    __device__ __forceinline__ Ctx unit_ctx(int pm, int pn, int wr, int wc, int fr, int fq) const { Ctx c;
        if (pm < 68) { const float* b = bias + row_bm(pm * 256) * 3072;
#pragma unroll
            for (int ri = 0; ri < 8; ++ri) c.r[ri] = rstd_of(SSP, UNIT_ROW(pm, wr, fr, ri));
#pragma unroll
            for (int bj = 0; bj < 2; ++bj)
#pragma unroll
                for (int n = 0; n < 2; ++n) c.x[bj][n] = *(const f32x4*)(b + UNIT_COL(pn, wc, fq, bj, n));
        } else { const float* b = bias + row_bm(pn * 256) * 3072 + 2048;
#pragma unroll
            for (int ri = 0; ri < 8; ++ri) c.r[ri] = b[UNIT_ROW(pm - 68, wr, fr, ri)];
#pragma unroll
            for (int bj = 0; bj < 2; ++bj)
#pragma unroll
                for (int n = 0; n < 2; ++n)
#pragma unroll
                    for (int i = 0; i < 4; ++i) c.x[bj][n][i] = rstd_of(SSP, UNIT_COL(pn, wc, fq, bj, n) + i);
        }
        return c; }
    __device__ __forceinline__ void st(int row, int col, f32x4 a, f32x4 b) const {
        if (col < 1024) st8bf(QB + (size_t)row * 1024 + col, a * QSCALE, b * QSCALE);
        else { const int cc = col - 1024; st8bf(KH + ((size_t)(cc >> 6) * MT + row) * 64 + (cc & 63), a, b); } }
    __device__ __forceinline__ void operator()(const Ctx& c, int row, int col, int ri, f32x4 v00, f32x4 v01, f32x4 v10, f32x4 v11) const {
        if (row < MT) { const float r = c.r[ri];
            st(row, col, v00 * r + c.x[0][0], v01 * r + c.x[0][1]); st(row, col + 128, v10 * r + c.x[1][0], v11 * r + c.x[1][1]);
        } else { const int ch = row - MT, h = ch >> 6, d = ch & 63; const float bb = c.r[ri];
            st8bf(VT8 + (((size_t)h * (MT / 8) + (col >> 3)) * 64 + d) * 8, v00 * c.x[0][0] + bb, v01 * c.x[0][1] + bb);
            st8bf(VT8 + (((size_t)h * (MT / 8) + ((col + 128) >> 3)) * 64 + d) * 8, v10 * c.x[1][0] + bb, v11 * c.x[1][1] + bb);
        } } };

__device__ __forceinline__ void mods_phase(const Frame& F) {
    LAS float* sl = (LAS float*)F.lds;
    LAS float* red = sl + 5 * 1024;
    const int tid = F.tid;
    for (int i = tid; i < 5 * 1024; i += 512) { const int b = i >> 10, k = i & 1023; const float v = b < 4 ? F.in(I_C)[b * 1024 + k] : F.in(I_CCTX)[k]; sl[i] = v / (1.f + expf(-v)); }
    __syncthreads();
    const int l16 = tid & 15, kg = tid >> 4;
    for (int it = F.blk; it < 4 * 96; it += F.G) {
        const int layer = it / 96, cc = it % 96;
        const float* W = F.in(I_WMOD) + (size_t)layer * 1024 * 6144 + cc * 64 + l16 * 4;
        f32x4 acc[5];
#pragma unroll
        for (int b = 0; b < 5; ++b) acc[b] = (f32x4){0.f, 0.f, 0.f, 0.f};
#pragma unroll 8
        for (int kk = 0; kk < 32; ++kk) { const int k = kg * 32 + kk; const f32x4 w = *(const f32x4*)(W + (size_t)k * 6144);
#pragma unroll
            for (int b = 0; b < 5; ++b) acc[b] += sl[b * 1024 + k] * w; }
#pragma unroll
        for (int b = 0; b < 5; ++b) *(LAS f32x4*)(red + ((kg * 5 + b) * 64 + l16 * 4)) = acc[b];
        __syncthreads();
        if (tid < 320) { const int b = tid >> 6, col = tid & 63; float s = 0.f;
            for (int g = 0; g < 32; ++g) s += red[(g * 5 + b) * 64 + col];
            F.mods()[((size_t)layer * 5 + b) * 6144 + cc * 64 + col] = s + F.in(I_BMOD)[layer * 6144 + cc * 64 + col]; }
        __syncthreads();
    }
}
__device__ __forceinline__ void rpb_phase(const Frame& F) {
    const int gt = F.blk * 512 + F.tid, ngt = F.G * 512;
    for (int i = gt; i < 2 * 16 * 15 * 64; i += ngt) { const int c = i & 63, r = (i >> 6) % 15, h = (i / (64 * 15)) & 15, jj = i / (64 * 15 * 16);
        const int dc = c - 32; float v = 0.f; if (dc >= -15 && dc <= 15) v = F.in(I_RPB)[((size_t)(jj * 16 + h) * 15 + r) * 31 + dc + 15] * LOG2E;
        F.rpbt()[i] = v; }
}
__device__ __forceinline__ void poolfold_phase(const Frame& F, int j) {
    const float* pw = F.in(I_POOLW) + (size_t)j * 4 * 128 * 128; const float* ps = F.in(I_POOLS) + (size_t)j * 512; const float* wo = F.in(I_WOUT) + (size_t)j * 1024 * 1024 + (size_t)512 * 1024;
    bf16* dst = F.wb(j) + WB_WOUT;
    const int gt = F.blk * 512 + F.tid, ngt = F.G * 512;
    for (int it = gt; it < 4 * 32 * 1024; it += ngt) {
        const int n = it & 1023, c4 = (it >> 10) & 31, g = it >> 15;
        const float* pr = pw + ((size_t)g * 128 + c4 * 4) * 128; const float* wr = wo + (size_t)g * 128 * 1024 + n; const float* sr = ps + g * 128;
        float acc[4] = {0.f, 0.f, 0.f, 0.f};
#pragma unroll 4
        for (int d = 0; d < 128; ++d) { const float w = wr[(size_t)d * 1024] * sr[d];
#pragma unroll
            for (int q = 0; q < 4; ++q) acc[q] += pr[q * 128 + d] * w; }
        u32x2 o; o.x = cvt_pk_bf16(acc[0], acc[1]); o.y = cvt_pk_bf16(acc[2], acc[3]);
        *(u32x2*)(dst + (size_t)n * 1024 + 512 + g * 128 + c4 * 4) = o;
    }
}
__device__ __forceinline__ void bias_phase(const Frame& F, int j) {
    const int lane = F.lane;
    for (int it = F.gw; it < 5632 + 3072; it += F.ngw) {
        const bool gu = it < 5632; const int n = gu ? it : it - 5632;
        const bf16* wrow = F.wb(j) + (gu ? WB_WGU : WB_WQKV) + (size_t)n * 1024;
        const float* sh = F.mods() + (size_t)(gu ? 2 * j : 2 * j + 1) * 5 * 6144 + (gu ? 3 * 1024 : 0);
        float w[16];
#pragma unroll
        for (int jj = 0; jj < 2; ++jj) { const bf16x8 v = *(const bf16x8*)(wrow + 8 * lane + 512 * jj);
#pragma unroll
            for (int e = 0; e < 8; ++e) w[8 * jj + e] = bf2f(v[e]); }
        float* out = F.bias() + (gu ? BIAS_GU + (size_t)j * 5 * 5632 : BIAS_QKV + (size_t)j * 5 * 3072);
#pragma unroll
        for (int bm = 0; bm < 5; ++bm) { float s = 0.f;
#pragma unroll
            for (int jj = 0; jj < 2; ++jj) { const f32x4 a = *(const f32x4*)(sh + bm * 6144 + 8 * lane + 512 * jj), b = *(const f32x4*)(sh + bm * 6144 + 8 * lane + 512 * jj + 4);
                s += (a[0] * w[8 * jj] + a[1] * w[8 * jj + 1]) + (a[2] * w[8 * jj + 2] + a[3] * w[8 * jj + 3]) + (b[0] * w[8 * jj + 4] + b[1] * w[8 * jj + 5]) + (b[2] * w[8 * jj + 6] + b[3] * w[8 * jj + 7]); }
            s = wave_sum(s);
            if (lane == 0) out[bm * (gu ? 5632 : 3072) + n] = s; }
    }
}
__device__ __forceinline__ void conv_tile(const float* src, int ldn, bf16* dst, int pitch, int k0, int n0, int mode, LAS unsigned* T, int lane) {
    const int c4 = (lane & 15) * 4;
#pragma unroll
    for (int it = 0; it < 8; ++it) { const int r = it * 4 + (lane >> 4);
        const f32x4 a = __builtin_nontemporal_load((const f32x4*)(src + (size_t)(k0 + 2 * r) * ldn + n0 + c4)), b = __builtin_nontemporal_load((const f32x4*)(src + (size_t)(k0 + 2 * r + 1) * ldn + n0 + c4));
#pragma unroll
        for (int c = 0; c < 4; ++c) T[(c4 + c) * 33 + r] = cvt_pk_bf16(a[c], b[c]); }
    asm volatile("s_waitcnt lgkmcnt(0)" ::: "memory");
#pragma unroll
    for (int it = 0; it < 8; ++it) { const int n = it * 8 + (lane >> 3), q = lane & 7; const int gn = n0 + n;
        const int drow = mode == 0 ? gn : ((gn >> 7) << 8) + (gn & 127) + (mode == 2 ? 128 : 0);
        u32x4 v; v.x = T[n * 33 + 4 * q]; v.y = T[n * 33 + 4 * q + 1]; v.z = T[n * 33 + 4 * q + 2]; v.w = T[n * 33 + 4 * q + 3];
        __builtin_nontemporal_store(v, (u32x4*)(dst + (size_t)drow * pitch + k0 + 8 * q)); }
    asm volatile("s_waitcnt lgkmcnt(0)" ::: "memory");
}
constexpr int CT0 = 512, CT1 = CT0 + 128, CT2 = CT1 + 704, CT3 = CT2 + 704, CT4 = CT3 + 704, CT5 = CT4 + 768, CT6 = CT5 + 256, CT7 = CT6 + 7168, CT8 = CT7 + 7168, CT9 = CT8 + 7168;
constexpr int CQ_P0M = CT9 - CT6, CQ_P1D = CQ_P0M + CT6, CQ_END = CQ_P1D + (CT9 - CT6);
static_assert(CQ_P0M % 8 == 0 && CQ_P1D % 8 == 0 && CQ_END % 8 == 0, "queue chunks");
__device__ __forceinline__ void conv_item(const Frame& F, int j, int it, LAS unsigned* T) {
    const float* src; int K, N, mode = 0, r; bf16* dst; size_t se = 0, de = 0; int tpe;
    if (it < CT0)      { r = it;       src = F.in(I_WIN) + (size_t)j * 1024 * 2048;  K = 1024; N = 2048; dst = F.wb(j) + WB_WIN; tpe = CT0; }
    else if (it < CT1) { r = it - CT0; src = F.in(I_WOUT) + (size_t)j * 1024 * 1024; K = 1024; N = 1024; dst = F.wb(j) + WB_WOUT; tpe = 128; }
    else if (it < CT2) { r = it - CT1; src = F.in(I_WFG) + (size_t)j * 1024 * DFF;   K = 1024; N = DFF; dst = F.wb(j) + WB_WGU; mode = 1; tpe = 704; }
    else if (it < CT3) { r = it - CT2; src = F.in(I_WFU) + (size_t)j * 1024 * DFF;   K = 1024; N = DFF; dst = F.wb(j) + WB_WGU; mode = 2; tpe = 704; }
    else if (it < CT4) { r = it - CT3; src = F.in(I_WFD) + (size_t)j * DFF * 1024;   K = DFF; N = 1024; dst = F.wb(j) + WB_WD; tpe = 704; }
    else if (it < CT5) { r = it - CT4; src = F.in(I_WQKV) + (size_t)j * 1024 * 3072; K = 1024; N = 3072; dst = F.wb(j) + WB_WQKV; tpe = 768; }
    else if (it < CT6) { r = it - CT5; src = F.in(I_WONA) + (size_t)j * 1024 * 1024; K = 1024; N = 1024; dst = F.wb(j) + WB_WO; tpe = 256; }
    else if (it < CT7) { r = it - CT6; src = F.in(I_WEG) + (size_t)j * NE * 1024 * DFE; K = 1024; N = DFE; dst = F.wb(j) + WB_WEGU; mode = 1; tpe = 896; se = (size_t)1024 * DFE; de = (size_t)7168 * 1024; }
    else if (it < CT8) { r = it - CT7; src = F.in(I_WEU) + (size_t)j * NE * 1024 * DFE; K = 1024; N = DFE; dst = F.wb(j) + WB_WEGU; mode = 2; tpe = 896; se = (size_t)1024 * DFE; de = (size_t)7168 * 1024; }
    else               { r = it - CT8; src = F.in(I_WED) + (size_t)j * NE * DFE * 1024; K = DFE; N = 1024; dst = F.wb(j) + WB_WED; tpe = 896; se = (size_t)DFE * 1024; de = (size_t)1024 * DFE; }
    const int e = r / tpe, rr = r % tpe, nb = N / 64, kb = rr / nb, nbi = rr % nb;
    conv_tile(src + e * se, N, dst + e * de, K, kb * 64, nbi * 64, mode, T, F.lane);
}
__device__ __forceinline__ void conv_dense0(const Frame& F) {
    LAS unsigned* T = (LAS unsigned*)(F.lds + F.wave * 8448);
    for (int it = F.gw; it < CT6; it += F.ngw) conv_item(F, 0, it, T);
}
__device__ __forceinline__ void conv_queue(const Frame& F, int limit, int max_chunks) {
    LAS unsigned* T = (LAS unsigned*)(F.lds + F.wave * 8448);
    volatile LAS int* qslot = (volatile LAS int*)(F.lds + 8 * 8448);
    unsigned* head = F.ctl() + CW_QHEAD;
    for (int n = 0; n < max_chunks; ++n) {
        __syncthreads();
        if (F.tid == 0) { int v = -1; if ((int)__hip_atomic_load(head, __ATOMIC_RELAXED, __HIP_MEMORY_SCOPE_AGENT) < limit) v = (int)__hip_atomic_fetch_add(head, 8u, __ATOMIC_RELAXED, __HIP_MEMORY_SCOPE_AGENT); *qslot = v; }
        __syncthreads();
        const int q0 = *qslot;
        if (q0 < 0 || q0 >= CQ_END) break;
        const int q = q0 + F.wave;
        if (q < CQ_P0M) conv_item(F, 0, CT6 + q, T); else if (q < CQ_P1D) conv_item(F, 1, q - CQ_P0M, T); else conv_item(F, 1, CT6 + (q - CQ_P1D), T);
    }
    __syncthreads();
}
__device__ __forceinline__ bool tail_idle(int nwg, int G, int c) { const int mine = c < nwg ? (nwg - c + G - 1) / G : 0; return mine < (nwg + G - 1) / G; }

__device__ __forceinline__ f32x4 bf4_to_f32(u32x2 u) { return (f32x4){__uint_as_float(u.x << 16), __uint_as_float(u.x & 0xffff0000u), __uint_as_float(u.y << 16), __uint_as_float(u.y & 0xffff0000u)}; }
__device__ __forceinline__ f32x4 moe_row4(const Frame& F, int rr, int c) {
    return bf4_to_f32(*(const u32x2*)(F.YPAIR() + (size_t)rr * D + c)) + bf4_to_f32(*(const u32x2*)(F.YPB() + (size_t)rr * D + c));
}
template <bool FIRST, bool COMBINE, bool ROUTER, bool FINAL>
__device__ __forceinline__ void norm_phase(const Frame& F, int Mrows, const float* g, const float* modbase  , int shift_idx, const float* prev_gate  ,
                                           const float* wr  , unsigned* cnt  ) {
    const int lane = F.lane;
    int2* tok_e = (int2*)F.tok(); int2* tok_pos = tok_e + MT; float2* tok_w = (float2*)(tok_pos + MT); int* rowsrc = (int*)(F.ws() + WS_TOK + 2 * MiB);
    constexpr int NR = 2;
    LAS int* lcnt = (LAS int*)F.lds; LAS int* lbase = lcnt + 8; LAS int* rec = lcnt + 16 + F.wave * 64;
    int nrec = 0;
    if (ROUTER) { if (F.tid < 8) lcnt[F.tid] = 0; __syncthreads(); }
    MoeTiles mtc; if (COMBINE) mtc.init(cnt);
    for (int row0 = F.gw * NR; row0 < Mrows; row0 += F.ngw * NR) {
        f32x4 v[NR][4];
#pragma unroll
        for (int q = 0; q < NR; ++q) { const int row = row0 + q;
            const float* src = FIRST ? (row < ML ? F.in(I_X) + (size_t)row * D : F.in(I_CTX) + (size_t)(row - ML) * D) : F.H() + (size_t)row * D;
#pragma unroll
            for (int jj = 0; jj < 4; ++jj) v[q][jj] = *(const f32x4*)(src + 4 * lane + 256 * jj); }
        if (COMBINE) {
#pragma unroll
            for (int q = 0; q < NR; ++q) { const int row = row0 + q; const int bm = row_bm(row);
                const int2 ee = tok_e[row], pp = tok_pos[row]; const int2 rr = make_int2(mtc.row_offset(ee.x) + pp.x, mtc.row_offset(ee.y) + pp.y); const float2 ww = tok_w[row];
                const float* pg = prev_gate + bm * 6144;
#pragma unroll
                for (int jj = 0; jj < 4; ++jj) { const int c = 4 * lane + 256 * jj; const f32x4 gg = *(const f32x4*)(pg + c);
                    const f32x4 a = moe_row4(F, rr.x, c), b = moe_row4(F, rr.y, c);
                    v[q][jj] += gg * (ww.x * a + ww.y * b); } }
        }
#pragma unroll
        for (int q = 0; q < NR; ++q) {
            const int row = row0 + q; const int bm = row_bm(row);
            if ((FIRST || COMBINE) && !FINAL) {
#pragma unroll
                for (int jj = 0; jj < 4; ++jj) *(f32x4*)(F.H() + (size_t)row * D + 4 * lane + 256 * jj) = v[q][jj];
            }
            float ss = 0.f;
#pragma unroll
            for (int jj = 0; jj < 4; ++jj) ss += (v[q][jj][0] * v[q][jj][0] + v[q][jj][1] * v[q][jj][1]) + (v[q][jj][2] * v[q][jj][2] + v[q][jj][3] * v[q][jj][3]);
            ss = wave_sum(ss);
            const float rstd = 1.0f / sqrtf(ss * (1.0f / D) + EPS);
            if (FINAL) {
#pragma unroll
                for (int jj = 0; jj < 4; ++jj) { const int c = 4 * lane + 256 * jj; *(f32x4*)(F.out() + (size_t)row * D + c) = v[q][jj] * rstd * *(const f32x4*)(g + c); }
                continue;
            }
            const float* sh = modbase + bm * 6144 + shift_idx * 1024; const float* sc = sh + 1024;
            float lg[NE];
#pragma unroll
            for (int e = 0; e < NE; ++e) lg[e] = 0.f;
#pragma unroll
            for (int jj = 0; jj < 4; ++jj) { const int c = 4 * lane + 256 * jj;
                const f32x4 y = v[q][jj] * rstd * *(const f32x4*)(g + c);
                const f32x4 a = y * (1.0f + *(const f32x4*)(sc + c)) + *(const f32x4*)(sh + c);
                u32x2 w; w.x = cvt_pk_bf16(a[0], a[1]); w.y = cvt_pk_bf16(a[2], a[3]);
                *(u32x2*)(F.AF() + (size_t)row * D + c) = w;
                if (ROUTER) {
#pragma unroll
                    for (int i = 0; i < 4; ++i) { const f32x4 w0 = *(const f32x4*)(wr + (size_t)(c + i) * 8), w1 = *(const f32x4*)(wr + (size_t)(c + i) * 8 + 4);
                        lg[0] += a[i] * w0[0]; lg[1] += a[i] * w0[1]; lg[2] += a[i] * w0[2]; lg[3] += a[i] * w0[3]; lg[4] += a[i] * w1[0]; lg[5] += a[i] * w1[1]; lg[6] += a[i] * w1[2]; lg[7] += a[i] * w1[3]; }
                }
            }
            if (ROUTER) {
#pragma unroll
                for (int e = 0; e < NE; ++e) lg[e] = wave_sum(lg[e]);
                int e0 = 0; float v0 = lg[0];
#pragma unroll
                for (int e = 1; e < NE; ++e) if (lg[e] > v0) { v0 = lg[e]; e0 = e; }
                int e1 = -1; float v1 = -3.0e38f;
#pragma unroll
                for (int e = 0; e < NE; ++e) if (e != e0 && lg[e] > v1) { v1 = lg[e]; e1 = e; }
                const float t = __expf(v1 - v0), w0 = 1.0f / (1.0f + t), w1 = t / (1.0f + t);
                if (lane == 0) {
                    const int p0 = __hip_atomic_fetch_add(lcnt + e0, 1, __ATOMIC_RELAXED, __HIP_MEMORY_SCOPE_WORKGROUP);
                    const int p1 = __hip_atomic_fetch_add(lcnt + e1, 1, __ATOMIC_RELAXED, __HIP_MEMORY_SCOPE_WORKGROUP);
                    rec[nrec * 4 + 0] = e0; rec[nrec * 4 + 1] = e1; rec[nrec * 4 + 2] = p0; rec[nrec * 4 + 3] = p1;
                    tok_e[row] = make_int2(e0, e1); tok_w[row] = make_float2(w0, w1);
                }
                ++nrec;
            }
        }
    }
    if (ROUTER) {
        __syncthreads();
        if (F.tid < 8) lbase[F.tid] = (int)__hip_atomic_fetch_add(cnt + F.tid, (unsigned)lcnt[F.tid], __ATOMIC_RELAXED, __HIP_MEMORY_SCOPE_AGENT);
        __syncthreads();
        if (lane < nrec) {
            const int row = F.gw * NR + (lane / NR) * F.ngw * NR + (lane % NR);
            const int e0 = rec[lane * 4 + 0], e1 = rec[lane * 4 + 1], p0 = lbase[e0] + rec[lane * 4 + 2], p1 = lbase[e1] + rec[lane * 4 + 3];
            tok_pos[row] = make_int2(p0, p1); rowsrc[(size_t)e0 * MT + p0] = row; rowsrc[(size_t)e1 * MT + p1] = row;
        }
    }
}

template <int WIN>
__device__ __forceinline__ void pool_rows8(const bf16* U, bf16* Y1, int r0, int t0, int L, int c0) {
    constexpr int A = WIN / 2, NRW = 8 + WIN - 1;
    bf16x8 raw[NRW];
#pragma unroll
    for (int k = 0; k < NRW; ++k) { const int tt = t0 - A + k; raw[k] = (bf16x8){0, 0, 0, 0, 0, 0, 0, 0};
        if (tt >= 0 && tt < L) raw[k] = *(const bf16x8*)(U + (size_t)(r0 - A + k) * 2048 + 1536 + c0); }
#pragma unroll
    for (int i = 0; i < 8; ++i) {
        float s[8];
#pragma unroll
        for (int e = 0; e < 8; ++e) s[e] = 0.f;
#pragma unroll
        for (int k = 0; k < WIN; ++k)
#pragma unroll
            for (int e = 0; e < 8; ++e) s[e] += bf2f(raw[i + k][e]);
        const int t = t0 + i, lo = max(t - A, 0), hi = min(t + (WIN - 1 - A), L - 1); const float inv = 1.0f / (float)(hi - lo + 1);
        float d[8];
#pragma unroll
        for (int e = 0; e < 8; ++e) d[e] = s[e] * inv - bf2f(raw[i + A][e]);
        u32x4 w; w.x = cvt_pk_bf16(d[0], d[1]); w.y = cvt_pk_bf16(d[2], d[3]); w.z = cvt_pk_bf16(d[4], d[5]); w.w = cvt_pk_bf16(d[6], d[7]);
        *(u32x4*)(Y1 + (size_t)(r0 + i) * D + 512 + c0) = w;
    }
}
__device__ __forceinline__ void conv_rows8(const bf16* U, bf16* Y1, const float* cw, int r0, int t0, int L, int c0) {
    bf16x8 gc[10], vl[10], gb[8];
#pragma unroll
    for (int k = 0; k < 10; ++k) { const int tt = t0 - 1 + k; gc[k] = (bf16x8){0, 0, 0, 0, 0, 0, 0, 0}; vl[k] = gc[k];
        if (tt >= 0 && tt < L) { const bf16* ur = U + (size_t)(r0 - 1 + k) * 2048; gc[k] = *(const bf16x8*)(ur + 512 + c0); vl[k] = *(const bf16x8*)(ur + 1024 + c0); } }
#pragma unroll
    for (int i = 0; i < 8; ++i) gb[i] = *(const bf16x8*)(U + (size_t)(r0 + i) * 2048 + c0);
    f32x4 w[3][2];
#pragma unroll
    for (int k = 0; k < 3; ++k) { w[k][0] = *(const f32x4*)(cw + k * 512 + c0); w[k][1] = *(const f32x4*)(cw + k * 512 + c0 + 4); }
#pragma unroll
    for (int i = 0; i < 8; ++i) {
        float o[8];
#pragma unroll
        for (int e = 0; e < 8; ++e) o[e] = 0.f;
#pragma unroll
        for (int k = 0; k < 3; ++k)
#pragma unroll
            for (int e = 0; e < 8; ++e) o[e] += (bf2f(gc[i + k][e]) * bf2f(vl[i + k][e])) * w[k][e >> 2][e & 3];
        u32x4 y; y.x = cvt_pk_bf16(bf2f(gb[i][0]) * o[0], bf2f(gb[i][1]) * o[1]); y.y = cvt_pk_bf16(bf2f(gb[i][2]) * o[2], bf2f(gb[i][3]) * o[3]);
        y.z = cvt_pk_bf16(bf2f(gb[i][4]) * o[4], bf2f(gb[i][5]) * o[5]); y.w = cvt_pk_bf16(bf2f(gb[i][6]) * o[6], bf2f(gb[i][7]) * o[7]);
        *(u32x4*)(Y1 + (size_t)(r0 + i) * D + c0) = y;
    }
}
__device__ __forceinline__ void mix_phase(const Frame& F, int j) {
    const bf16* U = F.BIG(); bf16* Y1 = F.Y1(); const float* cw = F.in(I_CONVW) + (size_t)j * 3 * 512;
    const int sub = F.lane >> 4, c16 = F.lane & 15;
    for (int wi = F.gw; wi < 8 * (MT / 32); wi += F.ngw) {
        const int cg = wi & 7, r0 = (wi >> 3) * 32 + sub * 8;
        int t0, L; if (r0 < ML) { t0 = r0 & 4095; L = SEQ; } else { t0 = (r0 - ML) & 255; L = CTXL; }
        const int c0 = ((cg & 3) * 16 + c16) * 8;
        if (cg < 4) conv_rows8(U, Y1, cw, r0, t0, L, c0);
        else if (cg == 4) pool_rows8<2>(U, Y1, r0, t0, L, c0);
        else if (cg == 5) pool_rows8<4>(U, Y1, r0, t0, L, c0);
        else if (cg == 6) pool_rows8<8>(U, Y1, r0, t0, L, c0);
        else pool_rows8<16>(U, Y1, r0, t0, L, c0);
    }
}

struct AttnState { f32x4 O[4]; float m, l; };
struct KVFrag { bf16x8 kf[2][2], vf[4]; };
__device__ __forceinline__ void attn_load(KVFrag& f, const bf16* kp  , const bf16* vp  ) {
#pragma unroll
    for (int t = 0; t < 2; ++t)
#pragma unroll
        for (int ks = 0; ks < 2; ++ks) f.kf[t][ks] = *(const bf16x8*)(kp + t * 4 * 64 + 32 * ks);
#pragma unroll
    for (int dt = 0; dt < 4; ++dt) f.vf[dt] = *(const bf16x8*)(vp + dt * 16 * 8);
}
template <bool LOCAL>
__device__ __forceinline__ void attn_compute(AttnState& st, const KVFrag& f, const bf16x8 (&qf)[2], const LAS float* brow, const float (&maskadd)[8]) {
    f32x4 S0 = (f32x4){0.f, 0.f, 0.f, 0.f}, S1 = (f32x4){0.f, 0.f, 0.f, 0.f};
    S0 = __builtin_amdgcn_mfma_f32_16x16x32_bf16(f.kf[0][0], qf[0], S0, 0, 0, 0); S0 = __builtin_amdgcn_mfma_f32_16x16x32_bf16(f.kf[0][1], qf[1], S0, 0, 0, 0);
    S1 = __builtin_amdgcn_mfma_f32_16x16x32_bf16(f.kf[1][0], qf[0], S1, 0, 0, 0); S1 = __builtin_amdgcn_mfma_f32_16x16x32_bf16(f.kf[1][1], qf[1], S1, 0, 0, 0);
    float s[8];
#pragma unroll
    for (int i = 0; i < 4; ++i) { s[i] = S0[i]; s[4 + i] = S1[i]; }
    if (LOCAL) {
#pragma unroll
        for (int i = 0; i < 8; ++i) s[i] += brow[i] + maskadd[i];
    }
    float mx = fmaxf(fmaxf(fmaxf(s[0], s[1]), fmaxf(s[2], s[3])), fmaxf(fmaxf(s[4], s[5]), fmaxf(s[6], s[7])));
    mx = fmaxf(mx, __shfl_xor(mx, 16)); mx = fmaxf(mx, __shfl_xor(mx, 32));
    const float mnew = fmaxf(st.m, mx), alpha = __builtin_amdgcn_exp2f(st.m - mnew);
    st.m = mnew;
    float p[8], ps = 0.f;
#pragma unroll
    for (int i = 0; i < 8; ++i) { p[i] = __builtin_amdgcn_exp2f(s[i] - mnew); ps += p[i]; }
    st.l = st.l * alpha + ps;
    u32x4 pw; pw.x = cvt_pk_bf16(p[0], p[1]); pw.y = cvt_pk_bf16(p[2], p[3]); pw.z = cvt_pk_bf16(p[4], p[5]); pw.w = cvt_pk_bf16(p[6], p[7]);
    const bf16x8 pb = __builtin_bit_cast(bf16x8, pw);
#pragma unroll
    for (int dt = 0; dt < 4; ++dt) { st.O[dt] = st.O[dt] * alpha; st.O[dt] = __builtin_amdgcn_mfma_f32_16x16x32_bf16(f.vf[dt], pb, st.O[dt], 0, 0, 0); }
}
__device__ __forceinline__ void attn_finish(AttnState& st, bf16* orow  ) {
    float l = st.l; l += __shfl_xor(l, 16); l += __shfl_xor(l, 32);
    const float inv = 1.0f / l;
#pragma unroll
    for (int dt = 0; dt < 4; ++dt) { const f32x4 o = st.O[dt] * inv; u32x2 w; w.x = cvt_pk_bf16(o[0], o[1]); w.y = cvt_pk_bf16(o[2], o[3]); *(u32x2*)(orow + 16 * dt) = w; }
}
constexpr int ATT_KC_OFF = 4096, ATT_VC_OFF = 4096 + 32768;
__device__ __forceinline__ void attn_load_lds(KVFrag& f, const LAS unsigned char* kq  , const LAS unsigned char* vq  ) {
#pragma unroll
    for (int t = 0; t < 2; ++t)
#pragma unroll
        for (int ks = 0; ks < 2; ++ks) f.kf[t][ks] = *(const LAS bf16x8*)(kq + (t * 2 + ks) * 1024);
#pragma unroll
    for (int dt = 0; dt < 4; ++dt) f.vf[dt] = *(const LAS bf16x8*)(vq + dt * 256);
}
template <int NL, bool LDSCTX>
__device__ __forceinline__ void attn_unit(const bf16* kl, const bf16* vl, const bf16* kc, const bf16* vc, const LAS unsigned char* kq, const LAS unsigned char* vq, const bf16x8 (&qf)[2],
                                          const LAS float* brow0  , const float (&maskadd)[8], bf16* orow) {
    constexpr int NC = NL + 8;
    AttnState st;
#pragma unroll
    for (int dt = 0; dt < 4; ++dt) st.O[dt] = (f32x4){0.f, 0.f, 0.f, 0.f};
    st.m = -1.0e30f; st.l = 0.f;
    KVFrag fr[3];
#define ATT_KP(c) ((c) < NL ? kl + (c) * 64 * 64 : kc + ((c) - NL) * 32 * 64)
#define ATT_VP(c) ((c) < NL ? vl + (c) * 8 * 512 : vc + ((c) - NL) * 4 * 512)
#define ATT_LOAD(set, c) do { if (LDSCTX && (c) >= NL) attn_load_lds(fr[set], kq + ((c) - NL) * 4096, vq + ((c) - NL) * 4096); else attn_load(fr[set], ATT_KP(c), ATT_VP(c)); } while (0)
    ATT_LOAD(0, 0); ATT_LOAD(1, 1);
#pragma unroll
    for (int c = 0; c < NC; ++c) {
        if (c + 2 < NC) ATT_LOAD((c + 2) % 3, c + 2);
        __builtin_amdgcn_sched_barrier(0);
        if (c < NL) attn_compute<true>(st, fr[c % 3], qf, brow0 + c * 64, maskadd); else attn_compute<false>(st, fr[c % 3], qf, brow0, maskadd);
        __builtin_amdgcn_sched_barrier(0);
    }
#undef ATT_LOAD
#undef ATT_KP
#undef ATT_VP
    attn_finish(st, orow);
}
__device__ __forceinline__ void attn_fast(const Frame& F, const float* rpbt, bool do_ctx) {
    const bf16* QB = F.BIG(); const bf16* KH = F.BIG() + (size_t)MT * 1024; const bf16* VT8 = F.VT(); bf16* AO = F.Y1();
    LAS float* tbl = (LAS float*)F.lds;
    const int lane = F.lane, fr = lane & 15, fq = lane >> 4, wave = F.wave;
    const int krow = 8 * (fr >> 2) + (fr & 3);
    const int per = (2048 + F.G - 1) / F.G;
    int cur_bh = -1;
    const LAS unsigned char* kq = F.lds + ATT_KC_OFF + (((16 * lane) ^ ((((16 * lane) >> 9) & 1) << 5)) & 1023) * 0 + (((fr * 64 + fq * 16) ^ ((((fr * 64 + fq * 16) >> 9) & 1) << 5)));
    const LAS unsigned char* vq = F.lds + ATT_VC_OFF + fq * 1024 + fr * 16;
    const int vb = (F.G % 8 == 0) ? (F.blk % 8) * (F.G / 8) + F.blk / 8 : F.blk;
    const int bu_end = min((vb + 1) * per, 2048);
    for (int bu = vb * per; bu < bu_end; ++bu) {
        const int bh = bu >> 5, rp = bu & 31, b = bh >> 4, h = bh & 15;
        if (bh != cur_bh) {
            __syncthreads();
            for (int i = F.tid; i < 15 * 64; i += 512) tbl[i] = rpbt[h * 15 * 64 + i];
            const int tcs = ML + b * 256;
#pragma unroll
            for (int s = 0; s < 4; ++s) { const int st = wave * 4 + s, tile = st >> 1, ks = st & 1;
                const int sb = 16 * lane, swz = sb ^ (((sb >> 9) & 1) << 5), rr = swz >> 6, cc = (swz & 63) >> 1, key = 16 * (tile >> 1) * 2 + 4 * (tile & 1) + 8 * (rr >> 2) + (rr & 3);
                __builtin_amdgcn_global_load_lds((const unsigned*)(KH + ((size_t)h * MT + tcs + key) * 64 + 32 * ks + cc), (LAS unsigned*)(F.lds + ATT_KC_OFF + st * 1024), 16, 0, 0);
                __builtin_amdgcn_global_load_lds((const unsigned*)(VT8 + ((size_t)h * (MT / 8) + (tcs >> 3) + st) * 512 + 8 * lane), (LAS unsigned*)(F.lds + ATT_VC_OFF + st * 1024), 16, 0, 0); }
            asm volatile("s_waitcnt vmcnt(0)" ::: "memory");
            cur_bh = bh; __syncthreads(); }
        const int r = 2 * rp + (wave >> 2), jb = wave & 3;
        const int w0 = jb == 0 ? 0 : (jb == 1 ? 8 : (jb == 2 ? 24 : 32));
        const int jq = 16 * jb + fr, cs = min(max(jq - 8, 0), 48), rs = min(max(r - 4, 0), 56);
        const int qrow = b * 4096 + r * 64 + jq;
        bf16x8 qf[2];
#pragma unroll
        for (int ks = 0; ks < 2; ++ks) qf[ks] = *(const bf16x8*)(QB + (size_t)qrow * 1024 + h * 64 + 32 * ks + 8 * fq);
        float maskadd[8];
#pragma unroll
        for (int i = 0; i < 8; ++i) { const int col = w0 + 8 * fq + i; maskadd[i] = (col >= cs && col < cs + 16) ? 0.f : -1.0e30f; }
        const int boff = w0 + 8 * fq - jq + 32;
        const int tl = b * 4096 + rs * 64 + w0, tc = ML + b * 256;
        const bf16* kl = KH + ((size_t)h * MT + tl + krow) * 64 + 8 * fq;
        const bf16* vl = VT8 + (((size_t)h * (MT / 8) + (tl >> 3) + fq) * 64 + fr) * 8;
        const bf16* kc = KH + ((size_t)h * MT + tc + krow) * 64 + 8 * fq;
        const bf16* vc = VT8 + (((size_t)h * (MT / 8) + (tc >> 3) + fq) * 64 + fr) * 8;
        attn_unit<8, true>(kl, vl, kc, vc, kq, vq, qf, tbl + (rs - r + 7) * 64 + boff, maskadd, AO + (size_t)qrow * D + h * 64 + 4 * fq);
    }
    if (do_ctx) {
        for (int wu = F.gw; wu < 1024; wu += F.ngw) {
            const int bh = wu >> 4, qb = wu & 15, b = bh >> 4, h = bh & 15;
            const int qrow = ML + b * 256 + 16 * qb + fr;
            bf16x8 qf[2];
#pragma unroll
            for (int ks = 0; ks < 2; ++ks) qf[ks] = *(const bf16x8*)(QB + (size_t)qrow * 1024 + h * 64 + 32 * ks + 8 * fq);
            float maskadd[8];
#pragma unroll
            for (int i = 0; i < 8; ++i) maskadd[i] = 0.f;
            const int tc = ML + b * 256;
            const bf16* kc = KH + ((size_t)h * MT + tc + krow) * 64 + 8 * fq;
            const bf16* vc = VT8 + (((size_t)h * (MT / 8) + (tc >> 3) + fq) * 64 + fr) * 8;
            attn_unit<0, false>(kc, vc, kc, vc, kq, vq, qf, tbl, maskadd, AO + (size_t)qrow * D + h * 64 + 4 * fq);
        }
    }
}

__global__ void __launch_bounds__(512, 2) fwd_kernel(Args args) {
    extern __shared__ __attribute__((aligned(16))) unsigned char lds_raw[];
    Frame F;
    F.lds = (LAS unsigned char*)lds_raw;
    volatile LAS unsigned* MISC = (volatile LAS unsigned*)(F.lds + MISC_OFF);
    if (threadIdx.x < 32) { unsigned v = 0u; const unsigned long long ka = (unsigned long long)__builtin_amdgcn_kernarg_segment_ptr();
        if (threadIdx.x == 16) v = (unsigned)ka; if (threadIdx.x == 17) v = (unsigned)(ka >> 32); MISC[threadIdx.x] = v; }
    __syncthreads();
    F.renew();
    XcdBarrier bar = xcd_barrier_post(F.ctl() + CW_BAR, MISC + 8);
#define GRID_BAR() do { XcdBarrier b_ = bar; asm volatile("" : "+s"(b_.x)); xcd_barrier(b_); F.renew(); } while (0)
#define MODS(layer) (F.mods() + (size_t)(layer) * 5 * 6144)
#define CNT(jj) (F.ctl() + CW_CNT + 64 * (jj))
#define TAIL_CONV(nwg, q) do { if (tail_idle((nwg), F.G, F.blk)) conv_queue(F, CQ_END, (q)); } while (0)

    mods_phase(F); rpb_phase(F); poolfold_phase(F, 0); conv_dense0(F);
    GRID_BAR();

    for (int j = 0; j < 2; ++j) {
        const int le = 2 * j, lo = 2 * j + 1;
        const bool last = (j == 1);
        if (j == 0) norm_phase<true, false, false, false>(F, MT, F.in(I_GMIX) + le * D, MODS(le), 0, nullptr, nullptr, nullptr);
        else { norm_phase<false, true, false, false>(F, MT, F.in(I_GMIX) + le * D, MODS(le), 0, MODS(le - 1) + 5 * 1024, nullptr, CNT(j - 1));
               __syncthreads(); poolfold_phase(F, 1); conv_queue(F, CQ_P1D, 1 << 20); }
        GRID_BAR();
        { pg8::SchedStatic S; S.init(F.AF(), F.wb(j) + WB_WIN, MT, 2048, 1024, F.G, F.blk); EpiStoreBf16 E{F.BIG(), 2048}; pg8::gemm_phase(F.lds, F.tid, 1024, 1024, S, E); }
        TAIL_CONV(68 * 8, 3);
        GRID_BAR();
        mix_phase(F, j); bias_phase(F, j);
        GRID_BAR();
        { pg8::SchedStatic S; S.init(F.Y1(), F.wb(j) + WB_WOUT, MT, 1024, 1024, F.G, F.blk); EpiResGateNorm E{F.H(), MODS(le) + 2 * 1024, F.in(I_GFFN) + le * D, MODS(le) + 4 * 1024, F.AF(), F.ssp(2 * j), (LAS float*)(F.lds + PART_OFF)}; pg8::gemm_phase(F.lds, F.tid, 1024, 1024, S, E); }
        TAIL_CONV(68 * 4, 3);
        GRID_BAR();
        { pg8::SchedStatic S; S.init(F.AF(), F.wb(j) + WB_WGU, MT, 2 * DFF, 1024, F.G, F.blk); EpiSwiGLUNorm E{F.BIG(), DFF, F.ssp(2 * j), F.bias() + BIAS_GU + (size_t)j * 5 * 5632}; pg8::gemm_phase(F.lds, F.tid, 1024, 1024, S, E); }
        GRID_BAR();
        { pg8::SchedStatic S; S.init(F.BIG(), F.wb(j) + WB_WD, MT, 1024, DFF, F.G, F.blk); EpiResGateNorm E{F.H(), MODS(le) + 5 * 1024, F.in(I_GMIX) + lo * D, MODS(lo) + 1 * 1024, F.AF(), F.ssp(2 * j + 1), (LAS float*)(F.lds + PART_OFF)}; pg8::gemm_phase(F.lds, F.tid, DFF, DFF, S, E); }
        TAIL_CONV(68 * 4, 9);
        GRID_BAR();
        const int Mo = last ? ML : MT;
        { pg8::SchedQKVT S; S.AF = (const char*)F.AF(); S.WQK = (const char*)(F.wb(j) + WB_WQKV); S.WV = (const char*)(F.wb(j) + WB_WQKV + (size_t)2048 * 1024); S.G = F.G; S.c = F.blk; S.tstep = (size_t)256 * 1024 * 2;
          EpiQKVT E{F.BIG(), F.BIG() + (size_t)MT * 1024, F.VT(), F.ssp(2 * j + 1), F.bias() + BIAS_QKV + (size_t)j * 5 * 3072}; pg8::gemm_phase(F.lds, F.tid, 1024, 1024, S, E); }
        TAIL_CONV(pg8::SchedQKVT::NQK + pg8::SchedQKVT::NVT, 3);
        GRID_BAR();
        attn_fast(F, F.rpbt() + (size_t)j * 16 * 15 * 64, !last);
        GRID_BAR();
        { pg8::SchedStatic S; S.init(F.Y1(), F.wb(j) + WB_WO, Mo, 1024, 1024, F.G, F.blk); EpiResGate E{F.H(), MODS(lo) + 2 * 1024}; pg8::gemm_phase(F.lds, F.tid, 1024, 1024, S, E); }
        TAIL_CONV((Mo / 256) * 4, 3);
        GRID_BAR();
        norm_phase<false, false, true, false>(F, Mo, F.in(I_GFFN) + lo * D, MODS(lo), 3, nullptr, F.in(I_WR) + (size_t)j * 1024 * 8, CNT(j));
        conv_queue(F, j == 0 ? CQ_P0M : CQ_END, 1 << 20);
        GRID_BAR();
        { pg8::SchedMoe S; S.init(F.AF(), F.wb(j) + WB_WEGU, (size_t)7168 * 1024, CNT(j), (const int*)(F.ws() + WS_TOK + 2 * MiB), 2 * DFE, 1024, F.G, F.blk); EpiSwiGLU E{F.BIG(), DFE}; pg8::gemm_phase_gather(F.lds, F.tid, 1024, 1024, S, E); }
        GRID_BAR();
        { pg8::SchedDownK2 S; S.init(F.BIG(), F.wb(j) + WB_WED, CNT(j), F.G, F.blk); EpiDownK2 E{F.YPAIR(), F.YPB()}; pg8::gemm_phase(F.lds, F.tid, pg8::DOWN_KH, DFE, S, E);
          TAIL_CONV(S.nwg, 6); }
        GRID_BAR();
    }
    norm_phase<false, true, false, true>(F, ML, F.in(I_GFINAL), nullptr, 0, MODS(3) + 5 * 1024, nullptr, CNT(1));
}

extern "C" void kernel_launch(void* const* d_in, const int* in_sizes, int n_in, void* d_out, int out_size, void* d_ws, size_t ws_size, hipStream_t stream) {
    static int grid = 0;
    if (grid == 0) {
        if (n_in != 24 || out_size != ML * D || ws_size < WS_END) { fprintf(stderr, "kernel_launch: unexpected shapes (n_in %d out %d ws %zu)\n", n_in, out_size, ws_size); grid = -1; return; }
        int dev = 0, cus = 0, per_cu = 0;
        if (hipGetDevice(&dev) != hipSuccess || hipDeviceGetAttribute(&cus, hipDeviceAttributeMultiprocessorCount, dev) != hipSuccess) { grid = -1; return; }
        if (hipFuncSetAttribute((const void*)fwd_kernel, hipFuncAttributeMaxDynamicSharedMemorySize, LDS_BYTES) != hipSuccess) { fprintf(stderr, "kernel_launch: hipFuncSetAttribute failed\n"); grid = -1; return; }
        if (hipOccupancyMaxActiveBlocksPerMultiprocessor(&per_cu, (const void*)fwd_kernel, 512, LDS_BYTES) != hipSuccess || per_cu < 1) { fprintf(stderr, "kernel_launch: occupancy query says %d\n", per_cu); grid = -1; return; }
        (void)hipGetLastError();
        grid = cus;
    }
    if (grid < 0) return;
    if (hipMemsetAsync((char*)d_ws + WS_CTL, 0, CTL_BYTES, stream) != hipSuccess) return;
    Args a{};
    for (int i = 0; i < 24; ++i) a.in[i] = (const float*)d_in[i];
    a.out = (float*)d_out; a.ws = (unsigned char*)d_ws;
    hipLaunchKernelGGL(fwd_kernel, dim3(grid), dim3(512), LDS_BYTES, stream, a);
}
```

```cpp
#include <hip/hip_runtime.h>
#include <cstdio>
#include <cstdint>

#define GAS __attribute__((address_space(1)))
#define LAS __attribute__((address_space(3)))
typedef unsigned short bf16;
typedef short bf16x8 __attribute__((ext_vector_type(8)));
typedef float f32x4 __attribute__((ext_vector_type(4)));
typedef float f32x2 __attribute__((ext_vector_type(2)));
typedef unsigned u32x4 __attribute__((ext_vector_type(4)));
typedef unsigned u32x2 __attribute__((ext_vector_type(2)));

constexpr int D = 1024, NB = 4, SEQ = 4096, CTXL = 256, GW = 64;
constexpr int ML = NB * SEQ, MC = NB * CTXL, MT = ML + MC;
constexpr int DFF = 2816, NE = 8, DFE = 3584, NH = 16, HD = 64;
constexpr int MPAIR_MAX = 36864;
constexpr float EPS = 1e-6f;
constexpr float QSCALE = 0.18033688011112042f;
constexpr float LOG2E = 1.4426950408889634f;

constexpr size_t MiB = 1u << 20;
constexpr size_t WS_CTL = 0, CTL_BYTES = 1 * MiB;
constexpr size_t WS_MODS = 1 * MiB;
constexpr size_t WS_RPB = 2 * MiB;
constexpr size_t WS_TOK = 4 * MiB;
constexpr size_t WS_WB = 8 * MiB, WB_STRIDE = 200 * MiB;
constexpr size_t WS_H = 408 * MiB;
constexpr size_t WS_AF = 476 * MiB;
constexpr size_t WS_Y1 = 510 * MiB;
constexpr size_t WS_VT = 544 * MiB;
constexpr size_t WS_YPB = WS_Y1;
constexpr size_t WS_YPAIR = 582 * MiB;
constexpr size_t WS_BIG = 654 * MiB;
constexpr size_t WS_END = 906 * MiB;
static_assert(WS_YPB + (size_t)MPAIR_MAX * 1024 * 2 <= WS_YPAIR && WS_YPAIR + (size_t)MPAIR_MAX * 1024 * 2 <= WS_BIG, "expert output buffers");
constexpr size_t WB_WIN = 0;
constexpr size_t WB_WOUT = WB_WIN + (size_t)2048 * 1024;
constexpr size_t WB_WGU = WB_WOUT + (size_t)1024 * 1024;
constexpr size_t WB_WD = WB_WGU + (size_t)5632 * 1024;
constexpr size_t WB_WQKV = WB_WD + (size_t)1024 * 2816;
constexpr size_t WB_WO = WB_WQKV + (size_t)3072 * 1024;
constexpr size_t WB_WEGU = WB_WO + (size_t)1024 * 1024;
constexpr size_t WB_WED = WB_WEGU + (size_t)8 * 7168 * 1024;
constexpr size_t WB_END = WB_WED + (size_t)8 * 1024 * 3584;
static_assert(WB_END * 2 <= WB_STRIDE && WS_WB + 2 * WB_STRIDE <= WS_H, "weights fit");
static_assert(WS_BIG + (size_t)MPAIR_MAX * 3584 * 2 <= WS_END, "big fits");
constexpr int CW_CNT = 64;
constexpr int CW_QHEAD = 1024;
constexpr int CW_SS = 32768;
constexpr size_t WS_BIAS = WS_MODS + 512 * 1024;
constexpr int BIAS_GU = 0, BIAS_QKV = 2 * 5 * 5632;
constexpr int CW_BAR = 4096;

constexpr int LDS_BYTES = 147456;
constexpr int MISC_OFF = 131072 + 320;
constexpr int PART_OFF = 131072 + 1024;

#ifndef FAST_MASK
#define FAST_MASK 0x3FF
#endif
#define FAST(k) ((FAST_MASK >> (k)) & 1)
#ifndef REP_MASK
#define REP_MASK 0
#endif
#define REPN(k) (1 + ((REP_MASK >> (k)) & 1))
struct Args { const float* in[24]; float* out; unsigned char* ws; };

__device__ __forceinline__ unsigned cvt_pk_bf16(float lo, float hi) { unsigned r; asm("v_cvt_pk_bf16_f32 %0, %1, %2" : "=v"(r) : "v"(lo), "v"(hi)); return r; }
__device__ __forceinline__ float bf2f(short s) { return __uint_as_float(((unsigned)(unsigned short)s) << 16); }
__device__ __forceinline__ float bfu2f(bf16 s) { return __uint_as_float(((unsigned)s) << 16); }
__device__ __forceinline__ float wave_sum(float v) {
#pragma unroll
    for (int o = 1; o < 64; o <<= 1) v += __shfl_xor(v, o);
    return v;
}
__device__ __forceinline__ float wave_max(float v) {
#pragma unroll
    for (int o = 1; o < 64; o <<= 1) v = fmaxf(v, __shfl_xor(v, o));
    return v;
}
__device__ __forceinline__ float silu_f(float g) { return g * __builtin_amdgcn_rcpf(1.f + __builtin_amdgcn_exp2f(-1.4426950408889634f * g)); }

#define XB_TMO      128
#define XB_XCNT(j)  (256  + 64 * (j))
#define XB_XSUB(j)  (1280 + 64 * (j))
#define XB_XGEN(j)  (2304 + 64 * (j))
#define XB_TOP      3328
#define XB_TOPGEN   3392
#define XCD_BAR_WORDS 3456
#define XB_SPIN_CAP (1u << 22)
__device__ __forceinline__ unsigned xb_ld(unsigned* p)              { return __hip_atomic_load(p, __ATOMIC_RELAXED, __HIP_MEMORY_SCOPE_AGENT); }
__device__ __forceinline__ unsigned xb_add(unsigned* p, unsigned v) { return __hip_atomic_fetch_add(p, v, __ATOMIC_RELAXED, __HIP_MEMORY_SCOPE_AGENT); }
__device__ __forceinline__ unsigned xb_xcc_id() { return (unsigned)__builtin_amdgcn_s_getreg((3 << 11) | 20) & 0xFu; }
#define XB_SPIN(cond, bar) do { unsigned _sp = 0; while (cond) { __builtin_amdgcn_s_sleep(1); \
    if ((++_sp & 255u) == 0u) { if (xb_ld(&(bar)[XB_TMO])) break; if (_sp > XB_SPIN_CAP) { atomicAdd(&(bar)[XB_TMO], 1u); break; } } } } while (0)
struct XcdBarrier { unsigned* bar; unsigned x; volatile LAS unsigned* st; };
__device__ __forceinline__ XcdBarrier xcd_barrier_post(unsigned* bar, volatile LAS unsigned* st) {
    XcdBarrier b; b.bar = bar; b.x = xb_xcc_id(); b.st = st;
    if (threadIdx.x == 0) (void)xb_add(&bar[XB_XCNT(b.x)], 1u);
    return b;
}
__device__ __forceinline__ void xcd_barrier_complete(unsigned* bar, unsigned x, unsigned& nloc, unsigned& nx) {
    const unsigned G = gridDim.x * gridDim.y * gridDim.z;
    unsigned sum, cnt, mine, sp = 0u;
    for (;;) {
        sum = 0u; cnt = 0u; mine = 0u;
#pragma unroll
        for (unsigned j = 0; j < 16; ++j) { const unsigned c = xb_ld(&bar[XB_XCNT(j)]); sum += c; cnt += (c > 0u) ? 1u : 0u; mine = (j == x) ? c : mine; }
        if (sum == G) break;
        __builtin_amdgcn_s_sleep(1);
        if ((++sp & 255u) == 0u) { if (xb_ld(&bar[XB_TMO])) break; if (sp > XB_SPIN_CAP) { atomicAdd(&bar[XB_TMO], 1u); break; } }
    }
    nloc = mine > 0u ? mine : 1u; nx = cnt > 0u ? cnt : 1u;
}
__device__ __forceinline__ void xcd_barrier(const XcdBarrier& b) {
    asm volatile("s_waitcnt vmcnt(0)" ::: "memory");
    __syncthreads();
    if (threadIdx.x == 0) {
        unsigned* bar = b.bar;
        __builtin_amdgcn_s_waitcnt(0);
        unsigned nloc = b.st[0], nx = b.st[1];
        if (nloc == 0u) { xcd_barrier_complete(bar, b.x, nloc, nx); b.st[0] = nloc; b.st[1] = nx; }
        const unsigned old = xb_add(&bar[XB_XSUB(b.x)], 1u);
        const unsigned gen = old / nloc;
        if (old + 1u == (gen + 1u) * nloc) {
            __builtin_amdgcn_fence(__ATOMIC_RELEASE, "agent");
            asm volatile("s_waitcnt vmcnt(0)" ::: "memory");
            const unsigned og = xb_add(&bar[XB_TOP], 1u);
            const unsigned tg = og / nx;
            if (og + 1u == (tg + 1u) * nx) xb_add(&bar[XB_TOPGEN], 1u);
            else XB_SPIN(xb_ld(&bar[XB_TOPGEN]) == tg, bar);
            __builtin_amdgcn_fence(__ATOMIC_ACQUIRE, "agent");
            xb_add(&bar[XB_XGEN(b.x)], 1u);
            asm volatile("s_waitcnt vmcnt(0)" ::: "memory");
        } else {
            XB_SPIN(xb_ld(&bar[XB_XGEN(b.x)]) == gen, bar);
            __builtin_amdgcn_fence(__ATOMIC_ACQUIRE, "agent");
            asm volatile("s_waitcnt vmcnt(0)" ::: "memory");
        }
    }
    __syncthreads();
}

typedef const __attribute__((address_space(4))) Args* KArgs;
constexpr int KARG_OFF = 131072 + 320 + 64;
__device__ __forceinline__ KArgs kargs(LAS unsigned char* lds) { volatile LAS unsigned* m = (volatile LAS unsigned*)(lds + KARG_OFF);
    const unsigned lo = __builtin_amdgcn_readfirstlane(m[0]), hi = __builtin_amdgcn_readfirstlane(m[1]); return (KArgs)(((unsigned long long)hi << 32) | lo); }
struct Frame {
    LAS unsigned char* lds;
    KArgs K;
    int tid, lane, wave, blk, G, gw, ngw;
    __device__ __forceinline__ void renew() { K = kargs(lds); int t = threadIdx.x; asm volatile("" : "+v"(t)); tid = t; lane = t & 63; wave = __builtin_amdgcn_readfirstlane(t >> 6);
        int b = blockIdx.x, g = gridDim.x; asm volatile("" : "+s"(b), "+s"(g)); blk = b; G = g; gw = b * 8 + wave; ngw = g * 8; }
    __device__ __forceinline__ const float* in(int i) const { return K->in[i]; }
    __device__ __forceinline__ float* out() const { return K->out; }
    __device__ __forceinline__ unsigned char* ws() const { return K->ws; }
    __device__ __forceinline__ unsigned* ctl() const { return (unsigned*)(ws() + WS_CTL); }
    __device__ __forceinline__ float* mods() const { return (float*)(ws() + WS_MODS); }
    __device__ __forceinline__ float* ssp(int use) const { return (float*)(ws() + 2 * MiB + 512 * 1024) + (size_t)use * MT * 4; }
    __device__ __forceinline__ float* bias() const { return (float*)(ws() + WS_BIAS); }
    __device__ __forceinline__ float* rpbt() const { return (float*)(ws() + WS_RPB); }
    __device__ __forceinline__ int* tok() const { return (int*)(ws() + WS_TOK); }
    __device__ __forceinline__ bf16* wb(int j) const { return (bf16*)(ws() + WS_WB + (size_t)j * WB_STRIDE); }
    __device__ __forceinline__ float* H() const { return (float*)(ws() + WS_H); }
    __device__ __forceinline__ bf16* AF() const { return (bf16*)(ws() + WS_AF); }
    __device__ __forceinline__ bf16* Y1() const { return (bf16*)(ws() + WS_Y1); }
    __device__ __forceinline__ bf16* VT() const { return (bf16*)(ws() + WS_VT); }
    __device__ __forceinline__ bf16* YPAIR() const { return (bf16*)(ws() + WS_YPAIR); }
    __device__ __forceinline__ bf16* YPB() const { return (bf16*)(ws() + WS_YPB); }
    __device__ __forceinline__ bf16* BIG() const { return (bf16*)(ws() + WS_BIG); }
};
enum { I_X = 0, I_C, I_CTX, I_CCTX, I_WMOD, I_BMOD, I_GMIX, I_GFFN, I_GFINAL, I_WIN, I_CONVW, I_POOLW, I_POOLS, I_WOUT, I_WFG, I_WFU, I_WFD, I_WQKV, I_RPB, I_WONA, I_WR, I_WEG, I_WEU, I_WED };

__device__ __forceinline__ int row_bm(int row) { return row < ML ? (row >> 12) : 4; }

constexpr size_t WS_SSP = 2 * MiB + 512 * 1024;
struct NoCtx {};
struct ColCtx { f32x4 x[2][2]; };
struct RowColCtx { float r[8]; f32x4 x[2][2]; };
__device__ __forceinline__ void st8bf(bf16* p, f32x4 a, f32x4 b) { u32x4 w; w.x = cvt_pk_bf16(a[0], a[1]); w.y = cvt_pk_bf16(a[2], a[3]); w.z = cvt_pk_bf16(b[0], b[1]); w.w = cvt_pk_bf16(b[2], b[3]); *(u32x4*)p = w; }
__device__ __forceinline__ float rstd_of(const float* SSP, int row) { const f32x4 s = *(const f32x4*)(SSP + (size_t)row * 4); return 1.0f / sqrtf(((s[0] + s[1]) + (s[2] + s[3])) * (1.0f / D) + EPS); }
#define UNIT_ROW(pm, wr, fr, ri) ((pm) * 256 + ((ri) >> 2) * 128 + (wr) * 64 + (((ri) >> 1) & 1) * 32 + 8 * ((fr) >> 2) + 4 * ((ri) & 1) + ((fr) & 3))
#define UNIT_COL(pn, wc, fq, bj, n) ((pn) * 256 + (bj) * 128 + (wc) * 32 + 8 * (fq) + 4 * (n))
struct EpiStoreBf16 { bf16* O; int ldc; static constexpr bool UNIT_END = false; typedef NoCtx Ctx;
    __device__ __forceinline__ Ctx unit_ctx(int, int, int, int, int, int) const { return Ctx{}; }
    __device__ __forceinline__ void operator()(const Ctx&, int row, int col, int, f32x4 v00, f32x4 v01, f32x4 v10, f32x4 v11) const { bf16* p = O + (size_t)row * ldc + col; st8bf(p, v00, v01); st8bf(p + 128, v10, v11); } };
struct EpiDownK2 { bf16* Y0; bf16* Y1; static constexpr bool UNIT_END = false; typedef NoCtx Ctx;
    __device__ __forceinline__ Ctx unit_ctx(int, int, int, int, int, int) const { return Ctx{}; }
    __device__ __forceinline__ void operator()(const Ctx&, int row, int col, int, f32x4 v00, f32x4 v01, f32x4 v10, f32x4 v11) const {
        bf16* p = ((col >> 10) ? Y1 : Y0) + (size_t)row * 1024 + (col & 1023); st8bf(p, v00, v01); st8bf(p + 128, v10, v11); } };
struct EpiResGate { float* H; const float* gate; static constexpr bool UNIT_END = false; typedef ColCtx Ctx;
    __device__ __forceinline__ Ctx unit_ctx(int pm, int pn, int, int wc, int, int fq) const { Ctx c; const float* g = gate + row_bm(pm * 256) * 6144;
#pragma unroll
        for (int bj = 0; bj < 2; ++bj)
#pragma unroll
            for (int n = 0; n < 2; ++n) c.x[bj][n] = *(const f32x4*)(g + UNIT_COL(pn, wc, fq, bj, n));
        return c; }
    __device__ __forceinline__ void operator()(const Ctx& c, int row, int col, int, f32x4 v00, f32x4 v01, f32x4 v10, f32x4 v11) const {
        float* p = H + (size_t)row * D + col;
        *(f32x4*)p = *(const f32x4*)p + c.x[0][0] * v00; *(f32x4*)(p + 4) = *(const f32x4*)(p + 4) + c.x[0][1] * v01;
        *(f32x4*)(p + 128) = *(const f32x4*)(p + 128) + c.x[1][0] * v10; *(f32x4*)(p + 132) = *(const f32x4*)(p + 132) + c.x[1][1] * v11; } };
struct GateNormCtx { f32x4 g[2][2], G[2][2]; };
__device__ __forceinline__ float sq4(f32x4 h) { return (h[0] * h[0] + h[1] * h[1]) + (h[2] * h[2] + h[3] * h[3]); }
struct EpiResGateNorm { float* H; const float* gate; const float* gn; const float* scn  ; bf16* AFn; float* SSP; LAS float* part  ;
    static constexpr bool UNIT_END = true; typedef GateNormCtx Ctx;
    __device__ __forceinline__ Ctx unit_ctx(int pm, int pn, int, int wc, int, int fq) const { Ctx c; const int bm = row_bm(pm * 256);
#pragma unroll
        for (int bj = 0; bj < 2; ++bj)
#pragma unroll
            for (int n = 0; n < 2; ++n) { const int col = UNIT_COL(pn, wc, fq, bj, n); c.g[bj][n] = *(const f32x4*)(gate + bm * 6144 + col); c.G[bj][n] = *(const f32x4*)(gn + col) * (1.0f + *(const f32x4*)(scn + bm * 6144 + col)); }
        return c; }
    __device__ __forceinline__ void operator()(const Ctx& c, int row, int col, int, f32x4 v00, f32x4 v01, f32x4 v10, f32x4 v11) const {
        float* p = H + (size_t)row * D + col; bf16* q = AFn + (size_t)row * D + col;
        const f32x4 h00 = *(const f32x4*)p + c.g[0][0] * v00, h01 = *(const f32x4*)(p + 4) + c.g[0][1] * v01;
        *(f32x4*)p = h00; *(f32x4*)(p + 4) = h01; st8bf(q, h00 * c.G[0][0], h01 * c.G[0][1]);
        float s = sq4(h00) + sq4(h01);
        asm volatile("" ::: "memory");
        const f32x4 h10 = *(const f32x4*)(p + 128) + c.g[1][0] * v10, h11 = *(const f32x4*)(p + 132) + c.g[1][1] * v11;
        *(f32x4*)(p + 128) = h10; *(f32x4*)(p + 132) = h11; st8bf(q + 128, h10 * c.G[1][0], h11 * c.G[1][1]);
        s += sq4(h10) + sq4(h11);
        s += __shfl_xor(s, 16); s += __shfl_xor(s, 32);
        if ((threadIdx.x & 48) == 0) part[(row & 255) * 4 + ((col >> 5) & 3)] = s; }
    __device__ __forceinline__ void unit_end(int pm, int pn, int tid) const {
        if (tid < 256) { const f32x4 a = *(const LAS f32x4*)(part + tid * 4); SSP[(size_t)(pm * 256 + tid) * 4 + pn] = (a[0] + a[1]) + (a[2] + a[3]); } } };
struct EpiSwiGLU { bf16* O; int ldc; static constexpr bool UNIT_END = false; typedef NoCtx Ctx;
    __device__ __forceinline__ Ctx unit_ctx(int, int, int, int, int, int) const { return Ctx{}; }
    __device__ __forceinline__ void store(int row, int col, f32x4 g0, f32x4 g1, f32x4 u0, f32x4 u1) const {
        const int rc = ((col >> 8) << 7) + (col & 127);
        f32x4 r0, r1;
#pragma unroll
        for (int i = 0; i < 4; ++i) { r0[i] = silu_f(g0[i]) * u0[i]; r1[i] = silu_f(g1[i]) * u1[i]; }
        st8bf(O + (size_t)row * ldc + rc, r0, r1); }
    __device__ __forceinline__ void operator()(const Ctx&, int row, int col, int, f32x4 v00, f32x4 v01, f32x4 v10, f32x4 v11) const { store(row, col, v00, v01, v10, v11); } };
struct EpiSwiGLUNorm { bf16* O; int ldc; const float* SSP; const float* bias  ; static constexpr bool UNIT_END = false; typedef RowColCtx Ctx;
    __device__ __forceinline__ Ctx unit_ctx(int pm, int pn, int wr, int wc, int fr, int fq) const { Ctx c; const float* b = bias + row_bm(pm * 256) * 5632;
#pragma unroll
        for (int ri = 0; ri < 8; ++ri) c.r[ri] = rstd_of(SSP, UNIT_ROW(pm, wr, fr, ri));
#pragma unroll
        for (int bj = 0; bj < 2; ++bj)
#pragma unroll
            for (int n = 0; n < 2; ++n) c.x[bj][n] = *(const f32x4*)(b + UNIT_COL(pn, wc, fq, bj, n));
        return c; }
    __device__ __forceinline__ void operator()(const Ctx& c, int row, int col, int ri, f32x4 v00, f32x4 v01, f32x4 v10, f32x4 v11) const {
        const float r = c.r[ri]; EpiSwiGLU e{O, ldc}; e.store(row, col, v00 * r + c.x[0][0], v01 * r + c.x[0][1], v10 * r + c.x[1][0], v11 * r + c.x[1][1]); } };

struct MoeTiles {
    int c0, c1, c2, c3, c4, c5, c6, c7, total;
    __device__ __forceinline__ static int ld(const unsigned* p) { return __builtin_amdgcn_readfirstlane((int)__hip_atomic_load(p, __ATOMIC_RELAXED, __HIP_MEMORY_SCOPE_AGENT)); }
    __device__ __forceinline__ static int t(int c) { return (c + 255) >> 8; }
    __device__ __forceinline__ void init(const unsigned* cnt) { c0 = ld(cnt); c1 = ld(cnt + 1); c2 = ld(cnt + 2); c3 = ld(cnt + 3); c4 = ld(cnt + 4); c5 = ld(cnt + 5); c6 = ld(cnt + 6); c7 = ld(cnt + 7);
        total = t(c0) + t(c1) + t(c2) + t(c3) + t(c4) + t(c5) + t(c6) + t(c7); }
    __device__ __forceinline__ void tile_info(int tile, int& ex, int& pos0, int& count) const {
        int cum = 0, e = 0, first = 0, c = c0;
#define MT_STEP(k, ck, cn) cum += t(ck); if (tile >= cum) { e = k + 1; first = cum; c = cn; }
        MT_STEP(0, c0, c1) MT_STEP(1, c1, c2) MT_STEP(2, c2, c3) MT_STEP(3, c3, c4) MT_STEP(4, c4, c5) MT_STEP(5, c5, c6) MT_STEP(6, c6, c7)
#undef MT_STEP
        ex = e; pos0 = (tile - first) * 256; count = c; }
    __device__ __forceinline__ int expert_of_tile(int tile) const { int ex, pos0, count; tile_info(tile, ex, pos0, count); return ex; }
    __device__ __forceinline__ int row_offset(int ex) const {
        return ((ex > 0 ? t(c0) : 0) + (ex > 1 ? t(c1) : 0) + (ex > 2 ? t(c2) : 0) + (ex > 3 ? t(c3) : 0) + (ex > 4 ? t(c4) : 0) + (ex > 5 ? t(c5) : 0) + (ex > 6 ? t(c6) : 0)) * 256; }
};
namespace pg8 {
constexpr int BM = 256, BK = 64, HALF = 128, HTB = HALF * BK * 2, STAGE_BYTES = 8 * HTB, NXCD = 8, WGM = 8;
__host__ __device__ __forceinline__ int lds_byte(int r, int c) { const int st = (r >> 4) * 2 + (c >> 5), rr = r & 15, cc = c & 31, ob = rr * 64 + cc * 2; return st * 1024 + (ob ^ (((ob >> 9) & 1) << 5)); }
__host__ __device__ __forceinline__ void stage_rc(int b, int& R, int& C) { const int st = b / 1024, sb = b % 1024, swz = sb ^ (((sb >> 9) & 1) << 5); R = (st >> 1) * 16 + swz / 64; C = (st & 1) * 32 + (swz % 64) / 2; }
__host__ __device__ __forceinline__ int perm32(int rho) { const int n = rho >> 4, i = rho & 15; return 8 * (i >> 2) + 4 * n + (i & 3); }
struct Unit { int pm, pn; };
__device__ __forceinline__ void tile_of(int L, int nwg, int nM, int nN, int& pm, int& pn) {
    int wgid = L; { const int q = nwg / NXCD, r = nwg % NXCD, xcd = wgid % NXCD, off = wgid / NXCD; wgid = (xcd < r ? xcd * (q + 1) : r * (q + 1) + (xcd - r) * q) + off; }
    const int nig = WGM * nN, gid = wgid / nig, fm = gid * WGM, gsz = (nM - fm) < WGM ? (nM - fm) : WGM;
    pm = fm + ((wgid % nig) % gsz); pn = (wgid % nig) / gsz;
}
struct SchedStatic {
    const char* A; const char* B; int nM, nN, nwg, G, c; size_t tstep;
    __device__ __forceinline__ void init(const bf16* A_, const bf16* B_, int M, int N, int K, int G_, int c_) { A = (const char*)A_; B = (const char*)B_; nM = M / BM; nN = N / BM; nwg = nM * nN; G = G_; c = c_; tstep = (size_t)BM * K * 2; }
    __device__ __forceinline__ bool next(int i, Unit& u) const { const int L = i * G + c; if (L >= nwg) return false; tile_of(L, nwg, nM, nN, u.pm, u.pn); return true; }
    __device__ __forceinline__ const char* a_base(const Unit& u) const { return A + (size_t)u.pm * tstep; }
    __device__ __forceinline__ const char* b_base(const Unit& u) const { return B + (size_t)u.pn * tstep; }
};
struct SchedQKVT {
    const char* AF; const char* WQK; const char* WV; int G, c; size_t tstep;
    static constexpr int NQK = 68 * 8, NVT = 4 * 68;
    __device__ __forceinline__ bool next(int i, Unit& u) const { const int L = i * G + c; if (L >= NQK + NVT) return false;
        int wgid = L; { const int nwg = NQK + NVT, q = nwg / NXCD, r = nwg % NXCD, xcd = wgid % NXCD, off = wgid / NXCD; wgid = (xcd < r ? xcd * (q + 1) : r * (q + 1) + (xcd - r) * q) + off; }
        if (wgid < NQK) { const int nig = WGM * 8, gid = wgid / nig, fm = gid * WGM, gsz = (68 - fm) < WGM ? (68 - fm) : WGM; u.pm = fm + ((wgid % nig) % gsz); u.pn = (wgid % nig) / gsz; }
        else { const int w = wgid - NQK; u.pm = 68 + (w & 3); u.pn = w >> 2; }
        return true; }
    __device__ __forceinline__ const char* a_base(const Unit& u) const { return u.pm < 68 ? AF + (size_t)u.pm * tstep : WV + (size_t)(u.pm - 68) * tstep; }
    __device__ __forceinline__ const char* b_base(const Unit& u) const { return u.pm < 68 ? WQK + (size_t)u.pn * tstep : AF + (size_t)u.pn * tstep; }
};
struct SchedMoe {
    const char* A; const char* B; const int* rowsrc; MoeTiles mt; int nN, nwg, G, c; size_t tstep, estride;
    __device__ __forceinline__ void init(const bf16* A_, const bf16* B_, size_t estride_elems, const unsigned* cnt, const int* rowsrc_, int N, int K, int G_, int c_) { A = (const char*)A_; B = (const char*)B_; rowsrc = rowsrc_; mt.init(cnt); nN = N / BM; nwg = mt.total * nN; G = G_; c = c_; tstep = (size_t)BM * K * 2; estride = estride_elems * 2; }
    __device__ __forceinline__ bool next(int i, Unit& u) const { const int L = i * G + c; if (L >= nwg) return false; tile_of(L, nwg, mt.total, nN, u.pm, u.pn); return true; }
    __device__ __forceinline__ const char* a_base(const Unit& u) const { return A + (size_t)u.pm * tstep; }
    __device__ __forceinline__ const char* b_base(const Unit& u) const { return B + (size_t)mt.expert_of_tile(u.pm) * estride + (size_t)u.pn * tstep; }
    __device__ __forceinline__ const char* a_matrix() const { return A; }
    __device__ __forceinline__ void rows_of(const Unit& u, const int (&r)[4], int (&row)[4]) const { int ex, pos0, count; mt.tile_info(u.pm, ex, pos0, count); const int* rs = rowsrc + (size_t)ex * MT + pos0;
#pragma unroll
        for (int q = 0; q < 4; ++q) row[q] = (pos0 + r[q] < count) ? rs[r[q]] : 0; }
};
constexpr int DOWN_KH = 1792;
struct SchedDownK2 {
    const char* A; const char* B; MoeTiles mt; int nwg, G, c; size_t tstep, estride;
    __device__ __forceinline__ void init(const bf16* A_, const bf16* B_, const unsigned* cnt, int G_, int c_) { A = (const char*)A_; B = (const char*)B_; mt.init(cnt); nwg = mt.total * 8; G = G_; c = c_; tstep = (size_t)BM * DFE * 2; estride = (size_t)1024 * DFE * 2; }
    __device__ __forceinline__ bool next(int i, Unit& u) const { const int L = i * G + c; if (L >= nwg) return false; tile_of(L, nwg, mt.total, 8, u.pm, u.pn); return true; }
    __device__ __forceinline__ const char* a_base(const Unit& u) const { return A + (size_t)u.pm * tstep + (size_t)(u.pn >> 2) * DOWN_KH * 2; }
    __device__ __forceinline__ const char* b_base(const Unit& u) const { return B + (size_t)mt.expert_of_tile(u.pm) * estride + (size_t)(u.pn & 3) * tstep + (size_t)(u.pn >> 2) * DOWN_KH * 2; }
};
template <class Epi>
__device__ __forceinline__ void epi_apply(const f32x4 (&acc)[2][2][4][2], const Unit& u, int wr, int wc, int fr, int fq, const Epi& E, int tid) {
    const typename Epi::Ctx ctx = E.unit_ctx(u.pm, u.pn, wr, wc, fr, fq);
    const int col = u.pn * BM + wc * 32 + 8 * fq;
#pragma unroll
    for (int ai = 0; ai < 2; ++ai)
#pragma unroll
        for (int m = 0; m < 4; ++m) {
            E(ctx, UNIT_ROW(u.pm, wr, fr, ai * 4 + m), col, ai * 4 + m, acc[ai][0][m][0], acc[ai][0][m][1], acc[ai][1][m][0], acc[ai][1][m][1]);
            if (m & 1) asm volatile("" ::: "memory"); }
    if constexpr (Epi::UNIT_END) {
        asm volatile("s_waitcnt lgkmcnt(0)" ::: "memory"); __builtin_amdgcn_s_barrier(); asm volatile("" ::: "memory");
        E.unit_end(u.pm, u.pn, tid);
    }
}
template <class Epi, class Sched>
__device__ __forceinline__ void gemm_phase(LAS unsigned char* lds, const int tid, const int K, const int LD  , const Sched& S, const Epi& E) {
    const int wid = __builtin_amdgcn_readfirstlane(tid >> 6), lane = tid & 63, wr = wid >> 2, wc = wid & 3, fr = lane & 15, fq = lane >> 4;
    const int nt = K / BK;
    unsigned voff[2];
#pragma unroll
    for (int i = 0; i < 2; ++i) { int R, C; stage_rc(tid * 16 + i * 8192, R, C); R = (R & ~31) + perm32(R & 31); voff[i] = (unsigned)(R * LD + C) * 2u; }
    const size_t kstep = (size_t)(BK * 2);
    const size_t hstep = (size_t)HALF * LD * 2;
    const unsigned ldsw = (unsigned)wid * 1024u;
    const int aoff = lds_byte(wr * 64 + fr, fq * 8), boff = lds_byte(wc * 32 + fr, fq * 8);
#define PG8_SA(b, h) (((b) * 2 + (h)) * HTB)
#define PG8_SB(b, h) ((4 + (b) * 2 + (h)) * HTB)
#define PG8_STAGE(bufoff, gbase) do { _Pragma("unroll") for (int _i = 0; _i < 2; ++_i) \
        __builtin_amdgcn_global_load_lds((const unsigned*)((const char*)(gbase) + voff[_i]), (LAS unsigned*)(lds + (bufoff) + ldsw + _i * 8192), 16, 0, 0); } while (0)
#define PG8_LDA(dst, b, h) do { _Pragma("unroll") for (int m = 0; m < 4; ++m) _Pragma("unroll") for (int k = 0; k < 2; ++k) dst[m][k] = *(const LAS bf16x8*)(lds + PG8_SA(b, h) + aoff + m * 2048 + k * 1024); } while (0)
#define PG8_LDB(dst, b, h) do { _Pragma("unroll") for (int n = 0; n < 2; ++n) _Pragma("unroll") for (int k = 0; k < 2; ++k) dst[n][k] = *(const LAS bf16x8*)(lds + PG8_SB(b, h) + boff + n * 2048 + k * 1024); } while (0)
#define PG8_MMA(ai, bj, At, Bt) do { __builtin_amdgcn_s_setprio(1); _Pragma("unroll") for (int m = 0; m < 4; ++m) _Pragma("unroll") for (int n = 0; n < 2; ++n) _Pragma("unroll") for (int k = 0; k < 2; ++k) \
        acc[ai][bj][m][n] = __builtin_amdgcn_mfma_f32_16x16x32_bf16(Bt[n][k], At[m][k], acc[ai][bj][m][n], 0, 0, 0); __builtin_amdgcn_s_setprio(0); } while (0)
#define PG8_WAIT_V(n) asm volatile("s_waitcnt vmcnt(" #n ")" ::: "memory")
#define PG8_WAIT_L(n) asm volatile("s_waitcnt lgkmcnt(" #n ")" ::: "memory")
#define PG8_BAR __builtin_amdgcn_s_barrier()
#define PG8_SCHED __builtin_amdgcn_sched_barrier(0)
    Unit cur, nxt; int ui = 0;
    if (!S.next(0, cur)) return;
    f32x4 acc[2][2][4][2];
#pragma unroll
    for (int a = 0; a < 2; ++a)
#pragma unroll
        for (int b = 0; b < 2; ++b)
#pragma unroll
            for (int m = 0; m < 4; ++m)
#pragma unroll
                for (int n = 0; n < 2; ++n) acc[a][b][m][n] = (f32x4){0.f, 0.f, 0.f, 0.f};
    bf16x8 At[4][2], B0[2][2], B1[2][2];
    const char* cA = S.a_base(cur); const char* cB = S.b_base(cur);
    PG8_STAGE(PG8_SB(0, 0), cB); PG8_STAGE(PG8_SB(0, 1), cB + hstep); PG8_STAGE(PG8_SA(0, 0), cA); PG8_STAGE(PG8_SA(0, 1), cA + hstep);
    if (wr == 1) PG8_BAR;
    PG8_WAIT_V(2); PG8_BAR;
    PG8_STAGE(PG8_SB(1, 0), cB + kstep); PG8_STAGE(PG8_SA(1, 0), cA + kstep); PG8_STAGE(PG8_SB(1, 1), cB + hstep + kstep);
    PG8_WAIT_V(6); PG8_BAR;
    for (;;) {
        const bool has_next = S.next(ui + 1, nxt);
        const char* nA = has_next ? S.a_base(nxt) : cA; const char* nB = has_next ? S.b_base(nxt) : cB;
        for (int t = 0; t < nt; t += 2) {
            const bool last = (t == nt - 2);
            const char* a1 = cA + (size_t)(t + 1) * kstep;
            const char* a2 = last ? nA : cA + (size_t)(t + 2) * kstep; const char* b2 = last ? nB : cB + (size_t)(t + 2) * kstep;
            const char* a3 = a2 + kstep; const char* b3 = b2 + kstep;
            PG8_LDB(B0, 0, 0); PG8_LDB(B1, 0, 1); PG8_SCHED; PG8_LDA(At, 0, 0); PG8_STAGE(PG8_SA(1, 1), a1 + hstep);
            PG8_WAIT_V(8); PG8_WAIT_L(0); PG8_BAR; PG8_MMA(0, 0, At, B0); PG8_MMA(0, 1, At, B1); PG8_BAR; PG8_SCHED;
            PG8_LDA(At, 0, 1); PG8_STAGE(PG8_SB(0, 0), b2); PG8_STAGE(PG8_SB(0, 1), b2 + hstep); PG8_STAGE(PG8_SA(0, 0), a2);
            PG8_WAIT_V(8); PG8_WAIT_L(0); PG8_BAR; PG8_MMA(1, 0, At, B0); PG8_MMA(1, 1, At, B1); PG8_BAR; PG8_SCHED;
            PG8_LDB(B0, 1, 0); PG8_LDB(B1, 1, 1); PG8_SCHED; PG8_LDA(At, 1, 0); PG8_STAGE(PG8_SA(0, 1), a2 + hstep);
            PG8_WAIT_V(8); PG8_WAIT_L(0); PG8_BAR; PG8_MMA(0, 0, At, B0); PG8_MMA(0, 1, At, B1); PG8_BAR; PG8_SCHED;
            PG8_LDA(At, 1, 1); PG8_STAGE(PG8_SB(1, 0), b3); PG8_STAGE(PG8_SB(1, 1), b3 + hstep); PG8_STAGE(PG8_SA(1, 0), a3);
            PG8_WAIT_V(8); PG8_WAIT_L(0); PG8_BAR; PG8_MMA(1, 0, At, B0); PG8_MMA(1, 1, At, B1); PG8_BAR; PG8_SCHED;
        }
        if (wr == 0) PG8_BAR;
        epi_apply(acc, cur, wr, wc, fr, fq, E, tid);
        if (!has_next) break;
#pragma unroll
        for (int a = 0; a < 2; ++a)
#pragma unroll
            for (int b = 0; b < 2; ++b)
#pragma unroll
                for (int m = 0; m < 4; ++m)
#pragma unroll
                    for (int n = 0; n < 2; ++n) acc[a][b][m][n] = (f32x4){0.f, 0.f, 0.f, 0.f};
        cur = nxt; cA = nA; cB = nB; ++ui;
        if (wr == 1) PG8_BAR;
    }
    PG8_WAIT_V(0);
    PG8_BAR;
#undef PG8_SA
#undef PG8_SB
#undef PG8_STAGE
#undef PG8_LDA
#undef PG8_LDB
#undef PG8_MMA
#undef PG8_WAIT_V
#undef PG8_WAIT_L
#undef PG8_BAR
#undef PG8_SCHED
}
template <class Epi, class Sched>
__device__ __forceinline__ void gemm_phase_gather(LAS unsigned char* lds, const int tid, const int K, const int LD, const Sched& S, const Epi& E) {
    const int wid = __builtin_amdgcn_readfirstlane(tid >> 6), lane = tid & 63, wr = wid >> 2, wc = wid & 3, fr = lane & 15, fq = lane >> 4;
    const int nt = K / BK;
    unsigned voff[2];
#pragma unroll
    for (int i = 0; i < 2; ++i) { int R, C; stage_rc(tid * 16 + i * 8192, R, C); R = (R & ~31) + perm32(R & 31); voff[i] = (unsigned)(R * LD + C) * 2u; }
    int rloc[4];
#pragma unroll
    for (int i = 0; i < 2; ++i) { int R, C; stage_rc(tid * 16 + i * 8192, R, C); R = (R & ~31) + perm32(R & 31); rloc[i] = R; rloc[2 + i] = HALF + R; }
    unsigned vc[2][2], vn[2][2];
    const char* Am = S.a_matrix();
#define PG8_OFFS(dst, u) do { int _row[4]; S.rows_of(u, rloc, _row); _Pragma("unroll") for (int _h = 0; _h < 2; ++_h) _Pragma("unroll") for (int _i = 0; _i < 2; ++_i) \
        dst[_h][_i] = (unsigned)_row[2 * _h + _i] * (unsigned)(LD * 2) + (voff[_i] - (unsigned)(rloc[_i] * LD * 2)); } while (0)
#define PG8_STAGE_A(bufoff, koff, v) do { _Pragma("unroll") for (int _i = 0; _i < 2; ++_i) \
        __builtin_amdgcn_global_load_lds((const unsigned*)(Am + (koff) + (v)[_i]), (LAS unsigned*)(lds + (bufoff) + ldsw + _i * 8192), 16, 0, 0); } while (0)
    const size_t kstep = (size_t)(BK * 2);
    const size_t hstep = (size_t)HALF * LD * 2;
    const unsigned ldsw = (unsigned)wid * 1024u;
    const int aoff = lds_byte(wr * 64 + fr, fq * 8), boff = lds_byte(wc * 32 + fr, fq * 8);
#define PG8_SA(b, h) (((b) * 2 + (h)) * HTB)
#define PG8_SB(b, h) ((4 + (b) * 2 + (h)) * HTB)
#define PG8_STAGE(bufoff, gbase) do { _Pragma("unroll") for (int _i = 0; _i < 2; ++_i) \
        __builtin_amdgcn_global_load_lds((const unsigned*)((const char*)(gbase) + voff[_i]), (LAS unsigned*)(lds + (bufoff) + ldsw + _i * 8192), 16, 0, 0); } while (0)
#define PG8_LDA(dst, b, h) do { _Pragma("unroll") for (int m = 0; m < 4; ++m) _Pragma("unroll") for (int k = 0; k < 2; ++k) dst[m][k] = *(const LAS bf16x8*)(lds + PG8_SA(b, h) + aoff + m * 2048 + k * 1024); } while (0)
#define PG8_LDB(dst, b, h) do { _Pragma("unroll") for (int n = 0; n < 2; ++n) _Pragma("unroll") for (int k = 0; k < 2; ++k) dst[n][k] = *(const LAS bf16x8*)(lds + PG8_SB(b, h) + boff + n * 2048 + k * 1024); } while (0)
#define PG8_MMA(ai, bj, At, Bt) do { __builtin_amdgcn_s_setprio(1); _Pragma("unroll") for (int m = 0; m < 4; ++m) _Pragma("unroll") for (int n = 0; n < 2; ++n) _Pragma("unroll") for (int k = 0; k < 2; ++k) \
        acc[ai][bj][m][n] = __builtin_amdgcn_mfma_f32_16x16x32_bf16(Bt[n][k], At[m][k], acc[ai][bj][m][n], 0, 0, 0); __builtin_amdgcn_s_setprio(0); } while (0)
#define PG8_WAIT_V(n) asm volatile("s_waitcnt vmcnt(" #n ")" ::: "memory")
#define PG8_WAIT_L(n) asm volatile("s_waitcnt lgkmcnt(" #n ")" ::: "memory")
#define PG8_BAR __builtin_amdgcn_s_barrier()
#define PG8_SCHED __builtin_amdgcn_sched_barrier(0)
    Unit cur, nxt; int ui = 0;
    if (!S.next(0, cur)) return;
    f32x4 acc[2][2][4][2];
#pragma unroll
    for (int a = 0; a < 2; ++a)
#pragma unroll
        for (int b = 0; b < 2; ++b)
#pragma unroll
            for (int m = 0; m < 4; ++m)
#pragma unroll
                for (int n = 0; n < 2; ++n) acc[a][b][m][n] = (f32x4){0.f, 0.f, 0.f, 0.f};
    bf16x8 At[4][2], B0[2][2], B1[2][2];
    const char* cB = S.b_base(cur);
    PG8_OFFS(vc, cur);
    PG8_STAGE(PG8_SB(0, 0), cB); PG8_STAGE(PG8_SB(0, 1), cB + hstep); PG8_STAGE_A(PG8_SA(0, 0), 0, vc[0]); PG8_STAGE_A(PG8_SA(0, 1), 0, vc[1]);
    if (wr == 1) PG8_BAR;
    PG8_WAIT_V(2); PG8_BAR;
    PG8_STAGE(PG8_SB(1, 0), cB + kstep); PG8_STAGE_A(PG8_SA(1, 0), kstep, vc[0]); PG8_STAGE(PG8_SB(1, 1), cB + hstep + kstep);
    PG8_WAIT_V(6); PG8_BAR;
    for (;;) {
        const bool has_next = S.next(ui + 1, nxt);
        const char* nB = has_next ? S.b_base(nxt) : cB;
        if (has_next && nxt.pm != cur.pm) PG8_OFFS(vn, nxt); else {
#pragma unroll
            for (int _h = 0; _h < 2; ++_h)
#pragma unroll
                for (int _i = 0; _i < 2; ++_i) vn[_h][_i] = vc[_h][_i]; }
        for (int t = 0; t < nt; t += 2) {
            const bool last = (t == nt - 2);
            const size_t k1 = (size_t)(t + 1) * kstep, k2 = last ? 0 : (size_t)(t + 2) * kstep, k3 = k2 + kstep;
            const char* b2 = last ? nB : cB + (size_t)(t + 2) * kstep; const char* b3 = b2 + kstep;
            unsigned w0[2], w1[2];
#pragma unroll
            for (int _i = 0; _i < 2; ++_i) { w0[_i] = last ? vn[0][_i] : vc[0][_i]; w1[_i] = last ? vn[1][_i] : vc[1][_i]; }
            PG8_LDB(B0, 0, 0); PG8_LDB(B1, 0, 1); PG8_SCHED; PG8_LDA(At, 0, 0); PG8_STAGE_A(PG8_SA(1, 1), k1, vc[1]);
            PG8_WAIT_V(8); PG8_WAIT_L(0); PG8_BAR; PG8_MMA(0, 0, At, B0); PG8_MMA(0, 1, At, B1); PG8_BAR; PG8_SCHED;
            PG8_LDA(At, 0, 1); PG8_STAGE(PG8_SB(0, 0), b2); PG8_STAGE(PG8_SB(0, 1), b2 + hstep); PG8_STAGE_A(PG8_SA(0, 0), k2, w0);
            PG8_WAIT_V(8); PG8_WAIT_L(0); PG8_BAR; PG8_MMA(1, 0, At, B0); PG8_MMA(1, 1, At, B1); PG8_BAR; PG8_SCHED;
            PG8_LDB(B0, 1, 0); PG8_LDB(B1, 1, 1); PG8_SCHED; PG8_LDA(At, 1, 0); PG8_STAGE_A(PG8_SA(0, 1), k2, w1);
            PG8_WAIT_V(8); PG8_WAIT_L(0); PG8_BAR; PG8_MMA(0, 0, At, B0); PG8_MMA(0, 1, At, B1); PG8_BAR; PG8_SCHED;
            PG8_LDA(At, 1, 1); PG8_STAGE(PG8_SB(1, 0), b3); PG8_STAGE(PG8_SB(1, 1), b3 + hstep); PG8_STAGE_A(PG8_SA(1, 0), k3, w0);
            PG8_WAIT_V(8); PG8_WAIT_L(0); PG8_BAR; PG8_MMA(1, 0, At, B0); PG8_MMA(1, 1, At, B1); PG8_BAR; PG8_SCHED;
        }
        if (wr == 0) PG8_BAR;
        epi_apply(acc, cur, wr, wc, fr, fq, E, tid);
        if (!has_next) break;
#pragma unroll
        for (int a = 0; a < 2; ++a)
#pragma unroll
            for (int b = 0; b < 2; ++b)
#pragma unroll
                for (int m = 0; m < 4; ++m)
#pragma unroll
                    for (int n = 0; n < 2; ++n) acc[a][b][m][n] = (f32x4){0.f, 0.f, 0.f, 0.f};
        cur = nxt; cB = nB; ++ui;
#pragma unroll
        for (int _h = 0; _h < 2; ++_h)
#pragma unroll
            for (int _i = 0; _i < 2; ++_i) vc[_h][_i] = vn[_h][_i];
        if (wr == 1) PG8_BAR;
    }
    PG8_WAIT_V(0);
    PG8_BAR;
#undef PG8_OFFS
#undef PG8_STAGE_A
#undef PG8_SA
#undef PG8_SB
#undef PG8_STAGE
#undef PG8_LDA
#undef PG8_LDB
#undef PG8_MMA
#undef PG8_WAIT_V
#undef PG8_WAIT_L
#undef PG8_BAR
#undef PG8_SCHED
}
}
struct EpiQKVT { bf16* QB; bf16* KH; bf16* VT8; const float* SSP; const float* bias  ;
    static constexpr bool UNIT_END = false; typedef RowColCtx Ctx;
    __device__ __forceinline__ Ctx unit_ctx(int pm, int pn, int wr, int wc, int fr, int fq) const { Ctx c;
        if (pm < 68) { const float* b = bias + row_bm(pm * 256) * 3072;
#pragma unroll
            for (int ri = 0; ri < 8; ++ri) c.r[ri] = rstd_of(SSP, UNIT_ROW(pm, wr, fr, ri));
#pragma unroll
            for (int bj = 0; bj < 2; ++bj)
#pragma unroll
                for (int n = 0; n < 2; ++n) c.x[bj][n] = *(const f32x4*)(b + UNIT_COL(pn, wc, fq, bj, n));
        } else { const float* b = bias + row_bm(pn * 256) * 3072 + 2048;
#pragma unroll
            for (int ri = 0; ri < 8; ++ri) c.r[ri] = b[UNIT_ROW(pm - 68, wr, fr, ri)];
#pragma unroll
            for (int bj = 0; bj < 2; ++bj)
#pragma unroll
                for (int n = 0; n < 2; ++n)
#pragma unroll
                    for (int i = 0; i < 4; ++i) c.x[bj][n][i] = rstd_of(SSP, UNIT_COL(pn, wc, fq, bj, n) + i);
        }
        return c; }
    __device__ __forceinline__ void st(int row, int col, f32x4 a, f32x4 b) const {
        if (col < 1024) st8bf(QB + (size_t)row * 1024 + col, a * QSCALE, b * QSCALE);
        else { const int cc = col - 1024; st8bf(KH + ((size_t)(cc >> 6) * MT + row) * 64 + (cc & 63), a, b); } }
    __device__ __forceinline__ void operator()(const Ctx& c, int row, int col, int ri, f32x4 v00, f32x4 v01, f32x4 v10, f32x4 v11) const {
        if (row < MT) { const float r = c.r[ri];
            st(row, col, v00 * r + c.x[0][0], v01 * r + c.x[0][1]); st(row, col + 128, v10 * r + c.x[1][0], v11 * r + c.x[1][1]);
        } else { const int ch = row - MT, h = ch >> 6, d = ch & 63; const float bb = c.r[ri];
            st8bf(VT8 + (((size_t)h * (MT / 8) + (col >> 3)) * 64 + d) * 8, v00 * c.x[0][0] + bb, v01 * c.x[0][1] + bb);
            st8bf(VT8 + (((size_t)h * (MT / 8) + ((col + 128) >> 3)) * 64 + d) * 8, v10 * c.x[1][0] + bb, v11 * c.x[1][1] + bb);
        } } };

__device__ __forceinline__ void mods_phase(const Frame& F) {
    LAS float* sl = (LAS float*)F.lds;
    LAS float* red = sl + 5 * 1024;
    const int tid = F.tid;
    for (int i = tid; i < 5 * 1024; i += 512) { const int b = i >> 10, k = i & 1023; const float v = b < 4 ? F.in(I_C)[b * 1024 + k] : F.in(I_CCTX)[k]; sl[i] = v / (1.f + expf(-v)); }
    __syncthreads();
    const int l16 = tid & 15, kg = tid >> 4;
    for (int it = F.blk; it < 4 * 96; it += F.G) {
        const int layer = it / 96, cc = it % 96;
        const float* W = F.in(I_WMOD) + (size_t)layer * 1024 * 6144 + cc * 64 + l16 * 4;
        f32x4 acc[5];
#pragma unroll
        for (int b = 0; b < 5; ++b) acc[b] = (f32x4){0.f, 0.f, 0.f, 0.f};
#pragma unroll 8
        for (int kk = 0; kk < 32; ++kk) { const int k = kg * 32 + kk; const f32x4 w = *(const f32x4*)(W + (size_t)k * 6144);
#pragma unroll
            for (int b = 0; b < 5; ++b) acc[b] += sl[b * 1024 + k] * w; }
#pragma unroll
        for (int b = 0; b < 5; ++b) *(LAS f32x4*)(red + ((kg * 5 + b) * 64 + l16 * 4)) = acc[b];
        __syncthreads();
        if (tid < 320) { const int b = tid >> 6, col = tid & 63; float s = 0.f;
            for (int g = 0; g < 32; ++g) s += red[(g * 5 + b) * 64 + col];
            F.mods()[((size_t)layer * 5 + b) * 6144 + cc * 64 + col] = s + F.in(I_BMOD)[layer * 6144 + cc * 64 + col]; }
        __syncthreads();
    }
}
__device__ __forceinline__ void rpb_phase(const Frame& F) {
    const int gt = F.blk * 512 + F.tid, ngt = F.G * 512;
    for (int i = gt; i < 2 * 16 * 15 * 64; i += ngt) { const int c = i & 63, r = (i >> 6) % 15, h = (i / (64 * 15)) & 15, jj = i / (64 * 15 * 16);
        const int dc = c - 32; float v = 0.f; if (dc >= -15 && dc <= 15) v = F.in(I_RPB)[((size_t)(jj * 16 + h) * 15 + r) * 31 + dc + 15] * LOG2E;
        F.rpbt()[i] = v; }
}
__device__ __forceinline__ void poolfold_phase(const Frame& F, int j) {
    const float* pw = F.in(I_POOLW) + (size_t)j * 4 * 128 * 128; const float* ps = F.in(I_POOLS) + (size_t)j * 512; const float* wo = F.in(I_WOUT) + (size_t)j * 1024 * 1024 + (size_t)512 * 1024;
    bf16* dst = F.wb(j) + WB_WOUT;
    const int gt = F.blk * 512 + F.tid, ngt = F.G * 512;
    for (int it = gt; it < 4 * 32 * 1024; it += ngt) {
        const int n = it & 1023, c4 = (it >> 10) & 31, g = it >> 15;
        const float* pr = pw + ((size_t)g * 128 + c4 * 4) * 128; const float* wr = wo + (size_t)g * 128 * 1024 + n; const float* sr = ps + g * 128;
        float acc[4] = {0.f, 0.f, 0.f, 0.f};
#pragma unroll 4
        for (int d = 0; d < 128; ++d) { const float w = wr[(size_t)d * 1024] * sr[d];
#pragma unroll
            for (int q = 0; q < 4; ++q) acc[q] += pr[q * 128 + d] * w; }
        u32x2 o; o.x = cvt_pk_bf16(acc[0], acc[1]); o.y = cvt_pk_bf16(acc[2], acc[3]);
        *(u32x2*)(dst + (size_t)n * 1024 + 512 + g * 128 + c4 * 4) = o;
    }
}
__device__ __forceinline__ void bias_phase(const Frame& F, int j) {
    const int lane = F.lane;
    for (int it = F.gw; it < 5632 + 3072; it += F.ngw) {
        const bool gu = it < 5632; const int n = gu ? it : it - 5632;
        const bf16* wrow = F.wb(j) + (gu ? WB_WGU : WB_WQKV) + (size_t)n * 1024;
        const float* sh = F.mods() + (size_t)(gu ? 2 * j : 2 * j + 1) * 5 * 6144 + (gu ? 3 * 1024 : 0);
        float w[16];
#pragma unroll
        for (int jj = 0; jj < 2; ++jj) { const bf16x8 v = *(const bf16x8*)(wrow + 8 * lane + 512 * jj);
#pragma unroll
            for (int e = 0; e < 8; ++e) w[8 * jj + e] = bf2f(v[e]); }
        float* out = F.bias() + (gu ? BIAS_GU + (size_t)j * 5 * 5632 : BIAS_QKV + (size_t)j * 5 * 3072);
#pragma unroll
        for (int bm = 0; bm < 5; ++bm) { float s = 0.f;
#pragma unroll
            for (int jj = 0; jj < 2; ++jj) { const f32x4 a = *(const f32x4*)(sh + bm * 6144 + 8 * lane + 512 * jj), b = *(const f32x4*)(sh + bm * 6144 + 8 * lane + 512 * jj + 4);
                s += (a[0] * w[8 * jj] + a[1] * w[8 * jj + 1]) + (a[2] * w[8 * jj + 2] + a[3] * w[8 * jj + 3]) + (b[0] * w[8 * jj + 4] + b[1] * w[8 * jj + 5]) + (b[2] * w[8 * jj + 6] + b[3] * w[8 * jj + 7]); }
            s = wave_sum(s);
            if (lane == 0) out[bm * (gu ? 5632 : 3072) + n] = s; }
    }
}
__device__ __forceinline__ void conv_tile(const float* src, int ldn, bf16* dst, int pitch, int k0, int n0, int mode, LAS unsigned* T, int lane) {
    const int c4 = (lane & 15) * 4;
#pragma unroll
    for (int it = 0; it < 8; ++it) { const int r = it * 4 + (lane >> 4);
        const f32x4 a = __builtin_nontemporal_load((const f32x4*)(src + (size_t)(k0 + 2 * r) * ldn + n0 + c4)), b = __builtin_nontemporal_load((const f32x4*)(src + (size_t)(k0 + 2 * r + 1) * ldn + n0 + c4));
#pragma unroll
        for (int c = 0; c < 4; ++c) T[(c4 + c) * 33 + r] = cvt_pk_bf16(a[c], b[c]); }
    asm volatile("s_waitcnt lgkmcnt(0)" ::: "memory");
#pragma unroll
    for (int it = 0; it < 8; ++it) { const int n = it * 8 + (lane >> 3), q = lane & 7; const int gn = n0 + n;
        const int drow = mode == 0 ? gn : ((gn >> 7) << 8) + (gn & 127) + (mode == 2 ? 128 : 0);
        u32x4 v; v.x = T[n * 33 + 4 * q]; v.y = T[n * 33 + 4 * q + 1]; v.z = T[n * 33 + 4 * q + 2]; v.w = T[n * 33 + 4 * q + 3];
        __builtin_nontemporal_store(v, (u32x4*)(dst + (size_t)drow * pitch + k0 + 8 * q)); }
    asm volatile("s_waitcnt lgkmcnt(0)" ::: "memory");
}
constexpr int CT0 = 512, CT1 = CT0 + 128, CT2 = CT1 + 704, CT3 = CT2 + 704, CT4 = CT3 + 704, CT5 = CT4 + 768, CT6 = CT5 + 256, CT7 = CT6 + 7168, CT8 = CT7 + 7168, CT9 = CT8 + 7168;
constexpr int CQ_P0M = CT9 - CT6, CQ_P1D = CQ_P0M + CT6, CQ_END = CQ_P1D + (CT9 - CT6);
static_assert(CQ_P0M % 8 == 0 && CQ_P1D % 8 == 0 && CQ_END % 8 == 0, "queue chunks");
__device__ __forceinline__ void conv_item(const Frame& F, int j, int it, LAS unsigned* T) {
    const float* src; int K, N, mode = 0, r; bf16* dst; size_t se = 0, de = 0; int tpe;
    if (it < CT0)      { r = it;       src = F.in(I_WIN) + (size_t)j * 1024 * 2048;  K = 1024; N = 2048; dst = F.wb(j) + WB_WIN; tpe = CT0; }
    else if (it < CT1) { r = it - CT0; src = F.in(I_WOUT) + (size_t)j * 1024 * 1024; K = 1024; N = 1024; dst = F.wb(j) + WB_WOUT; tpe = 128; }
    else if (it < CT2) { r = it - CT1; src = F.in(I_WFG) + (size_t)j * 1024 * DFF;   K = 1024; N = DFF; dst = F.wb(j) + WB_WGU; mode = 1; tpe = 704; }
    else if (it < CT3) { r = it - CT2; src = F.in(I_WFU) + (size_t)j * 1024 * DFF;   K = 1024; N = DFF; dst = F.wb(j) + WB_WGU; mode = 2; tpe = 704; }
    else if (it < CT4) { r = it - CT3; src = F.in(I_WFD) + (size_t)j * DFF * 1024;   K = DFF; N = 1024; dst = F.wb(j) + WB_WD; tpe = 704; }
    else if (it < CT5) { r = it - CT4; src = F.in(I_WQKV) + (size_t)j * 1024 * 3072; K = 1024; N = 3072; dst = F.wb(j) + WB_WQKV; tpe = 768; }
    else if (it < CT6) { r = it - CT5; src = F.in(I_WONA) + (size_t)j * 1024 * 1024; K = 1024; N = 1024; dst = F.wb(j) + WB_WO; tpe = 256; }
    else if (it < CT7) { r = it - CT6; src = F.in(I_WEG) + (size_t)j * NE * 1024 * DFE; K = 1024; N = DFE; dst = F.wb(j) + WB_WEGU; mode = 1; tpe = 896; se = (size_t)1024 * DFE; de = (size_t)7168 * 1024; }
    else if (it < CT8) { r = it - CT7; src = F.in(I_WEU) + (size_t)j * NE * 1024 * DFE; K = 1024; N = DFE; dst = F.wb(j) + WB_WEGU; mode = 2; tpe = 896; se = (size_t)1024 * DFE; de = (size_t)7168 * 1024; }
    else               { r = it - CT8; src = F.in(I_WED) + (size_t)j * NE * DFE * 1024; K = DFE; N = 1024; dst = F.wb(j) + WB_WED; tpe = 896; se = (size_t)DFE * 1024; de = (size_t)1024 * DFE; }
    const int e = r / tpe, rr = r % tpe, nb = N / 64, kb = rr / nb, nbi = rr % nb;
    conv_tile(src + e * se, N, dst + e * de, K, kb * 64, nbi * 64, mode, T, F.lane);
}
__device__ __forceinline__ void conv_dense0(const Frame& F) {
    LAS unsigned* T = (LAS unsigned*)(F.lds + F.wave * 8448);
    for (int it = F.gw; it < CT6; it += F.ngw) conv_item(F, 0, it, T);
}
__device__ __forceinline__ void conv_queue(const Frame& F, int limit, int max_chunks) {
    LAS unsigned* T = (LAS unsigned*)(F.lds + F.wave * 8448);
    volatile LAS int* qslot = (volatile LAS int*)(F.lds + 8 * 8448);
    unsigned* head = F.ctl() + CW_QHEAD;
    for (int n = 0; n < max_chunks; ++n) {
        __syncthreads();
        if (F.tid == 0) { int v = -1; if ((int)__hip_atomic_load(head, __ATOMIC_RELAXED, __HIP_MEMORY_SCOPE_AGENT) < limit) v = (int)__hip_atomic_fetch_add(head, 8u, __ATOMIC_RELAXED, __HIP_MEMORY_SCOPE_AGENT); *qslot = v; }
        __syncthreads();
        const int q0 = *qslot;
        if (q0 < 0 || q0 >= CQ_END) break;
        const int q = q0 + F.wave;
        if (q < CQ_P0M) conv_item(F, 0, CT6 + q, T); else if (q < CQ_P1D) conv_item(F, 1, q - CQ_P0M, T); else conv_item(F, 1, CT6 + (q - CQ_P1D), T);
    }
    __syncthreads();
}
__device__ __forceinline__ bool tail_idle(int nwg, int G, int c) { const int mine = c < nwg ? (nwg - c + G - 1) / G : 0; return mine < (nwg + G - 1) / G; }

__device__ __forceinline__ f32x4 bf4_to_f32(u32x2 u) { return (f32x4){__uint_as_float(u.x << 16), __uint_as_float(u.x & 0xffff0000u), __uint_as_float(u.y << 16), __uint_as_float(u.y & 0xffff0000u)}; }
__device__ __forceinline__ f32x4 moe_row4(const Frame& F, int rr, int c) {
    return bf4_to_f32(*(const u32x2*)(F.YPAIR() + (size_t)rr * D + c)) + bf4_to_f32(*(const u32x2*)(F.YPB() + (size_t)rr * D + c));
}
template <bool FIRST, bool COMBINE, bool ROUTER, bool FINAL>
__device__ __forceinline__ void norm_phase(const Frame& F, int Mrows, const float* g, const float* modbase  , int shift_idx, const float* prev_gate  ,
                                           const float* wr  , unsigned* cnt  ) {
    const int lane = F.lane;
    int2* tok_e = (int2*)F.tok(); int2* tok_pos = tok_e + MT; float2* tok_w = (float2*)(tok_pos + MT); int* rowsrc = (int*)(F.ws() + WS_TOK + 2 * MiB);
    constexpr int NR = 2;
    LAS int* lcnt = (LAS int*)F.lds; LAS int* lbase = lcnt + 8; LAS int* rec = lcnt + 16 + F.wave * 64;
    int nrec = 0;
    if (ROUTER) { if (F.tid < 8) lcnt[F.tid] = 0; __syncthreads(); }
    MoeTiles mtc; if (COMBINE) mtc.init(cnt);
    for (int row0 = F.gw * NR; row0 < Mrows; row0 += F.ngw * NR) {
        f32x4 v[NR][4];
#pragma unroll
        for (int q = 0; q < NR; ++q) { const int row = row0 + q;
            const float* src = FIRST ? (row < ML ? F.in(I_X) + (size_t)row * D : F.in(I_CTX) + (size_t)(row - ML) * D) : F.H() + (size_t)row * D;
#pragma unroll
            for (int jj = 0; jj < 4; ++jj) v[q][jj] = *(const f32x4*)(src + 4 * lane + 256 * jj); }
        if (COMBINE) {
#pragma unroll
            for (int q = 0; q < NR; ++q) { const int row = row0 + q; const int bm = row_bm(row);
                const int2 ee = tok_e[row], pp = tok_pos[row]; const int2 rr = make_int2(mtc.row_offset(ee.x) + pp.x, mtc.row_offset(ee.y) + pp.y); const float2 ww = tok_w[row];
                const float* pg = prev_gate + bm * 6144;
#pragma unroll
                for (int jj = 0; jj < 4; ++jj) { const int c = 4 * lane + 256 * jj; const f32x4 gg = *(const f32x4*)(pg + c);
                    const f32x4 a = moe_row4(F, rr.x, c), b = moe_row4(F, rr.y, c);
                    v[q][jj] += gg * (ww.x * a + ww.y * b); } }
        }
#pragma unroll
        for (int q = 0; q < NR; ++q) {
            const int row = row0 + q; const int bm = row_bm(row);
            if ((FIRST || COMBINE) && !FINAL) {
#pragma unroll
                for (int jj = 0; jj < 4; ++jj) *(f32x4*)(F.H() + (size_t)row * D + 4 * lane + 256 * jj) = v[q][jj];
            }
            float ss = 0.f;
#pragma unroll
            for (int jj = 0; jj < 4; ++jj) ss += (v[q][jj][0] * v[q][jj][0] + v[q][jj][1] * v[q][jj][1]) + (v[q][jj][2] * v[q][jj][2] + v[q][jj][3] * v[q][jj][3]);
            ss = wave_sum(ss);
            const float rstd = 1.0f / sqrtf(ss * (1.0f / D) + EPS);
            if (FINAL) {
#pragma unroll
                for (int jj = 0; jj < 4; ++jj) { const int c = 4 * lane + 256 * jj; *(f32x4*)(F.out() + (size_t)row * D + c) = v[q][jj] * rstd * *(const f32x4*)(g + c); }
                continue;
            }
            const float* sh = modbase + bm * 6144 + shift_idx * 1024; const float* sc = sh + 1024;
            float lg[NE];
#pragma unroll
            for (int e = 0; e < NE; ++e) lg[e] = 0.f;
#pragma unroll
            for (int jj = 0; jj < 4; ++jj) { const int c = 4 * lane + 256 * jj;
                const f32x4 y = v[q][jj] * rstd * *(const f32x4*)(g + c);
                const f32x4 a = y * (1.0f + *(const f32x4*)(sc + c)) + *(const f32x4*)(sh + c);
                u32x2 w; w.x = cvt_pk_bf16(a[0], a[1]); w.y = cvt_pk_bf16(a[2], a[3]);
                *(u32x2*)(F.AF() + (size_t)row * D + c) = w;
                if (ROUTER) {
#pragma unroll
                    for (int i = 0; i < 4; ++i) { const f32x4 w0 = *(const f32x4*)(wr + (size_t)(c + i) * 8), w1 = *(const f32x4*)(wr + (size_t)(c + i) * 8 + 4);
                        lg[0] += a[i] * w0[0]; lg[1] += a[i] * w0[1]; lg[2] += a[i] * w0[2]; lg[3] += a[i] * w0[3]; lg[4] += a[i] * w1[0]; lg[5] += a[i] * w1[1]; lg[6] += a[i] * w1[2]; lg[7] += a[i] * w1[3]; }
                }
            }
            if (ROUTER) {
#pragma unroll
                for (int e = 0; e < NE; ++e) lg[e] = wave_sum(lg[e]);
                int e0 = 0; float v0 = lg[0];
#pragma unroll
                for (int e = 1; e < NE; ++e) if (lg[e] > v0) { v0 = lg[e]; e0 = e; }
                int e1 = -1; float v1 = -3.0e38f;
#pragma unroll
                for (int e = 0; e < NE; ++e) if (e != e0 && lg[e] > v1) { v1 = lg[e]; e1 = e; }
                const float t = __expf(v1 - v0), w0 = 1.0f / (1.0f + t), w1 = t / (1.0f + t);
                if (lane == 0) {
                    const int p0 = __hip_atomic_fetch_add(lcnt + e0, 1, __ATOMIC_RELAXED, __HIP_MEMORY_SCOPE_WORKGROUP);
                    const int p1 = __hip_atomic_fetch_add(lcnt + e1, 1, __ATOMIC_RELAXED, __HIP_MEMORY_SCOPE_WORKGROUP);
                    rec[nrec * 4 + 0] = e0; rec[nrec * 4 + 1] = e1; rec[nrec * 4 + 2] = p0; rec[nrec * 4 + 3] = p1;
                    tok_e[row] = make_int2(e0, e1); tok_w[row] = make_float2(w0, w1);
                }
                ++nrec;
            }
        }
    }
    if (ROUTER) {
        __syncthreads();
        if (F.tid < 8) lbase[F.tid] = (int)__hip_atomic_fetch_add(cnt + F.tid, (unsigned)lcnt[F.tid], __ATOMIC_RELAXED, __HIP_MEMORY_SCOPE_AGENT);
        __syncthreads();
        if (lane < nrec) {
            const int row = F.gw * NR + (lane / NR) * F.ngw * NR + (lane % NR);
            const int e0 = rec[lane * 4 + 0], e1 = rec[lane * 4 + 1], p0 = lbase[e0] + rec[lane * 4 + 2], p1 = lbase[e1] + rec[lane * 4 + 3];
            tok_pos[row] = make_int2(p0, p1); rowsrc[(size_t)e0 * MT + p0] = row; rowsrc[(size_t)e1 * MT + p1] = row;
        }
    }
}

template <int WIN>
__device__ __forceinline__ void pool_rows8(const bf16* U, bf16* Y1, int r0, int t0, int L, int c0) {
    constexpr int A = WIN / 2, NRW = 8 + WIN - 1;
    bf16x8 raw[NRW];
#pragma unroll
    for (int k = 0; k < NRW; ++k) { const int tt = t0 - A + k; raw[k] = (bf16x8){0, 0, 0, 0, 0, 0, 0, 0};
        if (tt >= 0 && tt < L) raw[k] = *(const bf16x8*)(U + (size_t)(r0 - A + k) * 2048 + 1536 + c0); }
#pragma unroll
    for (int i = 0; i < 8; ++i) {
        float s[8];
#pragma unroll
        for (int e = 0; e < 8; ++e) s[e] = 0.f;
#pragma unroll
        for (int k = 0; k < WIN; ++k)
#pragma unroll
            for (int e = 0; e < 8; ++e) s[e] += bf2f(raw[i + k][e]);
        const int t = t0 + i, lo = max(t - A, 0), hi = min(t + (WIN - 1 - A), L - 1); const float inv = 1.0f / (float)(hi - lo + 1);
        float d[8];
#pragma unroll
        for (int e = 0; e < 8; ++e) d[e] = s[e] * inv - bf2f(raw[i + A][e]);
        u32x4 w; w.x = cvt_pk_bf16(d[0], d[1]); w.y = cvt_pk_bf16(d[2], d[3]); w.z = cvt_pk_bf16(d[4], d[5]); w.w = cvt_pk_bf16(d[6], d[7]);
        *(u32x4*)(Y1 + (size_t)(r0 + i) * D + 512 + c0) = w;
    }
}
__device__ __forceinline__ void conv_rows8(const bf16* U, bf16* Y1, const float* cw, int r0, int t0, int L, int c0) {
    bf16x8 gc[10], vl[10], gb[8];
#pragma unroll
    for (int k = 0; k < 10; ++k) { const int tt = t0 - 1 + k; gc[k] = (bf16x8){0, 0, 0, 0, 0, 0, 0, 0}; vl[k] = gc[k];
        if (tt >= 0 && tt < L) { const bf16* ur = U + (size_t)(r0 - 1 + k) * 2048; gc[k] = *(const bf16x8*)(ur + 512 + c0); vl[k] = *(const bf16x8*)(ur + 1024 + c0); } }
#pragma unroll
    for (int i = 0; i < 8; ++i) gb[i] = *(const bf16x8*)(U + (size_t)(r0 + i) * 2048 + c0);
    f32x4 w[3][2];
#pragma unroll
    for (int k = 0; k < 3; ++k) { w[k][0] = *(const f32x4*)(cw + k * 512 + c0); w[k][1] = *(const f32x4*)(cw + k * 512 + c0 + 4); }
#pragma unroll
    for (int i = 0; i < 8; ++i) {
        float o[8];
#pragma unroll
        for (int e = 0; e < 8; ++e) o[e] = 0.f;
#pragma unroll
        for (int k = 0; k < 3; ++k)
#pragma unroll
            for (int e = 0; e < 8; ++e) o[e] += (bf2f(gc[i + k][e]) * bf2f(vl[i + k][e])) * w[k][e >> 2][e & 3];
        u32x4 y; y.x = cvt_pk_bf16(bf2f(gb[i][0]) * o[0], bf2f(gb[i][1]) * o[1]); y.y = cvt_pk_bf16(bf2f(gb[i][2]) * o[2], bf2f(gb[i][3]) * o[3]);
        y.z = cvt_pk_bf16(bf2f(gb[i][4]) * o[4], bf2f(gb[i][5]) * o[5]); y.w = cvt_pk_bf16(bf2f(gb[i][6]) * o[6], bf2f(gb[i][7]) * o[7]);
        *(u32x4*)(Y1 + (size_t)(r0 + i) * D + c0) = y;
    }
}
__device__ __forceinline__ void mix_phase(const Frame& F, int j) {
    const bf16* U = F.BIG(); bf16* Y1 = F.Y1(); const float* cw = F.in(I_CONVW) + (size_t)j * 3 * 512;
    const int sub = F.lane >> 4, c16 = F.lane & 15;
    for (int wi = F.gw; wi < 8 * (MT / 32); wi += F.ngw) {
        const int cg = wi & 7, r0 = (wi >> 3) * 32 + sub * 8;
        int t0, L; if (r0 < ML) { t0 = r0 & 4095; L = SEQ; } else { t0 = (r0 - ML) & 255; L = CTXL; }
        const int c0 = ((cg & 3) * 16 + c16) * 8;
        if (cg < 4) conv_rows8(U, Y1, cw, r0, t0, L, c0);
        else if (cg == 4) pool_rows8<2>(U, Y1, r0, t0, L, c0);
        else if (cg == 5) pool_rows8<4>(U, Y1, r0, t0, L, c0);
        else if (cg == 6) pool_rows8<8>(U, Y1, r0, t0, L, c0);
        else pool_rows8<16>(U, Y1, r0, t0, L, c0);
    }
}

struct AttnState { f32x4 O[4]; float m, l; };
struct KVFrag { bf16x8 kf[2][2], vf[4]; };
__device__ __forceinline__ void attn_load(KVFrag& f, const bf16* kp  , const bf16* vp  ) {
#pragma unroll
    for (int t = 0; t < 2; ++t)
#pragma unroll
        for (int ks = 0; ks < 2; ++ks) f.kf[t][ks] = *(const bf16x8*)(kp + t * 4 * 64 + 32 * ks);
#pragma unroll
    for (int dt = 0; dt < 4; ++dt) f.vf[dt] = *(const bf16x8*)(vp + dt * 16 * 8);
}
template <bool LOCAL>
__device__ __forceinline__ void attn_compute(AttnState& st, const KVFrag& f, const bf16x8 (&qf)[2], const LAS float* brow, const float (&maskadd)[8]) {
    f32x4 S0 = (f32x4){0.f, 0.f, 0.f, 0.f}, S1 = (f32x4){0.f, 0.f, 0.f, 0.f};
    S0 = __builtin_amdgcn_mfma_f32_16x16x32_bf16(f.kf[0][0], qf[0], S0, 0, 0, 0); S0 = __builtin_amdgcn_mfma_f32_16x16x32_bf16(f.kf[0][1], qf[1], S0, 0, 0, 0);
    S1 = __builtin_amdgcn_mfma_f32_16x16x32_bf16(f.kf[1][0], qf[0], S1, 0, 0, 0); S1 = __builtin_amdgcn_mfma_f32_16x16x32_bf16(f.kf[1][1], qf[1], S1, 0, 0, 0);
    float s[8];
#pragma unroll
    for (int i = 0; i < 4; ++i) { s[i] = S0[i]; s[4 + i] = S1[i]; }
    if (LOCAL) {
#pragma unroll
        for (int i = 0; i < 8; ++i) s[i] += brow[i] + maskadd[i];
    }
    float mx = fmaxf(fmaxf(fmaxf(s[0], s[1]), fmaxf(s[2], s[3])), fmaxf(fmaxf(s[4], s[5]), fmaxf(s[6], s[7])));
    mx = fmaxf(mx, __shfl_xor(mx, 16)); mx = fmaxf(mx, __shfl_xor(mx, 32));
    const float mnew = fmaxf(st.m, mx), alpha = __builtin_amdgcn_exp2f(st.m - mnew);
    st.m = mnew;
    float p[8], ps = 0.f;
#pragma unroll
    for (int i = 0; i < 8; ++i) { p[i] = __builtin_amdgcn_exp2f(s[i] - mnew); ps += p[i]; }
    st.l = st.l * alpha + ps;
    u32x4 pw; pw.x = cvt_pk_bf16(p[0], p[1]); pw.y = cvt_pk_bf16(p[2], p[3]); pw.z = cvt_pk_bf16(p[4], p[5]); pw.w = cvt_pk_bf16(p[6], p[7]);
    const bf16x8 pb = __builtin_bit_cast(bf16x8, pw);
#pragma unroll
    for (int dt = 0; dt < 4; ++dt) { st.O[dt] = st.O[dt] * alpha; st.O[dt] = __builtin_amdgcn_mfma_f32_16x16x32_bf16(f.vf[dt], pb, st.O[dt], 0, 0, 0); }
}
__device__ __forceinline__ void attn_finish(AttnState& st, bf16* orow  ) {
    float l = st.l; l += __shfl_xor(l, 16); l += __shfl_xor(l, 32);
    const float inv = 1.0f / l;
#pragma unroll
    for (int dt = 0; dt < 4; ++dt) { const f32x4 o = st.O[dt] * inv; u32x2 w; w.x = cvt_pk_bf16(o[0], o[1]); w.y = cvt_pk_bf16(o[2], o[3]); *(u32x2*)(orow + 16 * dt) = w; }
}
constexpr int ATT_KC_OFF = 4096, ATT_VC_OFF = 4096 + 32768;
__device__ __forceinline__ void attn_load_lds(KVFrag& f, const LAS unsigned char* kq  , const LAS unsigned char* vq  ) {
#pragma unroll
    for (int t = 0; t < 2; ++t)
#pragma unroll
        for (int ks = 0; ks < 2; ++ks) f.kf[t][ks] = *(const LAS bf16x8*)(kq + (t * 2 + ks) * 1024);
#pragma unroll
    for (int dt = 0; dt < 4; ++dt) f.vf[dt] = *(const LAS bf16x8*)(vq + dt * 256);
}
template <int NL, bool LDSCTX>
__device__ __forceinline__ void attn_unit(const bf16* kl, const bf16* vl, const bf16* kc, const bf16* vc, const LAS unsigned char* kq, const LAS unsigned char* vq, const bf16x8 (&qf)[2],
                                          const LAS float* brow0  , const float (&maskadd)[8], bf16* orow) {
    constexpr int NC = NL + 8;
    AttnState st;
#pragma unroll
    for (int dt = 0; dt < 4; ++dt) st.O[dt] = (f32x4){0.f, 0.f, 0.f, 0.f};
    st.m = -1.0e30f; st.l = 0.f;
    KVFrag fr[3];
#define ATT_KP(c) ((c) < NL ? kl + (c) * 64 * 64 : kc + ((c) - NL) * 32 * 64)
#define ATT_VP(c) ((c) < NL ? vl + (c) * 8 * 512 : vc + ((c) - NL) * 4 * 512)
#define ATT_LOAD(set, c) do { if (LDSCTX && (c) >= NL) attn_load_lds(fr[set], kq + ((c) - NL) * 4096, vq + ((c) - NL) * 4096); else attn_load(fr[set], ATT_KP(c), ATT_VP(c)); } while (0)
    ATT_LOAD(0, 0); ATT_LOAD(1, 1);
#pragma unroll
    for (int c = 0; c < NC; ++c) {
        if (c + 2 < NC) ATT_LOAD((c + 2) % 3, c + 2);
        __builtin_amdgcn_sched_barrier(0);
        if (c < NL) attn_compute<true>(st, fr[c % 3], qf, brow0 + c * 64, maskadd); else attn_compute<false>(st, fr[c % 3], qf, brow0, maskadd);
        __builtin_amdgcn_sched_barrier(0);
    }
#undef ATT_LOAD
#undef ATT_KP
#undef ATT_VP
    attn_finish(st, orow);
}
__device__ __forceinline__ void attn_fast(const Frame& F, const float* rpbt, bool do_ctx) {
    const bf16* QB = F.BIG(); const bf16* KH = F.BIG() + (size_t)MT * 1024; const bf16* VT8 = F.VT(); bf16* AO = F.Y1();
    LAS float* tbl = (LAS float*)F.lds;
    const int lane = F.lane, fr = lane & 15, fq = lane >> 4, wave = F.wave;
    const int krow = 8 * (fr >> 2) + (fr & 3);
    const int per = (2048 + F.G - 1) / F.G;
    int cur_bh = -1;
    const LAS unsigned char* kq = F.lds + ATT_KC_OFF + (((16 * lane) ^ ((((16 * lane) >> 9) & 1) << 5)) & 1023) * 0 + (((fr * 64 + fq * 16) ^ ((((fr * 64 + fq * 16) >> 9) & 1) << 5)));
    const LAS unsigned char* vq = F.lds + ATT_VC_OFF + fq * 1024 + fr * 16;
    const int vb = (F.G % 8 == 0) ? (F.blk % 8) * (F.G / 8) + F.blk / 8 : F.blk;
    const int bu_end = min((vb + 1) * per, 2048);
    for (int bu = vb * per; bu < bu_end; ++bu) {
        const int bh = bu >> 5, rp = bu & 31, b = bh >> 4, h = bh & 15;
        if (bh != cur_bh) {
            __syncthreads();
            for (int i = F.tid; i < 15 * 64; i += 512) tbl[i] = rpbt[h * 15 * 64 + i];
            const int tcs = ML + b * 256;
#pragma unroll
            for (int s = 0; s < 4; ++s) { const int st = wave * 4 + s, tile = st >> 1, ks = st & 1;
                const int sb = 16 * lane, swz = sb ^ (((sb >> 9) & 1) << 5), rr = swz >> 6, cc = (swz & 63) >> 1, key = 16 * (tile >> 1) * 2 + 4 * (tile & 1) + 8 * (rr >> 2) + (rr & 3);
                __builtin_amdgcn_global_load_lds((const unsigned*)(KH + ((size_t)h * MT + tcs + key) * 64 + 32 * ks + cc), (LAS unsigned*)(F.lds + ATT_KC_OFF + st * 1024), 16, 0, 0);
                __builtin_amdgcn_global_load_lds((const unsigned*)(VT8 + ((size_t)h * (MT / 8) + (tcs >> 3) + st) * 512 + 8 * lane), (LAS unsigned*)(F.lds + ATT_VC_OFF + st * 1024), 16, 0, 0); }
            asm volatile("s_waitcnt vmcnt(0)" ::: "memory");
            cur_bh = bh; __syncthreads(); }
        const int r = 2 * rp + (wave >> 2), jb = wave & 3;
        const int w0 = jb == 0 ? 0 : (jb == 1 ? 8 : (jb == 2 ? 24 : 32));
        const int jq = 16 * jb + fr, cs = min(max(jq - 8, 0), 48), rs = min(max(r - 4, 0), 56);
        const int qrow = b * 4096 + r * 64 + jq;
        bf16x8 qf[2];
#pragma unroll
        for (int ks = 0; ks < 2; ++ks) qf[ks] = *(const bf16x8*)(QB + (size_t)qrow * 1024 + h * 64 + 32 * ks + 8 * fq);
        float maskadd[8];
#pragma unroll
        for (int i = 0; i < 8; ++i) { const int col = w0 + 8 * fq + i; maskadd[i] = (col >= cs && col < cs + 16) ? 0.f : -1.0e30f; }
        const int boff = w0 + 8 * fq - jq + 32;
        const int tl = b * 4096 + rs * 64 + w0, tc = ML + b * 256;
        const bf16* kl = KH + ((size_t)h * MT + tl + krow) * 64 + 8 * fq;
        const bf16* vl = VT8 + (((size_t)h * (MT / 8) + (tl >> 3) + fq) * 64 + fr) * 8;
        const bf16* kc = KH + ((size_t)h * MT + tc + krow) * 64 + 8 * fq;
        const bf16* vc = VT8 + (((size_t)h * (MT / 8) + (tc >> 3) + fq) * 64 + fr) * 8;
        attn_unit<8, true>(kl, vl, kc, vc, kq, vq, qf, tbl + (rs - r + 7) * 64 + boff, maskadd, AO + (size_t)qrow * D + h * 64 + 4 * fq);
    }
    if (do_ctx) {
        for (int wu = F.gw; wu < 1024; wu += F.ngw) {
            const int bh = wu >> 4, qb = wu & 15, b = bh >> 4, h = bh & 15;
            const int qrow = ML + b * 256 + 16 * qb + fr;
            bf16x8 qf[2];
#pragma unroll
            for (int ks = 0; ks < 2; ++ks) qf[ks] = *(const bf16x8*)(QB + (size_t)qrow * 1024 + h * 64 + 32 * ks + 8 * fq);
            float maskadd[8];
#pragma unroll
            for (int i = 0; i < 8; ++i) maskadd[i] = 0.f;
            const int tc = ML + b * 256;
            const bf16* kc = KH + ((size_t)h * MT + tc + krow) * 64 + 8 * fq;
            const bf16* vc = VT8 + (((size_t)h * (MT / 8) + (tc >> 3) + fq) * 64 + fr) * 8;
            attn_unit<0, false>(kc, vc, kc, vc, kq, vq, qf, tbl, maskadd, AO + (size_t)qrow * D + h * 64 + 4 * fq);
        }
    }
}

__global__ void __launch_bounds__(512, 2) fwd_kernel(Args args) {
    extern __shared__ __attribute__((aligned(16))) unsigned char lds_raw[];
    Frame F;
    F.lds = (LAS unsigned char*)lds_raw;
    volatile LAS unsigned* MISC = (volatile LAS unsigned*)(F.lds + MISC_OFF);
    if (threadIdx.x < 32) { unsigned v = 0u; const unsigned long long ka = (unsigned long long)__builtin_amdgcn_kernarg_segment_ptr();
        if (threadIdx.x == 16) v = (unsigned)ka; if (threadIdx.x == 17) v = (unsigned)(ka >> 32); MISC[threadIdx.x] = v; }
    __syncthreads();
    F.renew();
    XcdBarrier bar = xcd_barrier_post(F.ctl() + CW_BAR, MISC + 8);
#define GRID_BAR() do { XcdBarrier b_ = bar; asm volatile("" : "+s"(b_.x)); xcd_barrier(b_); F.renew(); } while (0)
#define MODS(layer) (F.mods() + (size_t)(layer) * 5 * 6144)
#define CNT(jj) (F.ctl() + CW_CNT + 64 * (jj))
#define TAIL_CONV(nwg, q) do { if (tail_idle((nwg), F.G, F.blk)) conv_queue(F, CQ_END, (q)); } while (0)

    mods_phase(F); rpb_phase(F); poolfold_phase(F, 0); conv_dense0(F);
    GRID_BAR();

    for (int j = 0; j < 2; ++j) {
        const int le = 2 * j, lo = 2 * j + 1;
        const bool last = (j == 1);
        if (j == 0) norm_phase<true, false, false, false>(F, MT, F.in(I_GMIX) + le * D, MODS(le), 0, nullptr, nullptr, nullptr);
        else { norm_phase<false, true, false, false>(F, MT, F.in(I_GMIX) + le * D, MODS(le), 0, MODS(le - 1) + 5 * 1024, nullptr, CNT(j - 1));
               __syncthreads(); poolfold_phase(F, 1); conv_queue(F, CQ_P1D, 1 << 20); }
        GRID_BAR();
        { pg8::SchedStatic S; S.init(F.AF(), F.wb(j) + WB_WIN, MT, 2048, 1024, F.G, F.blk); EpiStoreBf16 E{F.BIG(), 2048}; pg8::gemm_phase(F.lds, F.tid, 1024, 1024, S, E); }
        TAIL_CONV(68 * 8, 3);
        GRID_BAR();
        mix_phase(F, j); bias_phase(F, j);
        GRID_BAR();
        { pg8::SchedStatic S; S.init(F.Y1(), F.wb(j) + WB_WOUT, MT, 1024, 1024, F.G, F.blk); EpiResGateNorm E{F.H(), MODS(le) + 2 * 1024, F.in(I_GFFN) + le * D, MODS(le) + 4 * 1024, F.AF(), F.ssp(2 * j), (LAS float*)(F.lds + PART_OFF)}; pg8::gemm_phase(F.lds, F.tid, 1024, 1024, S, E); }
        TAIL_CONV(68 * 4, 3);
        GRID_BAR();
        { pg8::SchedStatic S; S.init(F.AF(), F.wb(j) + WB_WGU, MT, 2 * DFF, 1024, F.G, F.blk); EpiSwiGLUNorm E{F.BIG(), DFF, F.ssp(2 * j), F.bias() + BIAS_GU + (size_t)j * 5 * 5632}; pg8::gemm_phase(F.lds, F.tid, 1024, 1024, S, E); }
        GRID_BAR();
        { pg8::SchedStatic S; S.init(F.BIG(), F.wb(j) + WB_WD, MT, 1024, DFF, F.G, F.blk); EpiResGateNorm E{F.H(), MODS(le) + 5 * 1024, F.in(I_GMIX) + lo * D, MODS(lo) + 1 * 1024, F.AF(), F.ssp(2 * j + 1), (LAS float*)(F.lds + PART_OFF)}; pg8::gemm_phase(F.lds, F.tid, DFF, DFF, S, E); }
        TAIL_CONV(68 * 4, 9);
        GRID_BAR();
        const int Mo = last ? ML : MT;
        { pg8::SchedQKVT S; S.AF = (const char*)F.AF(); S.WQK = (const char*)(F.wb(j) + WB_WQKV); S.WV = (const char*)(F.wb(j) + WB_WQKV + (size_t)2048 * 1024); S.G = F.G; S.c = F.blk; S.tstep = (size_t)256 * 1024 * 2;
          EpiQKVT E{F.BIG(), F.BIG() + (size_t)MT * 1024, F.VT(), F.ssp(2 * j + 1), F.bias() + BIAS_QKV + (size_t)j * 5 * 3072}; pg8::gemm_phase(F.lds, F.tid, 1024, 1024, S, E); }
        TAIL_CONV(pg8::SchedQKVT::NQK + pg8::SchedQKVT::NVT, 3);
        GRID_BAR();
        attn_fast(F, F.rpbt() + (size_t)j * 16 * 15 * 64, !last);
        GRID_BAR();
        { pg8::SchedStatic S; S.init(F.Y1(), F.wb(j) + WB_WO, Mo, 1024, 1024, F.G, F.blk); EpiResGate E{F.H(), MODS(lo) + 2 * 1024}; pg8::gemm_phase(F.lds, F.tid, 1024, 1024, S, E); }
        TAIL_CONV((Mo / 256) * 4, 3);
        GRID_BAR();
        norm_phase<false, false, true, false>(F, Mo, F.in(I_GFFN) + lo * D, MODS(lo), 3, nullptr, F.in(I_WR) + (size_t)j * 1024 * 8, CNT(j));
        conv_queue(F, j == 0 ? CQ_P0M : CQ_END, 1 << 20);
        GRID_BAR();
        { pg8::SchedMoe S; S.init(F.AF(), F.wb(j) + WB_WEGU, (size_t)7168 * 1024, CNT(j), (const int*)(F.ws() + WS_TOK + 2 * MiB), 2 * DFE, 1024, F.G, F.blk); EpiSwiGLU E{F.BIG(), DFE}; pg8::gemm_phase_gather(F.lds, F.tid, 1024, 1024, S, E); }
        GRID_BAR();
        { pg8::SchedDownK2 S; S.init(F.BIG(), F.wb(j) + WB_WED, CNT(j), F.G, F.blk); EpiDownK2 E{F.YPAIR(), F.YPB()}; pg8::gemm_phase(F.lds, F.tid, pg8::DOWN_KH, DFE, S, E);
          TAIL_CONV(S.nwg, 6); }
        GRID_BAR();
    }
    norm_phase<false, true, false, true>(F, ML, F.in(I_GFINAL), nullptr, 0, MODS(3) + 5 * 1024, nullptr, CNT(1));
}

extern "C" void kernel_launch(void* const* d_in, const int* in_sizes, int n_in, void* d_out, int out_size, void* d_ws, size_t ws_size, hipStream_t stream) {
    static int grid = 0;
    if (grid == 0) {
        if (n_in != 24 || out_size != ML * D || ws_size < WS_END) { fprintf(stderr, "kernel_launch: unexpected shapes (n_in %d out %d ws %zu)\n", n_in, out_size, ws_size); grid = -1; return; }
        int dev = 0, cus = 0, per_cu = 0;
        if (hipGetDevice(&dev) != hipSuccess || hipDeviceGetAttribute(&cus, hipDeviceAttributeMultiprocessorCount, dev) != hipSuccess) { grid = -1; return; }
        if (hipFuncSetAttribute((const void*)fwd_kernel, hipFuncAttributeMaxDynamicSharedMemorySize, LDS_BYTES) != hipSuccess) { fprintf(stderr, "kernel_launch: hipFuncSetAttribute failed\n"); grid = -1; return; }
        if (hipOccupancyMaxActiveBlocksPerMultiprocessor(&per_cu, (const void*)fwd_kernel, 512, LDS_BYTES) != hipSuccess || per_cu < 1) { fprintf(stderr, "kernel_launch: occupancy query says %d\n", per_cu); grid = -1; return; }
        (void)hipGetLastError();
        grid = cus;
    }
    if (grid < 0) return;
    if (hipMemsetAsync((char*)d_ws + WS_CTL, 0, CTL_BYTES, stream) != hipSuccess) return;
    Args a{};
    for (int i = 0; i < 24; ++i) a.in[i] = (const float*)d_in[i];
    a.out = (float*)d_out; a.ws = (unsigned char*)d_ws;
    hipLaunchKernelGGL(fwd_kernel, dim3(grid), dim3(512), LDS_BYTES, stream, a);
}
```
